# Optimizing an MI355X kernel written in HIP

```python
import math
import jax, jax.numpy as jnp
from jax import lax
import numpy as np

D_MODEL = 1024
BATCH = 32
SEQ = 256
DEPTH = 2
DEC_BATCH = 2
DEC_SEQ = 2048
PAST_LEN = 256

GRID_W = 64
N_EVEN = (DEPTH + 1) // 2
N_ODD = DEPTH // 2
ML_HEADS = 4
ML_DK = 128
ML_DV = 128
ML_WIDTH = ML_HEADS * ML_DV
ML_CHUNK = 64
HG_HEADS = 4
HG_DK = 128
HG_DV = 128
HG_WIDTH = HG_HEADS * HG_DK
HG_CHUNK = 32
DA_HEADS = 8
DA_DQK = 64
DA_DV = 2 * DA_DQK
DA_WIDTH = DA_HEADS * DA_DV
Q_BLOCK = 128
ROPE_BASE = 10000.0
EPS = 1e-6
D_FF = ((8 * D_MODEL // 3 + 255) // 256) * 256
EV_SIZES = (ML_HEADS * ML_DK, ML_HEADS * ML_DK, ML_WIDTH, ML_WIDTH, 4 * ML_HEADS,
            HG_WIDTH, HG_WIDTH, HG_WIDTH, HG_HEADS * HG_DV, HG_HEADS * HG_DV)
EV_IN = sum(EV_SIZES)
OD_SIZES = (DA_HEADS * 2 * DA_DQK, DA_HEADS * 2 * DA_DQK, DA_WIDTH)
OD_IN = sum(OD_SIZES)

kernel_name = 'hybrid_mlstm_hgrn2_diffattn_prefix_dit'

f32 = jnp.float32


def _split(x, sizes):
    idx, acc = [], 0
    for s in sizes[:-1]:
        acc += s
        idx.append(acc)
    return jnp.split(x, idx, axis=-1)


def _rmsnorm(x, g):
    xf = x.astype(f32)
    return xf * lax.rsqrt(jnp.mean(xf * xf, axis=-1, keepdims=True) + EPS) * g.astype(f32)


def _head_rmsnorm(x, n_heads, g):
    B, S, W = x.shape
    xh = x.reshape(B, S, n_heads, W // n_heads)
    xh = xh * lax.rsqrt(jnp.mean(xh * xh, axis=-1, keepdims=True) + EPS)
    return xh.reshape(B, S, W) * g.astype(f32)


def _heads(x, n):
    B, S, _ = x.shape
    return x.astype(f32).reshape(B, S, n, -1).transpose(0, 2, 1, 3)


def _merge(x):
    B, H, S, d = x.shape
    return x.transpose(0, 2, 1, 3).reshape(B, S, H * d)


def _chunks(t, L):
    B, H, S = t.shape[:3]
    t = t.astype(f32).reshape((B, H, S // L, L) + t.shape[3:])
    return jnp.moveaxis(t, 2, 0)


def _unchunk(y):
    nc, B, H, L = y.shape[:4]
    y = jnp.moveaxis(y, 0, 2)
    return y.reshape((B, H, nc * L) + y.shape[4:])


def _flip(t):
    return jnp.flip(t, axis=2)


def _mlstm_chunkwise(q, k, v, ig, lf, C0, n0, m0):
    L = ML_CHUNK
    tri = jnp.tril(jnp.ones((L, L), bool))

    def step(carry, xs):
        C, n, m = carry
        qc, kc, vc, ic, fc = xs
        b = jnp.cumsum(fc, axis=-1)
        dmat = jnp.where(tri, b[..., :, None] - b[..., None, :] + ic[..., None, :], -jnp.inf)
        inter = b + m[..., None]
        mt = jnp.maximum(inter, jnp.max(dmat, axis=-1))
        w_inter = jnp.exp(inter - mt)
        s = jnp.einsum('bhtd,bhsd->bhts', qc, kc) * jnp.exp(dmat - mt[..., None])
        num = w_inter[..., None] * jnp.einsum('bhtd,bhde->bhte', qc, C) + jnp.einsum('bhts,bhse->bhte', s, vc)
        den = w_inter * jnp.einsum('bhtd,bhd->bht', qc, n) + jnp.sum(s, axis=-1)
        h = num / jnp.maximum(jnp.abs(den), jnp.exp(-mt))[..., None]
        bl = b[..., -1]
        g = bl[..., None] - b + ic
        m_new = jnp.maximum(bl + m, jnp.max(g, axis=-1))
        decay = jnp.exp(bl + m - m_new)
        wg = jnp.exp(g - m_new[..., None])
        C_new = decay[..., None, None] * C + jnp.einsum('bhs,bhsd,bhse->bhde', wg, kc, vc)
        n_new = decay[..., None] * n + jnp.einsum('bhs,bhsd->bhd', wg, kc)
        return (C_new, n_new, m_new), h

    xs = tuple(_chunks(t, L) for t in (q, k, v, ig, lf))
    (C, n, m), h = lax.scan(step, (C0.astype(f32), n0.astype(f32), m0.astype(f32)), xs)
    return _unchunk(h), C, n, m


def _hgrn2_chunkwise(q, lf, i, S0):
    L = HG_CHUNK
    tri = jnp.tril(jnp.ones((L, L), bool))[..., None]

    def step(S, xs):
        qc, fc, ic = xs
        a = jnp.cumsum(fc, axis=2)
        kc = -jnp.expm1(fc)
        inter = jnp.einsum('bhtd,bhde->bhte', qc * jnp.exp(a), S)
        rel = jnp.exp(jnp.where(tri, a[:, :, :, None, :] - a[:, :, None, :, :], -jnp.inf))
        sc = jnp.einsum('bhtd,bhtsd,bhsd->bhts', qc, rel, kc)
        o = inter + jnp.einsum('bhts,bhse->bhte', sc, ic)
        al = a[:, :, -1]
        S_new = jnp.exp(al)[..., None] * S + jnp.einsum('bhsd,bhse->bhde', kc * jnp.exp(al[:, :, None, :] - a), ic)
        return S_new, o

    xs = tuple(_chunks(t, L) for t in (q, lf, i))
    S, o = lax.scan(step, S0.astype(f32), xs)
    return _unchunk(o), S


def _axial_rope(x):
    B, H, N, _ = x.shape
    rows = N // GRID_W
    row = jnp.repeat(jnp.arange(rows, dtype=f32), GRID_W)
    col = jnp.tile(jnp.arange(GRID_W, dtype=f32), rows)
    half = DA_DQK // 2
    quarter = half // 2
    inv = ROPE_BASE ** (-jnp.arange(quarter, dtype=f32) / quarter)
    xr = x.astype(f32).reshape(B, H, N, 2, DA_DQK)

    def rot(xa, pos):
        ang = (pos[:, None] * inv[None, :])[:, None, :]
        cos, sin = jnp.cos(ang), jnp.sin(ang)
        x1, x2 = xa[..., :quarter], xa[..., quarter:]
        return jnp.concatenate([x1 * cos - x2 * sin, x1 * sin + x2 * cos], axis=-1)

    out = jnp.concatenate([rot(xr[..., :half], row), rot(xr[..., half:], col)], axis=-1)
    return out.reshape(B, H, N, 2 * DA_DQK)


def _diff_attention(q, k, v, lam):
    B, H, S, _ = q.shape
    nb = S // Q_BLOCK
    qb = jnp.moveaxis(q.astype(f32).reshape(B, H, nb, Q_BLOCK, 2 * DA_DQK), 2, 0)
    k = k.astype(f32)
    v = v.astype(f32)
    k1, k2 = k[..., :DA_DQK], k[..., DA_DQK:]
    scale = DA_DQK ** -0.5

    def blk(qblk):
        s1 = jnp.einsum('bhqd,bhkd->bhqk', qblk[..., :DA_DQK], k1) * scale
        s2 = jnp.einsum('bhqd,bhkd->bhqk', qblk[..., DA_DQK:], k2) * scale
        a = jax.nn.softmax(s1, axis=-1) - lam * jax.nn.softmax(s2, axis=-1)
        return jnp.einsum('bhqk,bhkd->bhqd', a, v)

    o = lax.map(blk, qb)
    return jnp.moveaxis(o, 0, 2).reshape(B, H, S, DA_DV)


def _modulation(cond, w, b):
    mod = jnp.einsum('...d,de->...e', jax.nn.silu(cond.astype(f32)), w.astype(f32)) + b.astype(f32)
    return jnp.split(mod[..., None, :], 6, axis=-1)


def _even_mixer(h, e, ev_w_in, ev_gate_b, ev_lb_logits, ml_norm_g, hg_norm_g, ev_w_out, C0, n0, m0, S0):
    B, S, _ = h.shape
    proj = jnp.einsum('bsd,de->bse', h, ev_w_in[e])
    ml_q, ml_k, ml_v, ml_o, ml_g, hg_q, hg_ff, hg_fb, hg_i, hg_o = _split(proj, EV_SIZES)
    q = _heads(ml_q, ML_HEADS) * (ML_DK ** -0.5)
    k = _heads(ml_k, ML_HEADS)
    v = _heads(ml_v, ML_HEADS)
    gates = (ml_g + ev_gate_b[e]).astype(f32).reshape(B, S, 4, ML_HEADS).transpose(2, 0, 3, 1)
    ig_f, ig_b, fg_f, fg_b = gates[0], gates[1], gates[2], gates[3]
    hf, Cf, nf, mf = _mlstm_chunkwise(q, k, v, ig_f, jax.nn.log_sigmoid(fg_f), C0[:, 0], n0[:, 0], m0[:, 0])
    hb, Cb, nb, mb = _mlstm_chunkwise(_flip(q), _flip(k), _flip(v), _flip(ig_b), _flip(jax.nn.log_sigmoid(fg_b)),
                                      C0[:, 1], n0[:, 1], m0[:, 1])
    ml_out = _head_rmsnorm(_merge(hf + _flip(hb)), ML_HEADS, ml_norm_g[e]) * jax.nn.sigmoid(ml_o.astype(f32))
    lb = jnp.cumsum(jax.nn.softmax(ev_lb_logits.astype(f32), axis=0), axis=0)[e]
    lf_f = _heads(jnp.log(lb + (1.0 - lb) * jax.nn.sigmoid(hg_ff.astype(f32))), HG_HEADS)
    lf_b = _heads(jnp.log(lb + (1.0 - lb) * jax.nn.sigmoid(hg_fb.astype(f32))), HG_HEADS)
    qh = _heads(hg_q, HG_HEADS)
    ih = _heads(hg_i, HG_HEADS)
    of, Sf = _hgrn2_chunkwise(qh, lf_f, ih, S0[:, 0])
    ob, Sb = _hgrn2_chunkwise(_flip(qh), _flip(lf_b), _flip(ih), S0[:, 1])
    hg_out = _head_rmsnorm(_merge(of + _flip(ob)), HG_HEADS, hg_norm_g[e]) * jax.nn.silu(hg_o.astype(f32))
    out = jnp.einsum('bse,ed->bsd', jnp.concatenate([ml_out, hg_out], axis=-1), ev_w_out[e])
    states = (jnp.stack([Cf, Cb], axis=1), jnp.stack([nf, nb], axis=1),
              jnp.stack([mf, mb], axis=1), jnp.stack([Sf, Sb], axis=1))
    return out, states


def _odd_mixer(h, o, layer_idx, od_w_in, od_lambda, da_norm_g, od_w_out, ctx_k, ctx_v):
    proj = jnp.einsum('bsd,de->bse', h, od_w_in[o])
    q, k, v = _split(proj, OD_SIZES)
    q = _heads(q, DA_HEADS)
    k = _heads(k, DA_HEADS)
    v = _heads(v, DA_HEADS)
    lam_init = 0.8 - 0.6 * math.exp(-0.3 * layer_idx)
    lp = od_lambda[o].astype(f32)
    lam = jnp.exp(jnp.sum(lp[0] * lp[1])) - jnp.exp(jnp.sum(lp[2] * lp[3])) + lam_init
    if ctx_k is None:
        att = _diff_attention(q, k, v, lam)
        cache = (k.transpose(0, 2, 1, 3), v.transpose(0, 2, 1, 3))
    else:
        q = _axial_rope(q)
        k = _axial_rope(k)
        kk = jnp.concatenate([ctx_k.astype(f32).transpose(0, 2, 1, 3), k], axis=2)
        vv = jnp.concatenate([ctx_v.astype(f32).transpose(0, 2, 1, 3), v], axis=2)
        att = _diff_attention(q, kk, vv, lam)
        cache = None
    att = _merge(att)
    att = _head_rmsnorm(att, DA_HEADS, jnp.tile(da_norm_g[o], DA_HEADS)) * (1.0 - lam_init)
    return jnp.einsum('bse,ed->bsd', att, od_w_out[o]), cache


def _swiglu(h, w1, w3, w2):
    return jnp.einsum('bsf,fd->bsd', jax.nn.silu(jnp.einsum('bsd,df->bsf', h, w1)) * jnp.einsum('bsd,df->bsf', h, w3), w2)


def setup_inputs(seed: int = 0) -> dict:
    key = jax.random.key(seed)
    ks = jax.random.split(key, 32)
    D = D_MODEL

    def nrm(k, shape, scale=1.0):
        return scale * jax.random.normal(k, shape, f32)

    gate_i = nrm(ks[10], (N_EVEN, 2 * ML_HEADS), 0.1)
    gate_f = 3.0 + 3.0 * jax.random.uniform(ks[11], (N_EVEN, 2 * ML_HEADS), f32)
    lb_logits = 2.0 * jnp.arange(N_EVEN + 1, dtype=f32)[:, None] + nrm(ks[12], (N_EVEN + 1, HG_WIDTH), 0.1)
    return {
        'x_prompt': nrm(ks[0], (BATCH, SEQ, D)),
        'x_sample': nrm(ks[1], (DEC_BATCH, DEC_SEQ, D)),
        'c': nrm(ks[2], (DEC_BATCH, D)),
        'c_ctx': nrm(ks[3], (D,)),
        'cache_attn_k': nrm(ks[4], (DEC_BATCH, N_ODD, PAST_LEN, DA_HEADS, 2 * DA_DQK)),
        'cache_attn_v': nrm(ks[5], (DEC_BATCH, N_ODD, PAST_LEN, DA_HEADS, DA_DV)),
        'state_mlstm_C': nrm(ks[6], (DEC_BATCH, N_EVEN, 2, ML_HEADS, ML_DK, ML_DV), 0.3),
        'state_mlstm_n': nrm(ks[7], (DEC_BATCH, N_EVEN, 2, ML_HEADS, ML_DK), 0.3),
        'state_mlstm_m': nrm(ks[8], (DEC_BATCH, N_EVEN, 2, ML_HEADS), 0.5),
        'state_hgrn_S': nrm(ks[9], (DEC_BATCH, N_EVEN, 2, HG_HEADS, HG_DK, HG_DV), 0.5),
        'ada_w': nrm(ks[13], (DEPTH, D, 6 * D), 0.3 * D ** -0.5),
        'ada_b': nrm(ks[14], (DEPTH, 6 * D), 0.05),
        'norm_mix_g': 1.0 + nrm(ks[15], (DEPTH, D), 0.05),
        'norm_ffn_g': 1.0 + nrm(ks[16], (DEPTH, D), 0.05),
        'ev_w_in': nrm(ks[17], (N_EVEN, D, EV_IN), D ** -0.5),
        'ev_gate_b': jnp.concatenate([gate_i, gate_f], axis=1),
        'ev_lb_logits': lb_logits,
        'ml_norm_g': 1.0 + nrm(ks[18], (N_EVEN, ML_WIDTH), 0.05),
        'hg_norm_g': 1.0 + nrm(ks[19], (N_EVEN, HG_WIDTH), 0.05),
        'ev_w_out': nrm(ks[20], (N_EVEN, ML_WIDTH + HG_WIDTH, D), (ML_WIDTH + HG_WIDTH) ** -0.5),
        'od_w_in': nrm(ks[21], (N_ODD, D, OD_IN), D ** -0.5),
        'od_lambda': nrm(ks[22], (N_ODD, 4, DA_DQK), 0.1),
        'da_norm_g': 1.0 + nrm(ks[23], (N_ODD, DA_DV), 0.05),
        'od_w_out': nrm(ks[24], (N_ODD, DA_WIDTH, D), DA_WIDTH ** -0.5),
        'ffn_w1': nrm(ks[25], (DEPTH, D, D_FF), D ** -0.5),
        'ffn_w3': nrm(ks[26], (DEPTH, D, D_FF), D ** -0.5),
        'ffn_w2': nrm(ks[27], (DEPTH, D_FF, D), D_FF ** -0.5),
        'final_norm_g': 1.0 + nrm(ks[28], (D,), 0.05),
    }


def reference(x_prompt, x_sample, c, c_ctx, cache_attn_k, cache_attn_v, state_mlstm_C, state_mlstm_n,
              state_mlstm_m, state_hgrn_S, ada_w, ada_b, norm_mix_g, norm_ffn_g, ev_w_in, ev_gate_b,
              ev_lb_logits, ml_norm_g, hg_norm_g, ev_w_out, od_w_in, od_lambda, da_norm_g, od_w_out,
              ffn_w1, ffn_w3, ffn_w2, final_norm_g):
    Bp = x_prompt.shape[0]
    zC = jnp.zeros((Bp, 2, ML_HEADS, ML_DK, ML_DV), f32)
    zn = jnp.zeros((Bp, 2, ML_HEADS, ML_DK), f32)
    zm = jnp.zeros((Bp, 2, ML_HEADS), f32)
    zS = jnp.zeros((Bp, 2, HG_HEADS, HG_DK, HG_DV), f32)
    xp = x_prompt.astype(f32)
    xs = x_sample.astype(f32)
    ks_, vs_, Cs_, ns_, ms_, Ss_ = [], [], [], [], [], []
    for l in range(DEPTH):
        sh_p, sc_p, g_p, sh2_p, sc2_p, g2_p = _modulation(c_ctx, ada_w[l], ada_b[l])
        sh_s, sc_s, g_s, sh2_s, sc2_s, g2_s = _modulation(c, ada_w[l], ada_b[l])
        hp = _rmsnorm(xp, norm_mix_g[l]) * (1.0 + sc_p) + sh_p
        hs = _rmsnorm(xs, norm_mix_g[l]) * (1.0 + sc_s) + sh_s
        if l % 2 == 0:
            e = l // 2
            mp, st = _even_mixer(hp, e, ev_w_in, ev_gate_b, ev_lb_logits, ml_norm_g, hg_norm_g, ev_w_out,
                                 zC, zn, zm, zS)
            ms, _ = _even_mixer(hs, e, ev_w_in, ev_gate_b, ev_lb_logits, ml_norm_g, hg_norm_g, ev_w_out,
                                state_mlstm_C[:, e], state_mlstm_n[:, e], state_mlstm_m[:, e], state_hgrn_S[:, e])
            Cs_.append(st[0])
            ns_.append(st[1])
            ms_.append(st[2])
            Ss_.append(st[3])
        else:
            o = l // 2
            mp, cache = _odd_mixer(hp, o, l, od_w_in, od_lambda, da_norm_g, od_w_out, None, None)
            ms, _ = _odd_mixer(hs, o, l, od_w_in, od_lambda, da_norm_g, od_w_out,
                               cache_attn_k[:, o], cache_attn_v[:, o])
            ks_.append(cache[0])
            vs_.append(cache[1])
        xp = xp + g_p * mp
        xs = xs + g_s * ms
        hp = _rmsnorm(xp, norm_ffn_g[l]) * (1.0 + sc2_p) + sh2_p
        hs = _rmsnorm(xs, norm_ffn_g[l]) * (1.0 + sc2_s) + sh2_s
        xp = xp + g2_p * _swiglu(hp, ffn_w1[l], ffn_w3[l], ffn_w2[l])
        xs = xs + g2_s * _swiglu(hs, ffn_w1[l], ffn_w3[l], ffn_w2[l])
    y_prompt = _rmsnorm(xp, final_norm_g)
    y_sample = _rmsnorm(xs, final_norm_g)
    new_attn_k = jnp.stack(ks_, axis=1)
    new_attn_v = jnp.stack(vs_, axis=1)
    new_mlstm_C = jnp.stack(Cs_, axis=1)
    new_mlstm_n = jnp.stack(ns_, axis=1)
    new_mlstm_m = jnp.stack(ms_, axis=1)
    new_hgrn_S = jnp.stack(Ss_, axis=1)
    return (y_prompt, y_sample, new_attn_k, new_attn_v, new_mlstm_C, new_mlstm_n, new_mlstm_m, new_hgrn_S)
```

```cpp
#include <hip/hip_runtime.h>
#include <hip/hip_cooperative_groups.h>
#include <cstdio>
namespace cg = cooperative_groups;

typedef unsigned short bf16_t;
using bf16x8 = __attribute__((ext_vector_type(8))) short;
using f32x16 = __attribute__((ext_vector_type(16))) float;
#define DI __device__ __forceinline__
#define MFMA(a, b, c) __builtin_amdgcn_mfma_f32_32x32x16_bf16((a), (b), (c), 0, 0, 0)

constexpr int D = 1024;
constexpr int M = 12288;
constexpr int MP = 8192;
constexpr int DFF = 2816;
constexpr int PNW = 3584;
constexpr int SMEM_BYTES = 77824;
#ifndef REP_G
#define REP_G 1
#endif
#ifndef REP_P0
#define REP_P0 1
#endif
#ifndef REP_MIX
#define REP_MIX 1
#endif
#ifndef REP_ATT
#define REP_ATT 1
#endif

constexpr size_t OFF_W_EVIN = 0;
constexpr size_t OFF_W_EVOUT = OFF_W_EVIN + (size_t)4736 * 1024 * 2;
constexpr size_t OFF_W_FFU0 = OFF_W_EVOUT + (size_t)1024 * 1024 * 2;
constexpr size_t OFF_W_FFU1 = OFF_W_FFU0 + (size_t)5632 * 1024 * 2;
constexpr size_t OFF_W_FFD0 = OFF_W_FFU1 + (size_t)5632 * 1024 * 2;
constexpr size_t OFF_W_FFD1 = OFF_W_FFD0 + (size_t)1024 * 2816 * 2;
constexpr size_t OFF_W_ODIN = OFF_W_FFD1 + (size_t)1024 * 2816 * 2;
constexpr size_t OFF_W_ODOUT = OFF_W_ODIN + (size_t)3072 * 1024 * 2;
constexpr size_t OFF_MOD = OFF_W_ODOUT + (size_t)1024 * 1024 * 2;
constexpr size_t OFF_ROPE = OFF_MOD + (size_t)2 * 3 * 6144 * 4;
constexpr size_t OFF_MISC = OFF_ROPE + 8192;
constexpr size_t OFF_BAR = OFF_MISC + 256;
constexpr size_t OFF_GATES = OFF_BAR + 16384;
constexpr size_t OFF_KC = OFF_GATES + (size_t)M * 16 * 4;
constexpr size_t OFF_VCT = OFF_KC + (size_t)2 * 8 * 256 * 128 * 2;
constexpr size_t OFF_NLOC = OFF_VCT + (size_t)2 * 8 * 256 * 128 * 2;
constexpr size_t OFF_NINIT = OFF_NLOC + (size_t)1536 * 128 * 4;
constexpr size_t OFF_SCAL = OFF_NINIT + (size_t)1536 * 128 * 4;
constexpr size_t OFF_MINIT = OFF_SCAL + (size_t)1536 * 4 * 4;
constexpr size_t OFF_AL = OFF_MINIT + (size_t)1536 * 4;
constexpr size_t OFF_PN = OFF_AL + (size_t)1536 * 128 * 4;
constexpr size_t OFF_PT = OFF_PN + (size_t)M * PNW * 2;
constexpr size_t OFF_ST = OFF_PT + (size_t)1536 * M * 2;
constexpr size_t WS_END = OFF_ST + (size_t)1536 * 16384 * 2;
constexpr size_t OFF_A = OFF_ST;
constexpr size_t OFF_ATT = OFF_ST + (size_t)M * 1024 * 2;
constexpr size_t OFF_U = OFF_PN;
constexpr size_t OFF_Q = OFF_PN;
constexpr size_t OFF_KB = OFF_PN + (size_t)M * 1024 * 2;
constexpr size_t OFF_VT = OFF_PN + (size_t)2 * M * 1024 * 2;
constexpr size_t OUT_Y = 0;
constexpr size_t OUT_AK = (size_t)M * 1024;
constexpr size_t OUT_AV = OUT_AK + (size_t)MP * 1024;
constexpr size_t OUT_C = OUT_AV + (size_t)MP * 1024;
constexpr size_t OUT_N = OUT_C + (size_t)32 * 2 * 4 * 16384;
constexpr size_t OUT_M = OUT_N + (size_t)32 * 2 * 4 * 128;
constexpr size_t OUT_S = OUT_M + 256;

struct Params {
  const float *x_prompt, *x_sample, *c, *c_ctx, *cache_k, *cache_v, *st_C, *st_n, *st_m, *st_S;
  const float *ada_w, *ada_b, *norm_mix_g, *norm_ffn_g, *ev_w_in, *ev_gate_b, *ev_lb_logits, *ml_norm_g, *hg_norm_g;
  const float *ev_w_out, *od_w_in, *od_lambda, *da_norm_g, *od_w_out, *ffn_w1, *ffn_w3, *ffn_w2, *final_norm_g;
  float* out;
  unsigned char* ws;
};

typedef __bf16 bf16v2 __attribute__((ext_vector_type(2)));
typedef float f32v2 __attribute__((ext_vector_type(2)));
DI unsigned short f2bf(float x) { return __builtin_bit_cast(unsigned short, (__bf16)x); }
DI float bf2f(unsigned short h) { return __uint_as_float(((unsigned)h) << 16); }
DI unsigned pack2(float a, float b) { f32v2 v = {a, b}; return __builtin_bit_cast(unsigned, __builtin_convertvector(v, bf16v2)); }
DI uint2 pack4(float a, float b, float c, float d) { return make_uint2(pack2(a, b), pack2(c, d)); }
DI float lo_bf(unsigned u) { return __uint_as_float(u << 16); }
DI float hi_bf(unsigned u) { return __uint_as_float(u & 0xffff0000u); }
DI int crow(int reg, int h) { return (reg & 3) + 8 * (reg >> 2) + 4 * h; }
DI float wsum(float v) {
#pragma unroll
  for (int o = 32; o > 0; o >>= 1) v += __shfl_xor(v, o);
  return v;
}
DI float wmax(float v) {
#pragma unroll
  for (int o = 32; o > 0; o >>= 1) v = fmaxf(v, __shfl_xor(v, o));
  return v;
}
DI float logsig(float x) { return fminf(x, 0.f) - log1pf(expf(-fabsf(x))); }
DI float sigmoidf(float x) { return 1.f / (1.f + expf(-x)); }
DI f32x16 zero16() { f32x16 z;
#pragma unroll
  for (int i = 0; i < 16; ++i) z[i] = 0.f;
  return z; }
DI bf16x8 ld8(const bf16_t* p) { return *(const bf16x8*)p; }


#define XB_TMO      128
#define XB_XCNT(j)  (256  + 64 * (j))
#define XB_XSUB(j)  (1280 + 64 * (j))
#define XB_XGEN(j)  (2304 + 64 * (j))
#define XB_TOP      3328
#define XB_TOPGEN   3392
#define XCD_BAR_WORDS 3456
#define XB_SPIN_CAP (1u << 22)
#define LAS __attribute__((address_space(3)))
DI unsigned xb_ld(unsigned* p)              { return __hip_atomic_load(p, __ATOMIC_RELAXED, __HIP_MEMORY_SCOPE_AGENT); }
DI unsigned xb_add(unsigned* p, unsigned v) { return __hip_atomic_fetch_add(p, v, __ATOMIC_RELAXED, __HIP_MEMORY_SCOPE_AGENT); }
DI unsigned xb_xcc_id() { return (unsigned)__builtin_amdgcn_s_getreg((3 << 11) | 20) & 0xFu; }
#define XB_SPIN(cond, bar) do { unsigned _sp = 0; while (cond) { __builtin_amdgcn_s_sleep(1); \
    if ((++_sp & 255u) == 0u) { if (xb_ld(&(bar)[XB_TMO])) break; if (_sp > XB_SPIN_CAP) { atomicAdd(&(bar)[XB_TMO], 1u); break; } } } } while (0)
struct XcdBarrier { unsigned* bar; unsigned x; volatile LAS unsigned* st; };
DI XcdBarrier xcd_barrier_post(unsigned* bar, volatile LAS unsigned* st) {
  XcdBarrier b; b.bar = bar; b.x = xb_xcc_id(); b.st = st;
  if (threadIdx.x == 0) (void)xb_add(&bar[XB_XCNT(b.x)], 1u);
  return b;
}
DI void xcd_barrier_complete(unsigned* bar, unsigned x, unsigned& nloc, unsigned& nx) {
  const unsigned G = gridDim.x * gridDim.y * gridDim.z;
  unsigned sum, cnt, mine, sp = 0u;
  for (;;) {
    sum = 0u; cnt = 0u; mine = 0u;
#pragma unroll
    for (unsigned j = 0; j < 16; ++j) { const unsigned c = xb_ld(&bar[XB_XCNT(j)]); sum += c; cnt += (c > 0u) ? 1u : 0u; mine = (j == x) ? c : mine; }
    if (sum == G) break;
    __builtin_amdgcn_s_sleep(1);
    if ((++sp & 255u) == 0u) { if (xb_ld(&bar[XB_TMO])) break; if (sp > XB_SPIN_CAP) { atomicAdd(&bar[XB_TMO], 1u); break; } }
  }
  nloc = mine > 0u ? mine : 1u; nx = cnt > 0u ? cnt : 1u;
}
DI void xcd_barrier(const XcdBarrier& b) {
  asm volatile("s_waitcnt vmcnt(0)" ::: "memory");
  __syncthreads();
  if (threadIdx.x == 0) {
    unsigned* bar = b.bar;
    __builtin_amdgcn_s_waitcnt(0);
    unsigned nloc = b.st[0], nx = b.st[1];
    if (nloc == 0u) { xcd_barrier_complete(bar, b.x, nloc, nx); b.st[0] = nloc; b.st[1] = nx; }
    const unsigned old = xb_add(&bar[XB_XSUB(b.x)], 1u);
    const unsigned gen = old / nloc;
    if (old + 1u == (gen + 1u) * nloc) {
      __builtin_amdgcn_fence(__ATOMIC_RELEASE, "agent");
      asm volatile("s_waitcnt vmcnt(0)" ::: "memory");
      const unsigned og = xb_add(&bar[XB_TOP], 1u);
      const unsigned tg = og / nx;
      if (og + 1u == (tg + 1u) * nx) xb_add(&bar[XB_TOPGEN], 1u);
      else XB_SPIN(xb_ld(&bar[XB_TOPGEN]) == tg, bar);
      __builtin_amdgcn_fence(__ATOMIC_ACQUIRE, "agent");
      xb_add(&bar[XB_XGEN(b.x)], 1u);
      asm volatile("s_waitcnt vmcnt(0)" ::: "memory");
    } else {
      XB_SPIN(xb_ld(&bar[XB_XGEN(b.x)]) == gen, bar);
      __builtin_amdgcn_fence(__ATOMIC_ACQUIRE, "agent");
      asm volatile("s_waitcnt vmcnt(0)" ::: "memory");
    }
  }
  __syncthreads();
}

DI void load_tile_64x128(bf16_t* dst, const bf16_t* src, size_t ld) {
  const int tid = threadIdx.x;
#pragma unroll
  for (int i = 0; i < 4; ++i) { int c = tid + 256 * i; int row = c >> 4, ch = c & 15; *(uint4*)(dst + row * 136 + ch * 8) = *(const uint4*)(src + (size_t)row * ld + ch * 8); }
}
DI void load_tile_128x64(bf16_t* dst, const bf16_t* src, size_t ld) {
  const int tid = threadIdx.x;
#pragma unroll
  for (int i = 0; i < 4; ++i) { int c = tid + 256 * i; int row = c >> 3, ch = c & 7; *(uint4*)(dst + row * 72 + ch * 8) = *(const uint4*)(src + (size_t)row * ld + ch * 8); }
}

struct TDesc { const float* src0; const float* src1; bf16_t* dst; int srcN, K, kind, tn, tk; };
DI TDesc tdecode(const Params& p, int t) {
  TDesc d; d.src1 = nullptr;
  if (t < 1184) { d.src0 = p.ev_w_in; d.srcN = 4624; d.K = 1024; d.dst = (bf16_t*)(p.ws + OFF_W_EVIN); d.kind = 1; d.tn = t / 16; d.tk = t % 16; }
  else if (t < 1440) { t -= 1184; d.src0 = p.ev_w_out; d.srcN = 1024; d.K = 1024; d.dst = (bf16_t*)(p.ws + OFF_W_EVOUT); d.kind = 0; d.tn = t / 16; d.tk = t % 16; }
  else if (t < 4256) { t -= 1440; int l = t / 1408; t -= l * 1408; d.src0 = p.ffn_w1 + (size_t)l * 1024 * DFF; d.src1 = p.ffn_w3 + (size_t)l * 1024 * DFF; d.srcN = DFF; d.K = 1024;
    d.dst = (bf16_t*)(p.ws + (l ? OFF_W_FFU1 : OFF_W_FFU0)); d.kind = 2; d.tn = t / 16; d.tk = t % 16; }
  else if (t < 5664) { t -= 4256; int l = t / 704; t -= l * 704; d.src0 = p.ffn_w2 + (size_t)l * DFF * 1024; d.srcN = 1024; d.K = DFF;
    d.dst = (bf16_t*)(p.ws + (l ? OFF_W_FFD1 : OFF_W_FFD0)); d.kind = 0; d.tn = t / 44; d.tk = t % 44; }
  else if (t < 6432) { t -= 5664; d.src0 = p.od_w_in; d.srcN = 3072; d.K = 1024; d.dst = (bf16_t*)(p.ws + OFF_W_ODIN); d.kind = 0; d.tn = t / 16; d.tk = t % 16; }
  else { t -= 6432; d.src0 = p.od_w_out; d.srcN = 1024; d.K = 1024; d.dst = (bf16_t*)(p.ws + OFF_W_ODOUT); d.kind = 0; d.tn = t / 16; d.tk = t % 16; }
  return d;
}
DI void t_load(const TDesc& d, float4& v0, float4& v1, float4& v2, float4& v3) {
  const int tid = threadIdx.x; const int c4 = (tid & 15) * 4, kr = tid >> 4;
  const int n = d.tn * 64 + c4;
  const float* src = d.src0; int sc;
  if (d.kind == 0) sc = n;
  else if (d.kind == 1) sc = n < 2048 ? n : (n < 4608 ? n + 16 : (n < 4624 ? n - 4608 + 2048 : -1));
  else { int jb = n >> 6, r = n & 63; src = (r < 32) ? d.src0 : d.src1; sc = jb * 32 + (r & 31); }
  v0 = v1 = v2 = v3 = make_float4(0.f, 0.f, 0.f, 0.f);
  if (sc >= 0) {
    const float* b = src + (size_t)(d.tk * 64 + kr) * d.srcN + sc;
    v0 = *(const float4*)(b); v1 = *(const float4*)(b + (size_t)16 * d.srcN); v2 = *(const float4*)(b + (size_t)32 * d.srcN); v3 = *(const float4*)(b + (size_t)48 * d.srcN);
  }
}
DI void t_ldsw(float* lds, const float4& v0, const float4& v1, const float4& v2, const float4& v3) {
  const int tid = threadIdx.x; const int c4 = (tid & 15) * 4, kr = tid >> 4;
  float* d = lds + kr * 65 + c4;
  d[0] = v0.x; d[1] = v0.y; d[2] = v0.z; d[3] = v0.w;
  d[16 * 65] = v1.x; d[16 * 65 + 1] = v1.y; d[16 * 65 + 2] = v1.z; d[16 * 65 + 3] = v1.w;
  d[32 * 65] = v2.x; d[32 * 65 + 1] = v2.y; d[32 * 65 + 2] = v2.z; d[32 * 65 + 3] = v2.w;
  d[48 * 65] = v3.x; d[48 * 65 + 1] = v3.y; d[48 * 65 + 2] = v3.z; d[48 * 65 + 3] = v3.w;
}
DI void t_store(const TDesc& d, const float* lds) {
  const int tid = threadIdx.x; const int nn = tid >> 2, kq = (tid & 3) * 16;
  unsigned w[8];
#pragma unroll
  for (int j = 0; j < 8; ++j) w[j] = pack2(lds[(kq + 2 * j) * 65 + nn], lds[(kq + 2 * j + 1) * 65 + nn]);
  bf16_t* o = d.dst + (size_t)(d.tn * 64 + nn) * d.K + d.tk * 64 + kq;
  *(uint4*)o = make_uint4(w[0], w[1], w[2], w[3]);
  *(uint4*)(o + 8) = make_uint4(w[4], w[5], w[6], w[7]);
}

DI void mod_unit(const Params& p, int u, float* lds) {
  float* sil = lds; float* red = lds + 3072;
  float* MOD = (float*)(p.ws + OFF_MOD);
  const int tid = threadIdx.x;
  for (int i = tid; i < 3072; i += 256) { int j = i >> 10, k = i & 1023; float v = (j == 0) ? p.c_ctx[k] : p.c[(j - 1) * 1024 + k]; sil[i] = v / (1.f + expf(-v)); }
  __syncthreads();
  const int l = u / 48, cb = u % 48; const int cgp = tid & 31, kg = tid >> 5;
  const float* w = p.ada_w + (size_t)l * 1024 * 6144 + cb * 128 + cgp * 4;
  float a0x = 0, a0y = 0, a0z = 0, a0w = 0, a1x = 0, a1y = 0, a1z = 0, a1w = 0, a2x = 0, a2y = 0, a2z = 0, a2w = 0;
#pragma unroll 4
  for (int k = kg * 128; k < kg * 128 + 128; ++k) {
    float4 wv = *(const float4*)(w + (size_t)k * 6144);
    float s0 = sil[k], s1 = sil[1024 + k], s2 = sil[2048 + k];
    a0x += s0 * wv.x; a0y += s0 * wv.y; a0z += s0 * wv.z; a0w += s0 * wv.w;
    a1x += s1 * wv.x; a1y += s1 * wv.y; a1z += s1 * wv.z; a1w += s1 * wv.w;
    a2x += s2 * wv.x; a2y += s2 * wv.y; a2z += s2 * wv.z; a2w += s2 * wv.w;
  }
  float* r0 = red + (kg * 3 + 0) * 128 + cgp * 4; r0[0] = a0x; r0[1] = a0y; r0[2] = a0z; r0[3] = a0w;
  float* r1 = red + (kg * 3 + 1) * 128 + cgp * 4; r1[0] = a1x; r1[1] = a1y; r1[2] = a1z; r1[3] = a1w;
  float* r2 = red + (kg * 3 + 2) * 128 + cgp * 4; r2[0] = a2x; r2[1] = a2y; r2[2] = a2z; r2[3] = a2w;
  __syncthreads();
  for (int i = tid; i < 384; i += 256) {
    int j = i >> 7, cc = i & 127; float s = 0;
#pragma unroll
    for (int g = 0; g < 8; ++g) s += red[(g * 3 + j) * 128 + cc];
    s += p.ada_b[l * 6144 + cb * 128 + cc];
    MOD[(l * 3 + j) * 6144 + cb * 128 + cc] = s;
  }
  __syncthreads();
}

DI void phase0(const Params& p, unsigned char* smem) {
  float* lds = (float*)smem;
  const int tid = threadIdx.x;
  {
    int item = blockIdx.x;
    if (item < 96) { mod_unit(p, item, lds); item += gridDim.x; }
    float4 v0, v1, v2, v3;
    TDesc cur = tdecode(p, 0);
    bool have = item < 6784;
    if (have) { cur = tdecode(p, item - 96); t_load(cur, v0, v1, v2, v3); }
    while (have) {
      t_ldsw(lds, v0, v1, v2, v3);
      const int nitem = item + gridDim.x; const bool hn = nitem < 6784;
      TDesc nxt = cur;
      if (hn) { nxt = tdecode(p, nitem - 96); t_load(nxt, v0, v1, v2, v3); }
      __syncthreads();
      t_store(cur, lds);
      __syncthreads();
      cur = nxt; item = nitem; have = hn;
    }
  }
  for (int item = blockIdx.x; item < 7041; item += gridDim.x) {
    if (item < 6784) continue;
    int t = item - 96;
    t -= 6688;
    if (t < 256) {
      bf16_t* KC = (bf16_t*)(p.ws + OFF_KC); bf16_t* VCT = (bf16_t*)(p.ws + OFF_VCT);
#pragma unroll 4
      for (int j = 0; j < 16; ++j) {
        int idx = t * 4096 + j * 256 + tid;
        if (idx < 524288) { int d = idx & 127, key = (idx >> 7) & 255, h = (idx >> 15) & 7, b = idx >> 18;
          KC[idx] = f2bf(p.cache_k[((size_t)(b * 256 + key) * 8 + h) * 128 + d]); }
        else { int i2 = idx - 524288; int key = i2 & 255, dv = (i2 >> 8) & 127, h = (i2 >> 15) & 7, b = i2 >> 18;
          VCT[i2] = f2bf(p.cache_v[((size_t)(b * 256 + key) * 8 + h) * 128 + dv]); }
      }
      continue;
    }
    float* ROPE = (float*)(p.ws + OFF_ROPE); float* MISC = (float*)(p.ws + OFF_MISC);
    for (int idx = tid; idx < 1024; idx += 256) {
      int pos = idx >> 4, i = idx & 15;
      float inv = powf(10000.f, -(float)i / 16.f);
      float ang = (float)pos * inv;
      ROPE[idx * 2] = cosf(ang); ROPE[idx * 2 + 1] = sinf(ang);
    }
    if (tid == 0) {
      float s01 = 0, s23 = 0;
      for (int i = 0; i < 64; ++i) { s01 += p.od_lambda[i] * p.od_lambda[64 + i]; s23 += p.od_lambda[128 + i] * p.od_lambda[192 + i]; }
      const float lam_init = 0.8f - 0.6f * expf(-0.3f);
      MISC[0] = expf(s01) - expf(s23) + lam_init;
      MISC[1] = lam_init;
    }
  }
}

DI void norm_phase(const float* src_p, const float* src_s, const float* gain, const float* mod, int sc_off, int sh_off, bf16_t* A) {
  const int wave = threadIdx.x >> 6, lane = threadIdx.x & 63;
  for (int row = blockIdx.x * 4 + wave; row < M; row += gridDim.x * 4) {
    const float* src = row < MP ? src_p + (size_t)row * D : src_s + (size_t)(row - MP) * D;
    const int j = row < MP ? 0 : 1 + ((row - MP) >> 11);
    float4 v[4]; float ss = 0;
#pragma unroll
    for (int i = 0; i < 4; ++i) { v[i] = *(const float4*)(src + i * 256 + lane * 4); ss += v[i].x * v[i].x + v[i].y * v[i].y + v[i].z * v[i].z + v[i].w * v[i].w; }
    ss = wsum(ss);
    const float rstd = rsqrtf(ss * (1.f / 1024.f) + 1e-6f);
    const float* msc = mod + j * 6144 + sc_off; const float* msh = mod + j * 6144 + sh_off;
#pragma unroll
    for (int i = 0; i < 4; ++i) {
      int c = i * 256 + lane * 4;
      float4 g4 = *(const float4*)(gain + c), sc4 = *(const float4*)(msc + c), sh4 = *(const float4*)(msh + c);
      float o0 = v[i].x * rstd * g4.x * (1.f + sc4.x) + sh4.x;
      float o1 = v[i].y * rstd * g4.y * (1.f + sc4.y) + sh4.y;
      float o2 = v[i].z * rstd * g4.z * (1.f + sc4.z) + sh4.z;
      float o3 = v[i].w * rstd * g4.w * (1.f + sc4.w) + sh4.w;
      *(uint2*)(A + (size_t)row * D + c) = pack4(o0, o1, o2, o3);
    }
  }
}

DI void final_norm_phase(float* X, const float* gain) {
  const int wave = threadIdx.x >> 6, lane = threadIdx.x & 63;
  for (int row = blockIdx.x * 4 + wave; row < M; row += gridDim.x * 4) {
    float* src = X + (size_t)row * D;
    float4 v[4]; float ss = 0;
#pragma unroll
    for (int i = 0; i < 4; ++i) { v[i] = *(const float4*)(src + i * 256 + lane * 4); ss += v[i].x * v[i].x + v[i].y * v[i].y + v[i].z * v[i].z + v[i].w * v[i].w; }
    ss = wsum(ss);
    const float rstd = rsqrtf(ss * (1.f / 1024.f) + 1e-6f);
#pragma unroll
    for (int i = 0; i < 4; ++i) {
      int c = i * 256 + lane * 4;
      float4 g4 = *(const float4*)(gain + c);
      float4 o; o.x = v[i].x * rstd * g4.x; o.y = v[i].y * rstd * g4.y; o.z = v[i].z * rstd * g4.z; o.w = v[i].w * rstd * g4.w;
      *(float4*)(src + c) = o;
    }
  }
}

template <int BM, int BN, int BK, bool SPLIT, class Epi>
DI void gemm_phase(const bf16_t* __restrict__ A, int lda, const bf16_t* __restrict__ Bt, int ldb, int Mrows, int N, int K, const Epi& epi, unsigned char* smem) {
  constexpr int MI = BM / 64, NI = BN / 64;
  constexpr int LDK = BK + 8;
  constexpr int LDS_A = BM * LDK, LDS_B = BN * LDK;
  constexpr int CPR = BK / 8;
  constexpr int RPP = 256 / CPR;
  constexpr int NA = BM / RPP, NB = BN / RPP;
  bf16_t* As = (bf16_t*)smem;
  bf16_t* Bs = As + 2 * LDS_A;
  const int tid = threadIdx.x, lane = tid & 63, wave = tid >> 6, wm = wave >> 1, wn = wave & 1, lr = lane & 31, lh = lane >> 5;
  const int ntm = Mrows / BM, ntn = N / BN, nkfull = K / BK;
  const int lrow = tid / CPR, lch = tid % CPR;
  const int lofs = lrow * LDK + lch * 8;
  const bf16_t* as0 = As + (wm * (BM / 2) + lr) * LDK + lh * 8;
  const bf16_t* bs0 = Bs + (wn * (BN / 2) + lr) * LDK + lh * 8;
  const int ntiles = ntm * ntn;
  const int nfull = SPLIT ? ((int)gridDim.x < ntiles ? (int)gridDim.x : ntiles) : ntiles;
  const int nitems = SPLIT ? nfull + 2 * (ntiles - nfull) : ntiles;
  for (int item = blockIdx.x; item < nitems; item += gridDim.x) {
    int tile = item, kbeg = 0, nk = nkfull; bool part = false;
    if (SPLIT && item >= nfull) { tile = nfull + ((item - nfull) >> 1); nk = nkfull >> 1; kbeg = ((item - nfull) & 1) * nk; part = true; }
    const int tm = tile % ntm, tn = tile / ntm; const int m0 = tm * BM, n0 = tn * BN;
    f32x16 acc[MI][NI];
#pragma unroll
    for (int mi = 0; mi < MI; ++mi)
#pragma unroll
      for (int ni = 0; ni < NI; ++ni) acc[mi][ni] = zero16();
    static_assert(NA <= 4 && NB <= 4, "staging registers");
    uint4 a00, a01, a02, a03, b00, b01, b02, b03, a10, a11, a12, a13, b10, b11, b12, b13;
    a00 = a01 = a02 = a03 = b00 = b01 = b02 = b03 = a10 = a11 = a12 = a13 = b10 = b11 = b12 = b13 = make_uint4(0u, 0u, 0u, 0u);
    const bf16_t* Ag = A + (size_t)(m0 + lrow) * lda + lch * 8 + (size_t)kbeg * BK;
    const bf16_t* Bg = Bt + (size_t)(n0 + lrow) * ldb + lch * 8 + (size_t)kbeg * BK;
    if (NA > 0) a00 = *(const uint4*)(Ag + (size_t)(RPP * 0) * lda + (0) * BK);
    if (NA > 1) a01 = *(const uint4*)(Ag + (size_t)(RPP * 1) * lda + (0) * BK);
    if (NA > 2) a02 = *(const uint4*)(Ag + (size_t)(RPP * 2) * lda + (0) * BK);
    if (NA > 3) a03 = *(const uint4*)(Ag + (size_t)(RPP * 3) * lda + (0) * BK);
    if (NB > 0) b00 = *(const uint4*)(Bg + (size_t)(RPP * 0) * ldb + (0) * BK);
    if (NB > 1) b01 = *(const uint4*)(Bg + (size_t)(RPP * 1) * ldb + (0) * BK);
    if (NB > 2) b02 = *(const uint4*)(Bg + (size_t)(RPP * 2) * ldb + (0) * BK);
    if (NB > 3) b03 = *(const uint4*)(Bg + (size_t)(RPP * 3) * ldb + (0) * BK);
    if (NA > 0) a10 = *(const uint4*)(Ag + (size_t)(RPP * 0) * lda + (1) * BK);
    if (NA > 1) a11 = *(const uint4*)(Ag + (size_t)(RPP * 1) * lda + (1) * BK);
    if (NA > 2) a12 = *(const uint4*)(Ag + (size_t)(RPP * 2) * lda + (1) * BK);
    if (NA > 3) a13 = *(const uint4*)(Ag + (size_t)(RPP * 3) * lda + (1) * BK);
    if (NB > 0) b10 = *(const uint4*)(Bg + (size_t)(RPP * 0) * ldb + (1) * BK);
    if (NB > 1) b11 = *(const uint4*)(Bg + (size_t)(RPP * 1) * ldb + (1) * BK);
    if (NB > 2) b12 = *(const uint4*)(Bg + (size_t)(RPP * 2) * ldb + (1) * BK);
    if (NB > 3) b13 = *(const uint4*)(Bg + (size_t)(RPP * 3) * ldb + (1) * BK);
    if (NA > 0) *(uint4*)(As + (0) * LDS_A + lofs + RPP * 0 * LDK) = a00;
    if (NA > 1) *(uint4*)(As + (0) * LDS_A + lofs + RPP * 1 * LDK) = a01;
    if (NA > 2) *(uint4*)(As + (0) * LDS_A + lofs + RPP * 2 * LDK) = a02;
    if (NA > 3) *(uint4*)(As + (0) * LDS_A + lofs + RPP * 3 * LDK) = a03;
    if (NB > 0) *(uint4*)(Bs + (0) * LDS_B + lofs + RPP * 0 * LDK) = b00;
    if (NB > 1) *(uint4*)(Bs + (0) * LDS_B + lofs + RPP * 1 * LDK) = b01;
    if (NB > 2) *(uint4*)(Bs + (0) * LDS_B + lofs + RPP * 2 * LDK) = b02;
    if (NB > 3) *(uint4*)(Bs + (0) * LDS_B + lofs + RPP * 3 * LDK) = b03;
    __syncthreads();
    for (int kt = 0; kt < nk; kt += 2) {
      if (kt + 2 < nk) {
        if (NA > 0) a00 = *(const uint4*)(Ag + (size_t)(RPP * 0) * lda + (kt + 2) * BK);
        if (NA > 1) a01 = *(const uint4*)(Ag + (size_t)(RPP * 1) * lda + (kt + 2) * BK);
        if (NA > 2) a02 = *(const uint4*)(Ag + (size_t)(RPP * 2) * lda + (kt + 2) * BK);
        if (NA > 3) a03 = *(const uint4*)(Ag + (size_t)(RPP * 3) * lda + (kt + 2) * BK);
        if (NB > 0) b00 = *(const uint4*)(Bg + (size_t)(RPP * 0) * ldb + (kt + 2) * BK);
        if (NB > 1) b01 = *(const uint4*)(Bg + (size_t)(RPP * 1) * ldb + (kt + 2) * BK);
        if (NB > 2) b02 = *(const uint4*)(Bg + (size_t)(RPP * 2) * ldb + (kt + 2) * BK);
        if (NB > 3) b03 = *(const uint4*)(Bg + (size_t)(RPP * 3) * ldb + (kt + 2) * BK);
      }
      {
        const bf16_t* as = as0 + (0) * LDS_A; const bf16_t* bs = bs0 + (0) * LDS_B;
      #pragma unroll
        for (int ks = 0; ks < BK / 16; ++ks) {
          bf16x8 af[MI], bfr[NI];
      #pragma unroll
          for (int mi = 0; mi < MI; ++mi) af[mi] = ld8(as + mi * 32 * LDK + ks * 16);
      #pragma unroll
          for (int ni = 0; ni < NI; ++ni) bfr[ni] = ld8(bs + ni * 32 * LDK + ks * 16);
      #pragma unroll
          for (int mi = 0; mi < MI; ++mi)
      #pragma unroll
            for (int ni = 0; ni < NI; ++ni) acc[mi][ni] = MFMA(af[mi], bfr[ni], acc[mi][ni]);
        }
      }
      if (NA > 0) *(uint4*)(As + (1) * LDS_A + lofs + RPP * 0 * LDK) = a10;
      if (NA > 1) *(uint4*)(As + (1) * LDS_A + lofs + RPP * 1 * LDK) = a11;
      if (NA > 2) *(uint4*)(As + (1) * LDS_A + lofs + RPP * 2 * LDK) = a12;
      if (NA > 3) *(uint4*)(As + (1) * LDS_A + lofs + RPP * 3 * LDK) = a13;
      if (NB > 0) *(uint4*)(Bs + (1) * LDS_B + lofs + RPP * 0 * LDK) = b10;
      if (NB > 1) *(uint4*)(Bs + (1) * LDS_B + lofs + RPP * 1 * LDK) = b11;
      if (NB > 2) *(uint4*)(Bs + (1) * LDS_B + lofs + RPP * 2 * LDK) = b12;
      if (NB > 3) *(uint4*)(Bs + (1) * LDS_B + lofs + RPP * 3 * LDK) = b13;
      __syncthreads();
      if (kt + 3 < nk) {
        if (NA > 0) a10 = *(const uint4*)(Ag + (size_t)(RPP * 0) * lda + (kt + 3) * BK);
        if (NA > 1) a11 = *(const uint4*)(Ag + (size_t)(RPP * 1) * lda + (kt + 3) * BK);
        if (NA > 2) a12 = *(const uint4*)(Ag + (size_t)(RPP * 2) * lda + (kt + 3) * BK);
        if (NA > 3) a13 = *(const uint4*)(Ag + (size_t)(RPP * 3) * lda + (kt + 3) * BK);
        if (NB > 0) b10 = *(const uint4*)(Bg + (size_t)(RPP * 0) * ldb + (kt + 3) * BK);
        if (NB > 1) b11 = *(const uint4*)(Bg + (size_t)(RPP * 1) * ldb + (kt + 3) * BK);
        if (NB > 2) b12 = *(const uint4*)(Bg + (size_t)(RPP * 2) * ldb + (kt + 3) * BK);
        if (NB > 3) b13 = *(const uint4*)(Bg + (size_t)(RPP * 3) * ldb + (kt + 3) * BK);
      }
      {
        const bf16_t* as = as0 + (1) * LDS_A; const bf16_t* bs = bs0 + (1) * LDS_B;
      #pragma unroll
        for (int ks = 0; ks < BK / 16; ++ks) {
          bf16x8 af[MI], bfr[NI];
      #pragma unroll
          for (int mi = 0; mi < MI; ++mi) af[mi] = ld8(as + mi * 32 * LDK + ks * 16);
      #pragma unroll
          for (int ni = 0; ni < NI; ++ni) bfr[ni] = ld8(bs + ni * 32 * LDK + ks * 16);
      #pragma unroll
          for (int mi = 0; mi < MI; ++mi)
      #pragma unroll
            for (int ni = 0; ni < NI; ++ni) acc[mi][ni] = MFMA(af[mi], bfr[ni], acc[mi][ni]);
        }
      }
      if (kt + 2 < nk) {
        if (NA > 0) *(uint4*)(As + (0) * LDS_A + lofs + RPP * 0 * LDK) = a00;
        if (NA > 1) *(uint4*)(As + (0) * LDS_A + lofs + RPP * 1 * LDK) = a01;
        if (NA > 2) *(uint4*)(As + (0) * LDS_A + lofs + RPP * 2 * LDK) = a02;
        if (NA > 3) *(uint4*)(As + (0) * LDS_A + lofs + RPP * 3 * LDK) = a03;
        if (NB > 0) *(uint4*)(Bs + (0) * LDS_B + lofs + RPP * 0 * LDK) = b00;
        if (NB > 1) *(uint4*)(Bs + (0) * LDS_B + lofs + RPP * 1 * LDK) = b01;
        if (NB > 2) *(uint4*)(Bs + (0) * LDS_B + lofs + RPP * 2 * LDK) = b02;
        if (NB > 3) *(uint4*)(Bs + (0) * LDS_B + lofs + RPP * 3 * LDK) = b03;
      }
      __syncthreads();
    }
    epi.template run<MI, NI>(acc, m0 + wm * (BM / 2), n0 + wn * (BN / 2), lr, lh, part);
  }
}

struct EpiEvIn {
  bf16_t* PN; bf16_t* PT; float* gates; const float* gate_b;
  template <int MI, int NI> DI void run(f32x16 (&acc)[MI][NI], int rbase, int cbase, int lr, int lh, bool part) const {
#pragma unroll
    for (int ni = 0; ni < NI; ++ni) {
      const int col = cbase + ni * 32 + lr; const int seg = col >> 9, cc = col & 511;
      int nat = -1, tr = -1; float scale = 1.f;
      switch (seg) {
        case 0: nat = 0; scale = 0.08838834764831845f; break;
        case 1: nat = 512; tr = 0; break;
        case 2: tr = 512; break;
        case 3: nat = 1024; break;
        case 4: nat = 1536; break;
        case 5: nat = 2048; break;
        case 6: nat = 2560; break;
        case 7: tr = 1024; break;
        case 8: nat = 3072; break;
        default: break;
      }
#pragma unroll
      for (int mi = 0; mi < MI; ++mi)
#pragma unroll
        for (int g = 0; g < 4; ++g) {
          const int row = rbase + mi * 32 + 8 * g + 4 * lh;
          float v0 = acc[mi][ni][4 * g] * scale, v1 = acc[mi][ni][4 * g + 1] * scale, v2 = acc[mi][ni][4 * g + 2] * scale, v3 = acc[mi][ni][4 * g + 3] * scale;
          if (seg == 9) {
            if (cc < 16) { float b = gate_b[cc];
              gates[(size_t)row * 16 + cc] = v0 + b; gates[(size_t)(row + 1) * 16 + cc] = v1 + b; gates[(size_t)(row + 2) * 16 + cc] = v2 + b; gates[(size_t)(row + 3) * 16 + cc] = v3 + b; }
          } else {
            if (nat >= 0) { bf16_t* d = PN + (size_t)row * PNW + nat + cc; d[0] = f2bf(v0); d[PNW] = f2bf(v1); d[2 * PNW] = f2bf(v2); d[3 * PNW] = f2bf(v3); }
            if (tr >= 0) *(uint2*)(PT + (size_t)(tr + cc) * M + row) = pack4(v0, v1, v2, v3);
          }
        }
    }
  }
};

struct EpiResid {
  const float* xin_p; const float* xin_s; float* X; const float* gmod;
  template <int MI, int NI> DI void run(f32x16 (&acc)[MI][NI], int rbase, int cbase, int lr, int lh, bool part) const {
#pragma unroll
    for (int ni = 0; ni < NI; ++ni) {
      const int col = cbase + ni * 32 + lr;
#pragma unroll
      for (int mi = 0; mi < MI; ++mi) {
        const int r0 = rbase + mi * 32; const int j = r0 < MP ? 0 : 1 + ((r0 - MP) >> 11);
        const float gv = gmod[j * 6144 + col];
#pragma unroll
        for (int gg = 0; gg < 4; ++gg) {
          const int row = rbase + mi * 32 + 8 * gg + 4 * lh;
          const float* xi = (row < MP ? xin_p + (size_t)row * D : xin_s + (size_t)(row - MP) * D) + col;
          float* xo = X + (size_t)row * D + col;
#pragma unroll
          for (int e = 0; e < 4; ++e) {
            if (part) atomicAdd(xo + (size_t)e * D, gv * acc[mi][ni][4 * gg + e]);
            else xo[(size_t)e * D] = xi[(size_t)e * D] + gv * acc[mi][ni][4 * gg + e];
          }
        }
      }
    }
  }
};

struct EpiFFUp {
  bf16_t* U;
  template <int MI, int NI> DI void run(f32x16 (&acc)[MI][NI], int rbase, int cbase, int lr, int lh, bool part) const {
    static_assert(NI == 2, "ffn up needs paired tiles");
    const int oc = (cbase >> 6) * 32 + lr;
#pragma unroll
    for (int mi = 0; mi < MI; ++mi)
#pragma unroll
      for (int g = 0; g < 4; ++g) {
        const int row = rbase + mi * 32 + 8 * g + 4 * lh;
#pragma unroll
        for (int e = 0; e < 4; ++e) {
          float a1 = acc[mi][0][4 * g + e], a3 = acc[mi][1][4 * g + e];
          U[(size_t)(row + e) * DFF + oc] = f2bf(a1 * __frcp_rn(1.f + __expf(-a1)) * a3);
        }
      }
  }
};

struct EpiOdIn {
  bf16_t* Q; bf16_t* Kb; bf16_t* VT; float* AK; float* AV; const float* rope;
  template <int MI, int NI> DI void run(f32x16 (&acc)[MI][NI], int rbase, int cbase, int lr, int lh, bool part) const {
#pragma unroll
    for (int ni = 0; ni < NI; ++ni) {
      const int col = cbase + ni * 32 + lr; const int seg = col >> 10, cc = col & 1023; const int d = col & 127;
#pragma unroll
      for (int mi = 0; mi < MI; ++mi)
#pragma unroll
        for (int g = 0; g < 4; ++g) {
          const bool sample = (rbase + mi * 32) >= MP;
          const int row = rbase + mi * 32 + 8 * g + 4 * lh;
          float v[4];
#pragma unroll
          for (int e = 0; e < 4; ++e) v[e] = acc[mi][ni][4 * g + e];
          if (seg < 2) {
            if (sample) {
#pragma unroll
              for (int e = 0; e < 4; ++e) {
                float pv = __shfl_xor(v[e], 16);
                int n = (row + e - MP) & 2047; int pos = (d & 32) ? (n & 63) : (n >> 6);
                float2 cs = *(const float2*)(rope + (pos * 16 + (d & 15)) * 2);
                v[e] = (d & 16) ? (pv * cs.y + v[e] * cs.x) : (v[e] * cs.x - pv * cs.y);
              }
            }
            if (seg == 0) {
#pragma unroll
              for (int e = 0; e < 4; ++e) Q[(size_t)(row + e) * 1024 + cc] = f2bf(v[e] * 0.18033688011112042f);
            } else {
#pragma unroll
              for (int e = 0; e < 4; ++e) Kb[(size_t)(row + e) * 1024 + cc] = f2bf(v[e]);
              if (!sample) {
#pragma unroll
                for (int e = 0; e < 4; ++e) AK[(size_t)(row + e) * 1024 + cc] = v[e];
              }
            }
          } else {
            *(uint2*)(VT + (size_t)cc * M + row) = pack4(v[0], v[1], v[2], v[3]);
            if (!sample) {
#pragma unroll
              for (int e = 0; e < 4; ++e) AV[(size_t)(row + e) * 1024 + cc] = v[e];
            }
          }
        }
    }
  }
};

DI void s1_phase(const Params& p, unsigned char* smem) {
  bf16_t* Vt = (bf16_t*)smem;
  bf16_t* Ktf = Vt + 128 * 72;
  bf16_t* Ktb = Ktf + 128 * 72;
  float* wgf = (float*)(Ktb + 128 * 72);
  float* wgb = wgf + 64;
  const bf16_t* PN = (const bf16_t*)(p.ws + OFF_PN);
  const bf16_t* PT = (const bf16_t*)(p.ws + OFF_PT);
  const float* GATES = (const float*)(p.ws + OFF_GATES);
  float* SCAL = (float*)(p.ws + OFF_SCAL);
  float* NLOC = (float*)(p.ws + OFF_NLOC);
  float* AL = (float*)(p.ws + OFF_AL);
  bf16_t* MLST = (bf16_t*)(p.ws + OFF_ST);
  bf16_t* HGST = (bf16_t*)(p.out);
  const int tid = threadIdx.x, lane = tid & 63, wave = tid >> 6, lr = lane & 31, lh = lane >> 5;
  for (int item = blockIdx.x; item < 1536; item += gridDim.x) {
    const int kind = item >= 768; const int it = item - kind * 768; const int gc = it >> 2, h = it & 3; const int tok0 = gc * 64;
    const int slot0 = it * 2;
    if (kind == 0) {
      load_tile_128x64(Vt, PT + (size_t)(512 + h * 128) * M + tok0, M);
      uint4 rk[4];
      const bf16_t* PTk = PT + (size_t)(h * 128) * M + tok0;
#pragma unroll
      for (int i = 0; i < 4; ++i) { int c = tid + 256 * i; rk[i] = *(const uint4*)(PTk + (size_t)(c >> 3) * M + (c & 7) * 8); }
      if (wave == 0) {
        const float* gp = GATES + (size_t)(tok0 + lane) * 16;
        float igf = gp[h], igb = gp[4 + h], lff = logsig(gp[8 + h]), lfb = logsig(gp[12 + h]);
        float bfw = lff;
#pragma unroll
        for (int o = 1; o < 64; o <<= 1) { float t = __shfl_up(bfw, o); if (lane >= o) bfw += t; }
        float blf = __shfl(bfw, 63);
        float gf = blf - bfw + igf; float mlocf = wmax(gf); wgf[lane] = expf(gf - mlocf);
        float bbw = lfb;
#pragma unroll
        for (int o = 1; o < 64; o <<= 1) { float t = __shfl_down(bbw, o); if (lane + o < 64) bbw += t; }
        float blb = __shfl(bbw, 0);
        float gb = blb - bbw + igb; float mlocb = wmax(gb); wgb[lane] = expf(gb - mlocb);
        if (lane == 0) { SCAL[slot0 * 4 + 0] = blf; SCAL[slot0 * 4 + 1] = mlocf; SCAL[(slot0 + 1) * 4 + 0] = blb; SCAL[(slot0 + 1) * 4 + 1] = mlocb; }
      }
      __syncthreads();
#pragma unroll
      for (int i = 0; i < 4; ++i) {
        int c = tid + 256 * i; int row = c >> 3, ch = c & 7;
        unsigned w[4] = {rk[i].x, rk[i].y, rk[i].z, rk[i].w};
        unsigned of[4], ob[4];
#pragma unroll
        for (int q = 0; q < 4; ++q) {
          float k0 = lo_bf(w[q]), k1 = hi_bf(w[q]);
          int t = ch * 8 + q * 2;
          of[q] = pack2(k0 * wgf[t], k1 * wgf[t + 1]); ob[q] = pack2(k0 * wgb[t], k1 * wgb[t + 1]);
        }
        *(uint4*)(Ktf + row * 72 + ch * 8) = make_uint4(of[0], of[1], of[2], of[3]);
        *(uint4*)(Ktb + row * 72 + ch * 8) = make_uint4(ob[0], ob[1], ob[2], ob[3]);
      }
    } else {
      bf16_t* Xf = Vt;
      bf16_t* Xb = (bf16_t*)(smem + 55808);
      load_tile_64x128(Xf, PN + (size_t)tok0 * PNW + 2048 + h * 128, PNW);
      load_tile_64x128(Xb, PN + (size_t)tok0 * PNW + 2560 + h * 128, PNW);
      __syncthreads();
      const int dir = tid >> 7, dk = tid & 127; const int ch = h * 128 + dk;
      const float lb = 1.f / (1.f + expf(p.ev_lb_logits[512 + ch] - p.ev_lb_logits[ch]));
      const bf16_t* xs = dir ? Xb : Xf;
      bf16_t* Kt = dir ? Ktb : Ktf;
      float r = 0.f;
#pragma unroll 2
      for (int s = 0; s < 64; ++s) {
        int t = dir ? s : 63 - s;
        float x = bf2f(xs[t * 136 + dk]); float f = lb + (1.f - lb) * __frcp_rn(1.f + __expf(-x)); float lf = __logf(f);
        Kt[dk * 72 + t] = f2bf((1.f - f) * __expf(r)); r += lf;
      }
      AL[(slot0 + dir) * 128 + dk] = r;
      __syncthreads();
      load_tile_128x64(Vt, PT + (size_t)(1024 + h * 128) * M + tok0, M);
    }
    __syncthreads();
    bf16_t* ST = kind ? HGST : MLST;
#pragma unroll 1
    for (int dir = 0; dir < 2; ++dir) {
      const bf16_t* Kt = dir ? Ktb : Ktf;
      f32x16 acc[4];
#pragma unroll
      for (int ni = 0; ni < 4; ++ni) acc[ni] = zero16();
#pragma unroll
      for (int ks = 0; ks < 4; ++ks) {
        bf16x8 a = ld8(Kt + (wave * 32 + lr) * 72 + ks * 16 + lh * 8);
#pragma unroll
        for (int ni = 0; ni < 4; ++ni) { bf16x8 b = ld8(Vt + (ni * 32 + lr) * 72 + ks * 16 + lh * 8); acc[ni] = MFMA(a, b, acc[ni]); }
      }
      bf16_t* dst = ST + (size_t)(slot0 + dir) * 16384;
#pragma unroll
      for (int ni = 0; ni < 4; ++ni)
#pragma unroll
        for (int g = 0; g < 4; ++g)
          *(uint2*)(dst + (ni * 32 + lr) * 128 + wave * 32 + 8 * g + 4 * lh) = pack4(acc[ni][4 * g], acc[ni][4 * g + 1], acc[ni][4 * g + 2], acc[ni][4 * g + 3]);
    }
    if (kind == 0) {
      const int dir = tid >> 7, dk = tid & 127; const bf16_t* Kt = dir ? Ktb : Ktf; float s = 0.f;
#pragma unroll 8
      for (int t = 0; t < 64; ++t) s += bf2f(Kt[dk * 72 + t]);
      NLOC[(slot0 + dir) * 128 + dk] = s;
    }
    __syncthreads();
  }
}

DI void s2_phase(const Params& p, unsigned char* smem) {
  const float* __restrict__ SCAL = (const float*)(p.ws + OFF_SCAL);
  float* __restrict__ MINIT = (float*)(p.ws + OFF_MINIT);
  const float* __restrict__ NLOC = (const float*)(p.ws + OFF_NLOC);
  float* __restrict__ NINIT = (float*)(p.ws + OFF_NINIT);
  const float* __restrict__ AL = (const float*)(p.ws + OFF_AL);
  bf16_t* MLST = (bf16_t*)(p.ws + OFF_ST);
  bf16_t* HGST = (bf16_t*)(p.out);
  float* tl = (float*)smem;
  const int tid = threadIdx.x;
  for (int u = blockIdx.x; u < 4352; u += gridDim.x) {
    int kind, sample, seq, h, dir, slab;
    if (u < 256) { kind = u >> 7; int v = u & 127; slab = v & 7; v >>= 3; dir = v & 1; v >>= 1; h = v & 3; seq = v >> 2; sample = 1; }
    else { int v = u - 256; kind = v >= 2048; v -= kind * 2048; slab = v & 7; v >>= 3; dir = v & 1; v >>= 1; h = v & 3; seq = v >> 2; sample = 0; }
    const int nc = sample ? 32 : 4; const int gc0 = sample ? 128 + seq * 32 : seq * 4;
    bf16_t* ST = kind ? HGST : MLST;
    const int e = slab * 2048 + tid * 8; const int dv = e >> 7, dk0 = e & 127;
    float st[8]; float nst = 0.f, m = 0.f;
    const int sidx = (seq * 2 + dir) * 4 + h;
    if (sample) {
      const float* S0 = (kind ? p.st_S : p.st_C) + (size_t)sidx * 16384;
#pragma unroll
      for (int j = 0; j < 8; ++j) st[j] = S0[(dk0 + j) * 128 + dv];
      if (kind == 0) { m = p.st_m[sidx]; if (slab == 0 && tid < 128) nst = p.st_n[sidx * 128 + tid]; }
    } else {
#pragma unroll
      for (int j = 0; j < 8; ++j) st[j] = 0.f;
    }
    const int slot0 = ((gc0 + (dir ? nc - 1 : 0)) * 4 + h) * 2 + dir;
    const int sstep = dir ? -8 : 8;
    uint4 Lq[4]; float4 Aq0[4], Aq1[4]; float2 Sq[4]; float Nq[4];
    const bool nthr = (kind == 0) && (slab == 0) && (tid < 128);
#pragma unroll
    for (int i = 0; i < 4; ++i) {
      const int sl = slot0 + i * sstep;
      Lq[i] = *(const uint4*)(ST + (size_t)sl * 16384 + e);
      Aq0[i] = make_float4(0.f, 0.f, 0.f, 0.f); Aq1[i] = Aq0[i]; Sq[i] = make_float2(0.f, 0.f); Nq[i] = 0.f;
      if (kind) { Aq0[i] = *(const float4*)(AL + sl * 128 + dk0); Aq1[i] = *(const float4*)(AL + sl * 128 + dk0 + 4); }
      else { Sq[i] = *(const float2*)(SCAL + sl * 4); if (nthr) Nq[i] = NLOC[sl * 128 + tid]; }
    }
    for (int ps = 0; ps < nc; ps += 4) {
#pragma unroll
      for (int i = 0; i < 4; ++i) {
        const int slot = slot0 + (ps + i) * sstep;
        const uint4 Lc = Lq[i];
        float dec[8]; float ls;
        if (kind == 0) {
          const float bl = Sq[i].x, mloc = Sq[i].y; const float mn = fmaxf(bl + m, mloc); const float d = __expf(bl + m - mn); ls = __expf(mloc - mn);
#pragma unroll
          for (int j = 0; j < 8; ++j) dec[j] = d;
          if (slab == 0) { if (tid == 0) MINIT[slot] = m; if (tid < 128) { NINIT[slot * 128 + tid] = nst; nst = d * nst + ls * Nq[i]; } }
          m = mn;
        } else {
          ls = 1.f;
          dec[0] = __expf(Aq0[i].x); dec[1] = __expf(Aq0[i].y); dec[2] = __expf(Aq0[i].z); dec[3] = __expf(Aq0[i].w);
          dec[4] = __expf(Aq1[i].x); dec[5] = __expf(Aq1[i].y); dec[6] = __expf(Aq1[i].z); dec[7] = __expf(Aq1[i].w);
        }
        *(uint4*)(ST + (size_t)slot * 16384 + e) = make_uint4(pack2(st[0], st[1]), pack2(st[2], st[3]), pack2(st[4], st[5]), pack2(st[6], st[7]));
        float l[8] = {lo_bf(Lc.x), hi_bf(Lc.x), lo_bf(Lc.y), hi_bf(Lc.y), lo_bf(Lc.z), hi_bf(Lc.z), lo_bf(Lc.w), hi_bf(Lc.w)};
#pragma unroll
        for (int j = 0; j < 8; ++j) st[j] = dec[j] * st[j] + ls * l[j];
        if (ps + i + 4 < nc) {
          const int sl = slot + 4 * sstep;
          Lq[i] = *(const uint4*)(ST + (size_t)sl * 16384 + e);
          if (kind) { Aq0[i] = *(const float4*)(AL + sl * 128 + dk0); Aq1[i] = *(const float4*)(AL + sl * 128 + dk0 + 4); }
          else { Sq[i] = *(const float2*)(SCAL + sl * 4); if (nthr) Nq[i] = NLOC[sl * 128 + tid]; }
        }
      }
    }
    if (!sample) {
#pragma unroll
      for (int j = 0; j < 8; ++j) tl[(dk0 + j) * 17 + (dv & 15)] = st[j];
      __syncthreads();
      float* Co = p.out + (kind ? OUT_S : OUT_C) + (size_t)sidx * 16384;
      const int dkr = tid >> 1, hf = tid & 1;
      float4 o0, o1;
      o0.x = tl[dkr * 17 + hf * 8 + 0]; o0.y = tl[dkr * 17 + hf * 8 + 1]; o0.z = tl[dkr * 17 + hf * 8 + 2]; o0.w = tl[dkr * 17 + hf * 8 + 3];
      o1.x = tl[dkr * 17 + hf * 8 + 4]; o1.y = tl[dkr * 17 + hf * 8 + 5]; o1.z = tl[dkr * 17 + hf * 8 + 6]; o1.w = tl[dkr * 17 + hf * 8 + 7];
      *(float4*)(Co + dkr * 128 + slab * 16 + hf * 8) = o0;
      *(float4*)(Co + dkr * 128 + slab * 16 + hf * 8 + 4) = o1;
      if (kind == 0 && slab == 0) { if (tid < 128) p.out[OUT_N + sidx * 128 + tid] = nst; if (tid == 0) p.out[OUT_M + sidx] = m; }
      __syncthreads();
    }
  }
}

DI void s3_epilogue(const float* Hs, const float* gain, const bf16_t* gate_src, bf16_t* mix_dst, bool use_silu) {
  const int tid = threadIdx.x, t = tid >> 2, part = tid & 3;
  const float* hr = Hs + t * 132 + part * 32;
  float ss = 0.f;
#pragma unroll
  for (int i = 0; i < 8; ++i) { float4 v = *(const float4*)(hr + i * 4); ss += v.x * v.x + v.y * v.y + v.z * v.z + v.w * v.w; }
  ss += __shfl_xor(ss, 1); ss += __shfl_xor(ss, 2);
  const float rstd = rsqrtf(ss * (1.f / 128.f) + 1e-6f);
#pragma unroll
  for (int i = 0; i < 8; ++i) {
    const int d = part * 32 + i * 4;
    float4 v = *(const float4*)(hr + i * 4); float4 g4 = *(const float4*)(gain + d);
    uint2 gs = *(const uint2*)(gate_src + (size_t)t * PNW + d);
    float x0 = lo_bf(gs.x), x1 = hi_bf(gs.x), x2 = lo_bf(gs.y), x3 = hi_bf(gs.y);
    float s0 = __frcp_rn(1.f + __expf(-x0)), s1 = __frcp_rn(1.f + __expf(-x1)), s2 = __frcp_rn(1.f + __expf(-x2)), s3 = __frcp_rn(1.f + __expf(-x3));
    if (use_silu) { s0 *= x0; s1 *= x1; s2 *= x2; s3 *= x3; }
    *(uint2*)(mix_dst + (size_t)t * 1024 + d) = pack4(v.x * rstd * g4.x * s0, v.y * rstd * g4.y * s1, v.z * rstd * g4.z * s2, v.w * rstd * g4.w * s3);
  }
}

DI void s3_phase(const Params& p, unsigned char* smem) {
  const bf16_t* PN = (const bf16_t*)(p.ws + OFF_PN);
  const bf16_t* PT = (const bf16_t*)(p.ws + OFF_PT);
  const float* GATES = (const float*)(p.ws + OFF_GATES);
  const float* SCAL = (const float*)(p.ws + OFF_SCAL);
  const float* NINIT = (const float*)(p.ws + OFF_NINIT);
  const float* MINIT = (const float*)(p.ws + OFF_MINIT);
  const bf16_t* MLST = (const bf16_t*)(p.ws + OFF_ST);
  const bf16_t* HGST = (const bf16_t*)(p.out);
  bf16_t* MIX = (bf16_t*)(p.out + OUT_AK);
  const int tid = threadIdx.x, lane = tid & 63, wave = tid >> 6, lr = lane & 31, lh = lane >> 5, wm = wave >> 1, wn = wave & 1;
  float* Hs = (float*)smem;
  for (int item = blockIdx.x; item < 1536; item += gridDim.x) {
    const int kind = item >= 768; const int it = item - kind * 768; const int gc = it >> 2, h = it & 3; const int tok0 = gc * 64;
    const int slotf = it * 2, slotb = it * 2 + 1;
    if (kind == 0) {
      bf16_t* Qs = (bf16_t*)smem;
      bf16_t* Ks = Qs + 64 * 136;
      bf16_t* Vt = Ks + 64 * 136;
      bf16_t* Pf = Vt + 128 * 72;
      bf16_t* Pb = Pf + 64 * 72;
      float* fa = (float*)(Pb + 64 * 72);
      float* rF = fa, *cF = fa + 64, *wF = fa + 128, *mtF = fa + 192, *rB = fa + 256, *cB = fa + 320, *wB = fa + 384, *mtB = fa + 448;
      float* facPf = fa + 512, *facPb = fa + 576, *facIf = fa + 640, *facIb = fa + 704;
      float* nF = fa + 768, *nB = fa + 896, *qnF = fa + 1024, *qnB = fa + 1088;
      load_tile_64x128(Qs, PN + (size_t)tok0 * PNW + h * 128, PNW);
      load_tile_64x128(Ks, PN + (size_t)tok0 * PNW + 512 + h * 128, PNW);
      load_tile_128x64(Vt, PT + (size_t)(512 + h * 128) * M + tok0, M);
      if (wave == 0) {
        const float* gp = GATES + (size_t)(tok0 + lane) * 16;
        float igf = gp[h], igb = gp[4 + h], lff = logsig(gp[8 + h]), lfb = logsig(gp[12 + h]);
        float bfw = lff;
#pragma unroll
        for (int o = 1; o < 64; o <<= 1) { float t = __shfl_up(bfw, o); if (lane >= o) bfw += t; }
        float cf = igf - bfw; float pm = cf;
#pragma unroll
        for (int o = 1; o < 64; o <<= 1) { float t = __shfl_up(pm, o); if (lane >= o) pm = fmaxf(pm, t); }
        float mF = MINIT[slotf];
        float interF = bfw + mF; float mt = fmaxf(interF, bfw + pm);
        rF[lane] = bfw - mt; cF[lane] = cf; wF[lane] = expf(interF - mt); mtF[lane] = mt;
        float bbw = lfb;
#pragma unroll
        for (int o = 1; o < 64; o <<= 1) { float t = __shfl_down(bbw, o); if (lane + o < 64) bbw += t; }
        float cb = igb - bbw; float sm = cb;
#pragma unroll
        for (int o = 1; o < 64; o <<= 1) { float t = __shfl_down(sm, o); if (lane + o < 64) sm = fmaxf(sm, t); }
        float mB = MINIT[slotb];
        float interB = bbw + mB; float mt2 = fmaxf(interB, bbw + sm);
        rB[lane] = bbw - mt2; cB[lane] = cb; wB[lane] = expf(interB - mt2); mtB[lane] = mt2;
      }
      if (wave >= 2) { int i = tid - 128; nF[i] = NINIT[slotf * 128 + i]; nB[i] = NINIT[slotb * 128 + i]; }
      __syncthreads();
      {
        f32x16 s = zero16();
#pragma unroll
        for (int ks = 0; ks < 8; ++ks) { bf16x8 a = ld8(Qs + (wm * 32 + lr) * 136 + ks * 16 + lh * 8); bf16x8 b = ld8(Ks + (wn * 32 + lr) * 136 + ks * 16 + lh * 8); s = MFMA(a, b, s); }
        const int sidx = wn * 32 + lr; const float cfs = cF[sidx], cbs = cB[sidx];
#pragma unroll
        for (int i = 0; i < 16; ++i) {
          const int t = wm * 32 + crow(i, lh);
          float pf = (sidx <= t) ? s[i] * __expf(rF[t] + cfs) : 0.f;
          float pb = (sidx >= t) ? s[i] * __expf(rB[t] + cbs) : 0.f;
          Pf[t * 72 + sidx] = f2bf(pf); Pb[t * 72 + sidx] = f2bf(pb);
        }
        const int t = tid >> 2, part = tid & 3; float sf = 0.f, sb = 0.f;
#pragma unroll 8
        for (int d = part * 32; d < part * 32 + 32; ++d) { float q = bf2f(Qs[t * 136 + d]); sf += q * nF[d]; sb += q * nB[d]; }
        sf += __shfl_xor(sf, 1); sf += __shfl_xor(sf, 2); sb += __shfl_xor(sb, 1); sb += __shfl_xor(sb, 2);
        if (part == 0) { qnF[t] = sf; qnB[t] = sb; }
      }
      __syncthreads();
      {
        const int t = tid >> 2, part = tid & 3; float sf = 0.f, sb = 0.f;
#pragma unroll
        for (int j = 0; j < 16; ++j) { sf += bf2f(Pf[t * 72 + part * 16 + j]); sb += bf2f(Pb[t * 72 + part * 16 + j]); }
        sf += __shfl_xor(sf, 1); sf += __shfl_xor(sf, 2); sb += __shfl_xor(sb, 1); sb += __shfl_xor(sb, 2);
        if (part == 0) {
          float denf = wF[t] * qnF[t] + sf; float Nf = fmaxf(fabsf(denf), expf(-mtF[t])); facPf[t] = 1.f / Nf; facIf[t] = wF[t] / Nf;
          float denb = wB[t] * qnB[t] + sb; float Nb = fmaxf(fabsf(denb), expf(-mtB[t])); facPb[t] = 1.f / Nb; facIb[t] = wB[t] / Nb;
        }
      }
      __syncthreads();
      f32x16 hacc[2]; hacc[0] = zero16(); hacc[1] = zero16();
#pragma unroll
      for (int pd = 0; pd < 2; ++pd) {
        __builtin_amdgcn_sched_barrier(0);
        const bf16_t* Pm = pd ? Pb : Pf; const float* fac = pd ? facPb : facPf;
        f32x16 t0[2]; t0[0] = zero16(); t0[1] = zero16();
#pragma unroll
        for (int ks = 0; ks < 4; ++ks) {
          bf16x8 bv = ld8(Vt + (wave * 32 + lr) * 72 + ks * 16 + lh * 8);
#pragma unroll
          for (int mi = 0; mi < 2; ++mi) t0[mi] = MFMA(ld8(Pm + (mi * 32 + lr) * 72 + ks * 16 + lh * 8), bv, t0[mi]);
        }
#pragma unroll
        for (int mi = 0; mi < 2; ++mi)
#pragma unroll
          for (int i = 0; i < 16; ++i) hacc[mi][i] += t0[mi][i] * fac[mi * 32 + crow(i, lh)];
      }
#pragma unroll
      for (int pd = 0; pd < 2; ++pd) {
        __builtin_amdgcn_sched_barrier(0);
        const bf16_t* Cm = MLST + (size_t)(pd ? slotb : slotf) * 16384 + (wave * 32 + lr) * 128 + lh * 8;
        const float* fac = pd ? facIb : facIf;
        f32x16 t0[2]; t0[0] = zero16(); t0[1] = zero16();
#pragma unroll
        for (int ks = 0; ks < 8; ++ks) {
          bf16x8 b0 = ld8(Cm + ks * 16);
#pragma unroll
          for (int mi = 0; mi < 2; ++mi) t0[mi] = MFMA(ld8(Qs + (mi * 32 + lr) * 136 + ks * 16 + lh * 8), b0, t0[mi]);
        }
#pragma unroll
        for (int mi = 0; mi < 2; ++mi)
#pragma unroll
          for (int i = 0; i < 16; ++i) hacc[mi][i] += t0[mi][i] * fac[mi * 32 + crow(i, lh)];
      }
      __syncthreads();
#pragma unroll
      for (int mi = 0; mi < 2; ++mi)
#pragma unroll
        for (int i = 0; i < 16; ++i) Hs[(mi * 32 + crow(i, lh)) * 132 + wave * 32 + lr] = hacc[mi][i];
      __syncthreads();
      s3_epilogue(Hs, p.ml_norm_g + h * 128, PN + (size_t)tok0 * PNW + 1024 + h * 128, MIX + (size_t)tok0 * 1024 + h * 128, false);
      __syncthreads();
    } else {
      bf16_t* QF = (bf16_t*)smem;
      bf16_t* QB = QF + 64 * 136;
      bf16_t* KF = QB + 64 * 136;
      bf16_t* KB = KF + 9216;
      bf16_t* P = KF;
      bf16_t* It = KB;
      load_tile_64x128(KF, PN + (size_t)tok0 * PNW + 2048 + h * 128, PNW);
      load_tile_64x128(KB, PN + (size_t)tok0 * PNW + 2560 + h * 128, PNW);
      load_tile_64x128(QF, PN + (size_t)tok0 * PNW + 1536 + h * 128, PNW);
      load_tile_64x128(QB, PN + (size_t)tok0 * PNW + 1536 + h * 128, PNW);
      __syncthreads();
      {
        const int dir = tid >> 7, dk = tid & 127; const int ch = h * 128 + dk;
        const float lb = 1.f / (1.f + expf(p.ev_lb_logits[512 + ch] - p.ev_lb_logits[ch]));
        bf16_t* Qd = dir ? QB : QF; bf16_t* Kd = dir ? KB : KF;
        float a = 0.f;
#pragma unroll 2
        for (int s = 0; s < 64; ++s) {
          int t = dir ? 63 - s : s;
          float x = bf2f(Kd[t * 136 + dk]); float f = lb + (1.f - lb) * __frcp_rn(1.f + __expf(-x)); float lf = __logf(f);
          a += lf;
          float q = bf2f(Qd[t * 136 + dk]);
          Qd[t * 136 + dk] = f2bf(q * __expf(a)); Kd[t * 136 + dk] = f2bf((1.f - f) * __expf(fminf(-a, 80.f)));
        }
      }
      __syncthreads();
      f32x16 pacc;
      {
        f32x16 sf = zero16(), sb = zero16();
#pragma unroll
        for (int ks = 0; ks < 8; ++ks) {
          sf = MFMA(ld8(QF + (wm * 32 + lr) * 136 + ks * 16 + lh * 8), ld8(KF + (wn * 32 + lr) * 136 + ks * 16 + lh * 8), sf);
          sb = MFMA(ld8(QB + (wm * 32 + lr) * 136 + ks * 16 + lh * 8), ld8(KB + (wn * 32 + lr) * 136 + ks * 16 + lh * 8), sb);
        }
        const int sidx = wn * 32 + lr;
#pragma unroll
        for (int i = 0; i < 16; ++i) { const int t = wm * 32 + crow(i, lh); pacc[i] = ((sidx <= t) ? sf[i] : 0.f) + ((sidx >= t) ? sb[i] : 0.f); }
      }
      f32x16 o[2]; o[0] = zero16(); o[1] = zero16();
      {
        const bf16_t* Sf = HGST + (size_t)slotf * 16384 + (wave * 32 + lr) * 128 + lh * 8;
        const bf16_t* Sb = HGST + (size_t)slotb * 16384 + (wave * 32 + lr) * 128 + lh * 8;
#pragma unroll
        for (int ks = 0; ks < 8; ++ks) {
          bf16x8 b0 = ld8(Sf + ks * 16), b1 = ld8(Sb + ks * 16);
#pragma unroll
          for (int mi = 0; mi < 2; ++mi) {
            o[mi] = MFMA(ld8(QF + (mi * 32 + lr) * 136 + ks * 16 + lh * 8), b0, o[mi]);
            o[mi] = MFMA(ld8(QB + (mi * 32 + lr) * 136 + ks * 16 + lh * 8), b1, o[mi]);
          }
        }
      }
      __syncthreads();
      {
        const int sidx = wn * 32 + lr;
#pragma unroll
        for (int i = 0; i < 16; ++i) P[(wm * 32 + crow(i, lh)) * 72 + sidx] = f2bf(pacc[i]);
      }
      load_tile_128x64(It, PT + (size_t)(1024 + h * 128) * M + tok0, M);
      __syncthreads();
#pragma unroll
      for (int ks = 0; ks < 4; ++ks) {
        bf16x8 bv = ld8(It + (wave * 32 + lr) * 72 + ks * 16 + lh * 8);
#pragma unroll
        for (int mi = 0; mi < 2; ++mi) o[mi] = MFMA(ld8(P + (mi * 32 + lr) * 72 + ks * 16 + lh * 8), bv, o[mi]);
      }
#pragma unroll
      for (int mi = 0; mi < 2; ++mi)
#pragma unroll
        for (int i = 0; i < 16; ++i) Hs[(mi * 32 + crow(i, lh)) * 132 + wave * 32 + lr] = o[mi][i];
      __syncthreads();
      s3_epilogue(Hs, p.hg_norm_g + h * 128, PN + (size_t)tok0 * PNW + 3072 + h * 128, MIX + (size_t)tok0 * 1024 + 512 + h * 128, true);
      __syncthreads();
    }
  }
}

DI void online_softmax(f32x16& s, float& m, float& l, f32x16 (&O)[4], bf16x8& p0, bf16x8& p1) {
  float mx = s[0];
#pragma unroll
  for (int i = 1; i < 16; ++i) mx = fmaxf(mx, s[i]);
  { auto r = __builtin_amdgcn_permlane32_swap(__float_as_uint(mx), __float_as_uint(mx), false, false); mx = fmaxf(__uint_as_float(r[0]), __uint_as_float(r[1])); }
  const float mn = fmaxf(m, mx);
  if (__ballot(mn > m) != 0ull) {
    const float alpha = __builtin_amdgcn_exp2f(m - mn);
    l *= alpha;
#pragma unroll
    for (int mt = 0; mt < 4; ++mt)
#pragma unroll
      for (int i = 0; i < 16; ++i) O[mt][i] *= alpha;
    m = mn;
  }
  float sum = 0.f;
#pragma unroll
  for (int i = 0; i < 16; ++i) { s[i] = __builtin_amdgcn_exp2f(s[i] - m); sum += s[i]; }
  l += sum;
  uint4 u0 = make_uint4(pack2(s[0], s[1]), pack2(s[2], s[3]), pack2(s[4], s[5]), pack2(s[6], s[7]));
  uint4 u1 = make_uint4(pack2(s[8], s[9]), pack2(s[10], s[11]), pack2(s[12], s[13]), pack2(s[14], s[15]));
  p0 = __builtin_bit_cast(bf16x8, u0); p1 = __builtin_bit_cast(bf16x8, u1);
}

#define ATTN_GLOAD(KT) do { \
    const int kt_ = (KT); const bf16_t* ksrc; size_t kld; const bf16_t* vsrc; size_t vld; \
    if (sample && kt_ < 4) { ksrc = KC + ((size_t)(seq * 8 + h) * 256 + kt_ * 64) * 128; kld = 128; vsrc = VCT + (size_t)(seq * 8 + h) * 128 * 256 + kt_ * 64; vld = 256; } \
    else { const int kt2 = sample ? kt_ - 4 : kt_; const int t0 = tokbase + kt2 * 64; ksrc = Kb + (size_t)t0 * 1024 + h * 128; kld = 1024; vsrc = VT + (size_t)(h * 128) * M + t0; vld = M; } \
    ksrc += (size_t)(tid >> 4) * kld + (tid & 15) * 8; vsrc += (size_t)(tid >> 3) * vld + (tid & 7) * 8; \
    rk0 = *(const uint4*)(ksrc); rk1 = *(const uint4*)(ksrc + 16 * kld); rk2 = *(const uint4*)(ksrc + 32 * kld); rk3 = *(const uint4*)(ksrc + 48 * kld); \
    rv0 = *(const uint4*)(vsrc); rv1 = *(const uint4*)(vsrc + 32 * vld); rv2 = *(const uint4*)(vsrc + 64 * vld); rv3 = *(const uint4*)(vsrc + 96 * vld); } while (0)
#define ATTN_LSTORE(KD, VD) do { \
    bf16_t* kd_ = (KD) + (tid >> 4) * 136 + (tid & 15) * 8; bf16_t* vd_ = (VD) + (tid >> 3) * 72 + (tid & 7) * 8; \
    *(uint4*)(kd_) = rk0; *(uint4*)(kd_ + 16 * 136) = rk1; *(uint4*)(kd_ + 32 * 136) = rk2; *(uint4*)(kd_ + 48 * 136) = rk3; \
    *(uint4*)(vd_) = rv0; *(uint4*)(vd_ + 32 * 72) = rv1; *(uint4*)(vd_ + 64 * 72) = rv2; *(uint4*)(vd_ + 96 * 72) = rv3; } while (0)

DI void attn_phase(const Params& p, unsigned char* smem) {
  bf16_t* Ks = (bf16_t*)smem;
  bf16_t* Vts = Ks + 64 * 136;
  float* Cmb = (float*)smem;
  const bf16_t* Q = (const bf16_t*)(p.ws + OFF_Q);
  const bf16_t* Kb = (const bf16_t*)(p.ws + OFF_KB);
  const bf16_t* VT = (const bf16_t*)(p.ws + OFF_VT);
  const bf16_t* KC = (const bf16_t*)(p.ws + OFF_KC);
  const bf16_t* VCT = (const bf16_t*)(p.ws + OFF_VCT);
  bf16_t* ATT = (bf16_t*)(p.ws + OFF_ATT);
  const float* MISC = (const float*)(p.ws + OFF_MISC);
  const float lam = MISC[0], lam_init = MISC[1];
  const int tid = threadIdx.x, lane = tid & 63, wave = tid >> 6, lr = lane & 31, lh = lane >> 5;
  const int br = wave >> 1, qw = wave & 1;
  for (int vit = blockIdx.x; vit < 1536; vit += gridDim.x) {
    int item = vit;
    {
      const int b = vit & 511, rnd = vit >> 9; const int xcd = b & 7, slot = b >> 3;
      if (rnd == 0) item = ((xcd * 2 + (slot >> 5)) << 5) | (slot & 31);
      else item = 512 + (((xcd * 32 + (slot >> 1)) << 2) | (((slot & 1) << 1) | (rnd - 1)));
    }
    int sample, seq, h, qb;
    if (item < 512) { sample = 1; qb = item & 31; h = (item >> 5) & 7; seq = item >> 8; }
    else { int v = item - 512; sample = 0; qb = v & 3; h = (v >> 2) & 7; seq = v >> 5; }
    const int tokbase = sample ? MP + seq * 2048 : seq * 256;
    const int nkt = sample ? 36 : 4;
    const int qtok = tokbase + qb * 64 + qw * 32 + lr;
    bf16x8 q[4];
    {
      const bf16_t* qp = Q + (size_t)qtok * 1024 + h * 128 + br * 64 + lh * 8;
#pragma unroll
      for (int s = 0; s < 4; ++s) q[s] = ld8(qp + s * 16);
    }
    f32x16 O[4];
#pragma unroll
    for (int mt = 0; mt < 4; ++mt) O[mt] = zero16();
    float m = -1e30f, l = 0.f;
    uint4 rk0, rk1, rk2, rk3, rv0, rv1, rv2, rv3;
    ATTN_GLOAD(0);
    __syncthreads();
    ATTN_LSTORE(Ks, Vts);
    __syncthreads();
    for (int kt = 0; kt < nkt; ++kt) {
      const int cur = kt & 1;
      if (kt + 1 < nkt) ATTN_GLOAD(kt + 1);
      const bf16_t* Kc = Ks + cur * 17920; const bf16_t* Vc = Vts + cur * 17920;
#pragma unroll
      for (int sub = 0; sub < 2; ++sub) {
        f32x16 s1 = zero16();
#pragma unroll
        for (int s = 0; s < 4; ++s) s1 = MFMA(ld8(Kc + (sub * 32 + lr) * 136 + br * 64 + s * 16 + lh * 8), q[s], s1);
        bf16x8 pa[2];
        online_softmax(s1, m, l, O, pa[0], pa[1]);
#pragma unroll
        for (int k2 = 0; k2 < 2; ++k2)
#pragma unroll
          for (int mt = 0; mt < 4; ++mt) {
            const bf16_t* vp = Vc + (mt * 32 + lr) * 72 + sub * 32 + k2 * 16 + 4 * lh;
            uint2 lo = *(const uint2*)vp, hi = *(const uint2*)(vp + 8);
            bf16x8 vf = __builtin_bit_cast(bf16x8, make_uint4(lo.x, lo.y, hi.x, hi.y));
            O[mt] = MFMA(vf, pa[k2], O[mt]);
          }
      }
      if (kt + 1 < nkt) ATTN_LSTORE(Ks + (cur ^ 1) * 17920, Vts + (cur ^ 1) * 17920);
      __syncthreads();
    }
    l += __shfl_xor(l, 32);
    const float inv = br ? lam / l : 1.f / l;
    __syncthreads();
    if (br == 1) {
#pragma unroll
      for (int mt = 0; mt < 4; ++mt)
#pragma unroll
        for (int i = 0; i < 16; ++i) Cmb[(qw * 64 + mt * 16 + i) * 64 + lane] = O[mt][i] * inv;
    }
    __syncthreads();
    if (br == 0) {
      float ss = 0.f;
#pragma unroll
      for (int mt = 0; mt < 4; ++mt)
#pragma unroll
        for (int i = 0; i < 16; ++i) { float o = O[mt][i] * inv - Cmb[(qw * 64 + mt * 16 + i) * 64 + lane]; O[mt][i] = o; ss += o * o; }
      ss += __shfl_xor(ss, 32);
      const float sc = rsqrtf(ss * (1.f / 128.f) + 1e-6f) * (1.f - lam_init);
      bf16_t* dst = ATT + (size_t)qtok * 1024 + h * 128;
#pragma unroll
      for (int mt = 0; mt < 4; ++mt)
#pragma unroll
        for (int g = 0; g < 4; ++g) {
          const int dv = mt * 32 + 8 * g + 4 * lh;
          float4 g4 = *(const float4*)(p.da_norm_g + dv);
          *(uint2*)(dst + dv) = pack4(O[mt][4 * g] * sc * g4.x, O[mt][4 * g + 1] * sc * g4.y, O[mt][4 * g + 2] * sc * g4.z, O[mt][4 * g + 3] * sc * g4.w);
        }
    }
  }
}

__global__ void __launch_bounds__(256, 2) mega(Params p) {
  __shared__ __attribute__((aligned(16))) unsigned char smem[SMEM_BYTES];
  cg::grid_group grid = cg::this_grid();
  unsigned char* ws = p.ws;
  float* MOD = (float*)(ws + OFF_MOD);
  float* X = p.out + OUT_Y;
  bf16_t* A = (bf16_t*)(ws + OFF_A);
  bf16_t* U = (bf16_t*)(ws + OFF_U);

  __shared__ uint4 xb_words;
  unsigned* bar = (unsigned*)(ws + OFF_BAR);
  if (threadIdx.x == 0) xb_words = make_uint4(0u, 0u, 0u, 0u);
  __syncthreads();
  XcdBarrier xb = xcd_barrier_post(bar, (volatile LAS unsigned*)&xb_words);
  if (p.ws == nullptr) grid.sync();
  for (int rep = 0; rep < REP_P0; ++rep) phase0(p, smem);
  xcd_barrier(xb);
  norm_phase(p.x_prompt, p.x_sample, p.norm_mix_g, MOD, 1024, 0, A);
  xcd_barrier(xb);
  {
    EpiEvIn e{(bf16_t*)(ws + OFF_PN), (bf16_t*)(ws + OFF_PT), (float*)(ws + OFF_GATES), p.ev_gate_b};
    for (int rep = 0; rep < REP_G; ++rep) gemm_phase<128, 128, 64, false>(A, 1024, (const bf16_t*)(ws + OFF_W_EVIN), 1024, M, 4736, 1024, e, smem);
  }
  xcd_barrier(xb);
  for (int rep = 0; rep < REP_MIX; ++rep) s1_phase(p, smem);
  xcd_barrier(xb);
  s2_phase(p, smem);
  xcd_barrier(xb);
  for (int rep = 0; rep < REP_MIX; ++rep) s3_phase(p, smem);
  xcd_barrier(xb);
  {
    EpiResid e{p.x_prompt, p.x_sample, X, MOD + 2048};
    gemm_phase<128, 64, 64, false>((const bf16_t*)(p.out + OUT_AK), 1024, (const bf16_t*)(ws + OFF_W_EVOUT), 1024, M, 1024, 1024, e, smem);
  }
  xcd_barrier(xb);
  norm_phase(X, X + (size_t)MP * D, p.norm_ffn_g, MOD, 4096, 3072, A);
  xcd_barrier(xb);
  {
    EpiFFUp e{U};
    for (int rep = 0; rep < REP_G; ++rep) gemm_phase<128, 128, 64, false>(A, 1024, (const bf16_t*)(ws + OFF_W_FFU0), 1024, M, 5632, 1024, e, smem);
  }
  xcd_barrier(xb);
  {
    EpiResid e{X, X + (size_t)MP * D, X, MOD + 5120};
    gemm_phase<128, 128, 64, true>(U, DFF, (const bf16_t*)(ws + OFF_W_FFD0), DFF, M, 1024, DFF, e, smem);
  }
  xcd_barrier(xb);
  norm_phase(X, X + (size_t)MP * D, p.norm_mix_g + 1024, MOD + 3 * 6144, 1024, 0, A);
  xcd_barrier(xb);
  {
    EpiOdIn e{(bf16_t*)(ws + OFF_Q), (bf16_t*)(ws + OFF_KB), (bf16_t*)(ws + OFF_VT), p.out + OUT_AK, p.out + OUT_AV, (const float*)(ws + OFF_ROPE)};
    for (int rep = 0; rep < REP_G; ++rep) gemm_phase<128, 128, 64, false>(A, 1024, (const bf16_t*)(ws + OFF_W_ODIN), 1024, M, 3072, 1024, e, smem);
  }
  xcd_barrier(xb);
  for (int rep = 0; rep < REP_ATT; ++rep) attn_phase(p, smem);
  xcd_barrier(xb);
  {
    EpiResid e{X, X + (size_t)MP * D, X, MOD + 3 * 6144 + 2048};
    gemm_phase<128, 128, 64, true>((const bf16_t*)(ws + OFF_ATT), 1024, (const bf16_t*)(ws + OFF_W_ODOUT), 1024, M, 1024, 1024, e, smem);
  }
  xcd_barrier(xb);
  norm_phase(X, X + (size_t)MP * D, p.norm_ffn_g + 1024, MOD + 3 * 6144, 4096, 3072, A);
  xcd_barrier(xb);
  {
    EpiFFUp e{U};
    for (int rep = 0; rep < REP_G; ++rep) gemm_phase<128, 128, 64, false>(A, 1024, (const bf16_t*)(ws + OFF_W_FFU1), 1024, M, 5632, 1024, e, smem);
  }
  xcd_barrier(xb);
  {
    EpiResid e{X, X + (size_t)MP * D, X, MOD + 3 * 6144 + 5120};
    gemm_phase<128, 128, 64, true>(U, DFF, (const bf16_t*)(ws + OFF_W_FFD1), DFF, M, 1024, DFF, e, smem);
  }
  xcd_barrier(xb);
  final_norm_phase(X, p.final_norm_g);
}

extern "C" void kernel_launch(void* const* d_in, const int* in_sizes, int n_in, void* d_out, int out_size, void* d_ws, size_t ws_size, hipStream_t stream) {
  static int grid_blocks = 0;
  if (!grid_blocks) {
    int dev = 0, cus = 0, per_cu = 0;
    (void)hipGetDevice(&dev);
    (void)hipDeviceGetAttribute(&cus, hipDeviceAttributeMultiprocessorCount, dev);
    (void)hipOccupancyMaxActiveBlocksPerMultiprocessor(&per_cu, mega, 256, 0);
    per_cu = 2;
    grid_blocks = cus * per_cu;
    if (ws_size < WS_END) { fprintf(stderr, "kernel_launch: workspace too small: %zu < %zu\n", ws_size, (size_t)WS_END); grid_blocks = -1; }
  }
  if (grid_blocks < 0) return;
  (void)hipMemsetAsync((unsigned char*)d_ws + OFF_BAR, 0, 16384, stream);
  Params p{};
  const float** pp = (const float**)&p;
  for (int i = 0; i < 28; ++i) pp[i] = (const float*)d_in[i];
  p.out = (float*)d_out; p.ws = (unsigned char*)d_ws;
  void* args[] = {&p};
  hipError_t e = hipLaunchCooperativeKernel((void*)mega, dim3(grid_blocks), dim3(256), args, 0, stream);
  if (e != hipSuccess) fprintf(stderr, "cooperative launch failed: %s (grid %d)\n", hipGetErrorString(e), grid_blocks);
}
```

```cpp
#include <hip/hip_runtime.h>
#include <hip/hip_cooperative_groups.h>
#include <cstdio>
namespace cg = cooperative_groups;

typedef unsigned short bf16_t;
using bf16x8 = __attribute__((ext_vector_type(8))) short;
using f32x16 = __attribute__((ext_vector_type(16))) float;
#define DI __device__ __forceinline__
#define MFMA(a, b, c) __builtin_amdgcn_mfma_f32_32x32x16_bf16((a), (b), (c), 0, 0, 0)

constexpr int D = 1024;
constexpr int M = 12288;
constexpr int MP = 8192;
constexpr int DFF = 2816;
constexpr int PNW = 3584;
constexpr int SMEM_BYTES = 77824;
#ifndef REP_G
#define REP_G 1
#endif
#ifndef REP_P0
#define REP_P0 1
#endif
#ifndef REP_MIX
#define REP_MIX 1
#endif
#ifndef REP_ATT
#define REP_ATT 1
#endif

constexpr size_t OFF_W_EVIN = 0;
constexpr size_t OFF_W_EVOUT = OFF_W_EVIN + (size_t)4736 * 1024 * 2;
constexpr size_t OFF_W_FFU0 = OFF_W_EVOUT + (size_t)1024 * 1024 * 2;
constexpr size_t OFF_W_FFU1 = OFF_W_FFU0 + (size_t)5632 * 1024 * 2;
constexpr size_t OFF_W_FFD0 = OFF_W_FFU1 + (size_t)5632 * 1024 * 2;
constexpr size_t OFF_W_FFD1 = OFF_W_FFD0 + (size_t)1024 * 2816 * 2;
constexpr size_t OFF_W_ODIN = OFF_W_FFD1 + (size_t)1024 * 2816 * 2;
constexpr size_t OFF_W_ODOUT = OFF_W_ODIN + (size_t)3072 * 1024 * 2;
constexpr size_t OFF_MOD = OFF_W_ODOUT + (size_t)1024 * 1024 * 2;
constexpr size_t OFF_ROPE = OFF_MOD + (size_t)2 * 3 * 6144 * 4;
constexpr size_t OFF_MISC = OFF_ROPE + 8192;
constexpr size_t OFF_BAR = OFF_MISC + 256;
constexpr size_t OFF_GATES = OFF_BAR + 16384;
constexpr size_t OFF_KC = OFF_GATES + (size_t)M * 16 * 4;
constexpr size_t OFF_VCT = OFF_KC + (size_t)2 * 8 * 256 * 128 * 2;
constexpr size_t OFF_NLOC = OFF_VCT + (size_t)2 * 8 * 256 * 128 * 2;
constexpr size_t OFF_NINIT = OFF_NLOC + (size_t)1536 * 128 * 4;
constexpr size_t OFF_SCAL = OFF_NINIT + (size_t)1536 * 128 * 4;
constexpr size_t OFF_MINIT = OFF_SCAL + (size_t)1536 * 4 * 4;
constexpr size_t OFF_AL = OFF_MINIT + (size_t)1536 * 4;
constexpr size_t OFF_PN = OFF_AL + (size_t)1536 * 128 * 4;
constexpr size_t OFF_PT = OFF_PN + (size_t)M * PNW * 2;
constexpr size_t OFF_ST = OFF_PT + (size_t)1536 * M * 2;
constexpr size_t WS_END = OFF_ST + (size_t)1536 * 16384 * 2;
constexpr size_t OFF_A = OFF_ST;
constexpr size_t OFF_ATT = OFF_ST + (size_t)M * 1024 * 2;
constexpr size_t OFF_U = OFF_PN;
constexpr size_t OFF_Q = OFF_PN;
constexpr size_t OFF_KB = OFF_PN + (size_t)M * 1024 * 2;
constexpr size_t OFF_VT = OFF_PN + (size_t)2 * M * 1024 * 2;
constexpr size_t OUT_Y = 0;
constexpr size_t OUT_AK = (size_t)M * 1024;
constexpr size_t OUT_AV = OUT_AK + (size_t)MP * 1024;
constexpr size_t OUT_C = OUT_AV + (size_t)MP * 1024;
constexpr size_t OUT_N = OUT_C + (size_t)32 * 2 * 4 * 16384;
constexpr size_t OUT_M = OUT_N + (size_t)32 * 2 * 4 * 128;
constexpr size_t OUT_S = OUT_M + 256;

struct Params {
  const float *x_prompt, *x_sample, *c, *c_ctx, *cache_k, *cache_v, *st_C, *st_n, *st_m, *st_S;
  const float *ada_w, *ada_b, *norm_mix_g, *norm_ffn_g, *ev_w_in, *ev_gate_b, *ev_lb_logits, *ml_norm_g, *hg_norm_g;
  const float *ev_w_out, *od_w_in, *od_lambda, *da_norm_g, *od_w_out, *ffn_w1, *ffn_w3, *ffn_w2, *final_norm_g;
  float* out;
  unsigned char* ws;
};

typedef __bf16 bf16v2 __attribute__((ext_vector_type(2)));
typedef float f32v2 __attribute__((ext_vector_type(2)));
DI unsigned short f2bf(float x) { return __builtin_bit_cast(unsigned short, (__bf16)x); }
DI float bf2f(unsigned short h) { return __uint_as_float(((unsigned)h) << 16); }
DI unsigned pack2(float a, float b) { f32v2 v = {a, b}; return __builtin_bit_cast(unsigned, __builtin_convertvector(v, bf16v2)); }
DI uint2 pack4(float a, float b, float c, float d) { return make_uint2(pack2(a, b), pack2(c, d)); }
DI float lo_bf(unsigned u) { return __uint_as_float(u << 16); }
DI float hi_bf(unsigned u) { return __uint_as_float(u & 0xffff0000u); }
DI int crow(int reg, int h) { return (reg & 3) + 8 * (reg >> 2) + 4 * h; }
DI float wsum(float v) {
#pragma unroll
  for (int o = 32; o > 0; o >>= 1) v += __shfl_xor(v, o);
  return v;
}
DI float wmax(float v) {
#pragma unroll
  for (int o = 32; o > 0; o >>= 1) v = fmaxf(v, __shfl_xor(v, o));
  return v;
}
DI float logsig(float x) { return fminf(x, 0.f) - log1pf(expf(-fabsf(x))); }
DI float sigmoidf(float x) { return 1.f / (1.f + expf(-x)); }
DI f32x16 zero16() { f32x16 z;
#pragma unroll
  for (int i = 0; i < 16; ++i) z[i] = 0.f;
  return z; }
DI bf16x8 ld8(const bf16_t* p) { return *(const bf16x8*)p; }


#define XB_TMO      128
#define XB_XCNT(j)  (256  + 64 * (j))
#define XB_XSUB(j)  (1280 + 64 * (j))
#define XB_XGEN(j)  (2304 + 64 * (j))
#define XB_TOP      3328
#define XB_TOPGEN   3392
#define XCD_BAR_WORDS 3456
#define XB_SPIN_CAP (1u << 22)
#define LAS __attribute__((address_space(3)))
DI unsigned xb_ld(unsigned* p)              { return __hip_atomic_load(p, __ATOMIC_RELAXED, __HIP_MEMORY_SCOPE_AGENT); }
DI unsigned xb_add(unsigned* p, unsigned v) { return __hip_atomic_fetch_add(p, v, __ATOMIC_RELAXED, __HIP_MEMORY_SCOPE_AGENT); }
DI unsigned xb_xcc_id() { return (unsigned)__builtin_amdgcn_s_getreg((3 << 11) | 20) & 0xFu; }
#define XB_SPIN(cond, bar) do { unsigned _sp = 0; while (cond) { __builtin_amdgcn_s_sleep(1); \
    if ((++_sp & 255u) == 0u) { if (xb_ld(&(bar)[XB_TMO])) break; if (_sp > XB_SPIN_CAP) { atomicAdd(&(bar)[XB_TMO], 1u); break; } } } } while (0)
struct XcdBarrier { unsigned* bar; unsigned x; volatile LAS unsigned* st; };
DI XcdBarrier xcd_barrier_post(unsigned* bar, volatile LAS unsigned* st) {
  XcdBarrier b; b.bar = bar; b.x = xb_xcc_id(); b.st = st;
  if (threadIdx.x == 0) (void)xb_add(&bar[XB_XCNT(b.x)], 1u);
  return b;
}
DI void xcd_barrier_complete(unsigned* bar, unsigned x, unsigned& nloc, unsigned& nx) {
  const unsigned G = gridDim.x * gridDim.y * gridDim.z;
  unsigned sum, cnt, mine, sp = 0u;
  for (;;) {
    sum = 0u; cnt = 0u; mine = 0u;
#pragma unroll
    for (unsigned j = 0; j < 16; ++j) { const unsigned c = xb_ld(&bar[XB_XCNT(j)]); sum += c; cnt += (c > 0u) ? 1u : 0u; mine = (j == x) ? c : mine; }
    if (sum == G) break;
    __builtin_amdgcn_s_sleep(1);
    if ((++sp & 255u) == 0u) { if (xb_ld(&bar[XB_TMO])) break; if (sp > XB_SPIN_CAP) { atomicAdd(&bar[XB_TMO], 1u); break; } }
  }
  nloc = mine > 0u ? mine : 1u; nx = cnt > 0u ? cnt : 1u;
}
DI void xcd_barrier(const XcdBarrier& b) {
  asm volatile("s_waitcnt vmcnt(0)" ::: "memory");
  __syncthreads();
  if (threadIdx.x == 0) {
    unsigned* bar = b.bar;
    __builtin_amdgcn_s_waitcnt(0);
    unsigned nloc = b.st[0], nx = b.st[1];
    if (nloc == 0u) { xcd_barrier_complete(bar, b.x, nloc, nx); b.st[0] = nloc; b.st[1] = nx; }
    const unsigned old = xb_add(&bar[XB_XSUB(b.x)], 1u);
    const unsigned gen = old / nloc;
    if (old + 1u == (gen + 1u) * nloc) {
      __builtin_amdgcn_fence(__ATOMIC_RELEASE, "agent");
      asm volatile("s_waitcnt vmcnt(0)" ::: "memory");
      const unsigned og = xb_add(&bar[XB_TOP], 1u);
      const unsigned tg = og / nx;
      if (og + 1u == (tg + 1u) * nx) xb_add(&bar[XB_TOPGEN], 1u);
      else XB_SPIN(xb_ld(&bar[XB_TOPGEN]) == tg, bar);
      __builtin_amdgcn_fence(__ATOMIC_ACQUIRE, "agent");
      xb_add(&bar[XB_XGEN(b.x)], 1u);
      asm volatile("s_waitcnt vmcnt(0)" ::: "memory");
    } else {
      XB_SPIN(xb_ld(&bar[XB_XGEN(b.x)]) == gen, bar);
      __builtin_amdgcn_fence(__ATOMIC_ACQUIRE, "agent");
      asm volatile("s_waitcnt vmcnt(0)" ::: "memory");
    }
  }
  __syncthreads();
}

DI void load_tile_64x128(bf16_t* dst, const bf16_t* src, size_t ld) {
  const int tid = threadIdx.x;
#pragma unroll
  for (int i = 0; i < 4; ++i) { int c = tid + 256 * i; int row = c >> 4, ch = c & 15; *(uint4*)(dst + row * 136 + ch * 8) = *(const uint4*)(src + (size_t)row * ld + ch * 8); }
}
DI void load_tile_128x64(bf16_t* dst, const bf16_t* src, size_t ld) {
  const int tid = threadIdx.x;
#pragma unroll
  for (int i = 0; i < 4; ++i) { int c = tid + 256 * i; int row = c >> 3, ch = c & 7; *(uint4*)(dst + row * 72 + ch * 8) = *(const uint4*)(src + (size_t)row * ld + ch * 8); }
}

struct TDesc { const float* src0; const float* src1; bf16_t* dst; int srcN, K, kind, tn, tk; };
DI TDesc tdecode(const Params& p, int t) {
  TDesc d; d.src1 = nullptr;
  if (t < 1184) { d.src0 = p.ev_w_in; d.srcN = 4624; d.K = 1024; d.dst = (bf16_t*)(p.ws + OFF_W_EVIN); d.kind = 1; d.tn = t / 16; d.tk = t % 16; }
  else if (t < 1440) { t -= 1184; d.src0 = p.ev_w_out; d.srcN = 1024; d.K = 1024; d.dst = (bf16_t*)(p.ws + OFF_W_EVOUT); d.kind = 0; d.tn = t / 16; d.tk = t % 16; }
  else if (t < 4256) { t -= 1440; int l = t / 1408; t -= l * 1408; d.src0 = p.ffn_w1 + (size_t)l * 1024 * DFF; d.src1 = p.ffn_w3 + (size_t)l * 1024 * DFF; d.srcN = DFF; d.K = 1024;
    d.dst = (bf16_t*)(p.ws + (l ? OFF_W_FFU1 : OFF_W_FFU0)); d.kind = 2; d.tn = t / 16; d.tk = t % 16; }
  else if (t < 5664) { t -= 4256; int l = t / 704; t -= l * 704; d.src0 = p.ffn_w2 + (size_t)l * DFF * 1024; d.srcN = 1024; d.K = DFF;
    d.dst = (bf16_t*)(p.ws + (l ? OFF_W_FFD1 : OFF_W_FFD0)); d.kind = 0; d.tn = t / 44; d.tk = t % 44; }
  else if (t < 6432) { t -= 5664; d.src0 = p.od_w_in; d.srcN = 3072; d.K = 1024; d.dst = (bf16_t*)(p.ws + OFF_W_ODIN); d.kind = 0; d.tn = t / 16; d.tk = t % 16; }
  else { t -= 6432; d.src0 = p.od_w_out; d.srcN = 1024; d.K = 1024; d.dst = (bf16_t*)(p.ws + OFF_W_ODOUT); d.kind = 0; d.tn = t / 16; d.tk = t % 16; }
  return d;
}
DI void t_load(const TDesc& d, float4& v0, float4& v1, float4& v2, float4& v3) {
  const int tid = threadIdx.x; const int c4 = (tid & 15) * 4, kr = tid >> 4;
  const int n = d.tn * 64 + c4;
  const float* src = d.src0; int sc;
  if (d.kind == 0) sc = n;
  else if (d.kind == 1) sc = n < 2048 ? n : (n < 4608 ? n + 16 : (n < 4624 ? n - 4608 + 2048 : -1));
  else { int jb = n >> 6, r = n & 63; src = (r < 32) ? d.src0 : d.src1; sc = jb * 32 + (r & 31); }
  v0 = v1 = v2 = v3 = make_float4(0.f, 0.f, 0.f, 0.f);
  if (sc >= 0) {
    const float* b = src + (size_t)(d.tk * 64 + kr) * d.srcN + sc;
    v0 = *(const float4*)(b); v1 = *(const float4*)(b + (size_t)16 * d.srcN); v2 = *(const float4*)(b + (size_t)32 * d.srcN); v3 = *(const float4*)(b + (size_t)48 * d.srcN);
  }
}
DI void t_ldsw(float* lds, const float4& v0, const float4& v1, const float4& v2, const float4& v3) {
  const int tid = threadIdx.x; const int c4 = (tid & 15) * 4, kr = tid >> 4;
  float* d = lds + kr * 65 + c4;
  d[0] = v0.x; d[1] = v0.y; d[2] = v0.z; d[3] = v0.w;
  d[16 * 65] = v1.x; d[16 * 65 + 1] = v1.y; d[16 * 65 + 2] = v1.z; d[16 * 65 + 3] = v1.w;
  d[32 * 65] = v2.x; d[32 * 65 + 1] = v2.y; d[32 * 65 + 2] = v2.z; d[32 * 65 + 3] = v2.w;
  d[48 * 65] = v3.x; d[48 * 65 + 1] = v3.y; d[48 * 65 + 2] = v3.z; d[48 * 65 + 3] = v3.w;
}
DI void t_store(const TDesc& d, const float* lds) {
  const int tid = threadIdx.x; const int nn = tid >> 2, kq = (tid & 3) * 16;
  unsigned w[8];
#pragma unroll
  for (int j = 0; j < 8; ++j) w[j] = pack2(lds[(kq + 2 * j) * 65 + nn], lds[(kq + 2 * j + 1) * 65 + nn]);
  bf16_t* o = d.dst + (size_t)(d.tn * 64 + nn) * d.K + d.tk * 64 + kq;
  *(uint4*)o = make_uint4(w[0], w[1], w[2], w[3]);
  *(uint4*)(o + 8) = make_uint4(w[4], w[5], w[6], w[7]);
}

DI void mod_unit(const Params& p, int u, float* lds) {
  float* sil = lds; float* red = lds + 3072;
  float* MOD = (float*)(p.ws + OFF_MOD);
  const int tid = threadIdx.x;
  for (int i = tid; i < 3072; i += 256) { int j = i >> 10, k = i & 1023; float v = (j == 0) ? p.c_ctx[k] : p.c[(j - 1) * 1024 + k]; sil[i] = v / (1.f + expf(-v)); }
  __syncthreads();
  const int l = u / 48, cb = u % 48; const int cgp = tid & 31, kg = tid >> 5;
  const float* w = p.ada_w + (size_t)l * 1024 * 6144 + cb * 128 + cgp * 4;
  float a0x = 0, a0y = 0, a0z = 0, a0w = 0, a1x = 0, a1y = 0, a1z = 0, a1w = 0, a2x = 0, a2y = 0, a2z = 0, a2w = 0;
#pragma unroll 4
  for (int k = kg * 128; k < kg * 128 + 128; ++k) {
    float4 wv = *(const float4*)(w + (size_t)k * 6144);
    float s0 = sil[k], s1 = sil[1024 + k], s2 = sil[2048 + k];
    a0x += s0 * wv.x; a0y += s0 * wv.y; a0z += s0 * wv.z; a0w += s0 * wv.w;
    a1x += s1 * wv.x; a1y += s1 * wv.y; a1z += s1 * wv.z; a1w += s1 * wv.w;
    a2x += s2 * wv.x; a2y += s2 * wv.y; a2z += s2 * wv.z; a2w += s2 * wv.w;
  }
  float* r0 = red + (kg * 3 + 0) * 128 + cgp * 4; r0[0] = a0x; r0[1] = a0y; r0[2] = a0z; r0[3] = a0w;
  float* r1 = red + (kg * 3 + 1) * 128 + cgp * 4; r1[0] = a1x; r1[1] = a1y; r1[2] = a1z; r1[3] = a1w;
  float* r2 = red + (kg * 3 + 2) * 128 + cgp * 4; r2[0] = a2x; r2[1] = a2y; r2[2] = a2z; r2[3] = a2w;
  __syncthreads();
  for (int i = tid; i < 384; i += 256) {
    int j = i >> 7, cc = i & 127; float s = 0;
#pragma unroll
    for (int g = 0; g < 8; ++g) s += red[(g * 3 + j) * 128 + cc];
    s += p.ada_b[l * 6144 + cb * 128 + cc];
    MOD[(l * 3 + j) * 6144 + cb * 128 + cc] = s;
  }
  __syncthreads();
}

DI void phase0(const Params& p, unsigned char* smem) {
  float* lds = (float*)smem;
  const int tid = threadIdx.x;
  {
    int item = blockIdx.x;
    if (item < 96) { mod_unit(p, item, lds); item += gridDim.x; }
    float4 v0, v1, v2, v3;
    TDesc cur = tdecode(p, 0);
    bool have = item < 6784;
    if (have) { cur = tdecode(p, item - 96); t_load(cur, v0, v1, v2, v3); }
    while (have) {
      t_ldsw(lds, v0, v1, v2, v3);
      const int nitem = item + gridDim.x; const bool hn = nitem < 6784;
      TDesc nxt = cur;
      if (hn) { nxt = tdecode(p, nitem - 96); t_load(nxt, v0, v1, v2, v3); }
      __syncthreads();
      t_store(cur, lds);
      __syncthreads();
      cur = nxt; item = nitem; have = hn;
    }
  }
  for (int item = blockIdx.x; item < 7041; item += gridDim.x) {
    if (item < 6784) continue;
    int t = item - 96;
    t -= 6688;
    if (t < 256) {
      bf16_t* KC = (bf16_t*)(p.ws + OFF_KC); bf16_t* VCT = (bf16_t*)(p.ws + OFF_VCT);
#pragma unroll 4
      for (int j = 0; j < 16; ++j) {
        int idx = t * 4096 + j * 256 + tid;
        if (idx < 524288) { int d = idx & 127, key = (idx >> 7) & 255, h = (idx >> 15) & 7, b = idx >> 18;
          KC[idx] = f2bf(p.cache_k[((size_t)(b * 256 + key) * 8 + h) * 128 + d]); }
        else { int i2 = idx - 524288; int key = i2 & 255, dv = (i2 >> 8) & 127, h = (i2 >> 15) & 7, b = i2 >> 18;
          VCT[i2] = f2bf(p.cache_v[((size_t)(b * 256 + key) * 8 + h) * 128 + dv]); }
      }
      continue;
    }
    float* ROPE = (float*)(p.ws + OFF_ROPE); float* MISC = (float*)(p.ws + OFF_MISC);
    for (int idx = tid; idx < 1024; idx += 256) {
      int pos = idx >> 4, i = idx & 15;
      float inv = powf(10000.f, -(float)i / 16.f);
      float ang = (float)pos * inv;
      ROPE[idx * 2] = cosf(ang); ROPE[idx * 2 + 1] = sinf(ang);
    }
    if (tid == 0) {
      float s01 = 0, s23 = 0;
      for (int i = 0; i < 64; ++i) { s01 += p.od_lambda[i] * p.od_lambda[64 + i]; s23 += p.od_lambda[128 + i] * p.od_lambda[192 + i]; }
      const float lam_init = 0.8f - 0.6f * expf(-0.3f);
      MISC[0] = expf(s01) - expf(s23) + lam_init;
      MISC[1] = lam_init;
    }
  }
}

DI void norm_phase(const float* src_p, const float* src_s, const float* gain, const float* mod, int sc_off, int sh_off, bf16_t* A) {
  const int wave = threadIdx.x >> 6, lane = threadIdx.x & 63;
  for (int row = blockIdx.x * 4 + wave; row < M; row += gridDim.x * 4) {
    const float* src = row < MP ? src_p + (size_t)row * D : src_s + (size_t)(row - MP) * D;
    const int j = row < MP ? 0 : 1 + ((row - MP) >> 11);
    float4 v[4]; float ss = 0;
#pragma unroll
    for (int i = 0; i < 4; ++i) { v[i] = *(const float4*)(src + i * 256 + lane * 4); ss += v[i].x * v[i].x + v[i].y * v[i].y + v[i].z * v[i].z + v[i].w * v[i].w; }
    ss = wsum(ss);
    const float rstd = rsqrtf(ss * (1.f / 1024.f) + 1e-6f);
    const float* msc = mod + j * 6144 + sc_off; const float* msh = mod + j * 6144 + sh_off;
#pragma unroll
    for (int i = 0; i < 4; ++i) {
      int c = i * 256 + lane * 4;
      float4 g4 = *(const float4*)(gain + c), sc4 = *(const float4*)(msc + c), sh4 = *(const float4*)(msh + c);
      float o0 = v[i].x * rstd * g4.x * (1.f + sc4.x) + sh4.x;
      float o1 = v[i].y * rstd * g4.y * (1.f + sc4.y) + sh4.y;
      float o2 = v[i].z * rstd * g4.z * (1.f + sc4.z) + sh4.z;
      float o3 = v[i].w * rstd * g4.w * (1.f + sc4.w) + sh4.w;
      *(uint2*)(A + (size_t)row * D + c) = pack4(o0, o1, o2, o3);
    }
  }
}

DI void final_norm_phase(float* X, const float* gain) {
  const int wave = threadIdx.x >> 6, lane = threadIdx.x & 63;
  for (int row = blockIdx.x * 4 + wave; row < M; row += gridDim.x * 4) {
    float* src = X + (size_t)row * D;
    float4 v[4]; float ss = 0;
#pragma unroll
    for (int i = 0; i < 4; ++i) { v[i] = *(const float4*)(src + i * 256 + lane * 4); ss += v[i].x * v[i].x + v[i].y * v[i].y + v[i].z * v[i].z + v[i].w * v[i].w; }
    ss = wsum(ss);
    const float rstd = rsqrtf(ss * (1.f / 1024.f) + 1e-6f);
#pragma unroll
    for (int i = 0; i < 4; ++i) {
      int c = i * 256 + lane * 4;
      float4 g4 = *(const float4*)(gain + c);
      float4 o; o.x = v[i].x * rstd * g4.x; o.y = v[i].y * rstd * g4.y; o.z = v[i].z * rstd * g4.z; o.w = v[i].w * rstd * g4.w;
      *(float4*)(src + c) = o;
    }
  }
}

template <int BM, int BN, int BK, bool SPLIT, class Epi>
DI void gemm_phase(const bf16_t* __restrict__ A, int lda, const bf16_t* __restrict__ Bt, int ldb, int Mrows, int N, int K, const Epi& epi, unsigned char* smem) {
  constexpr int MI = BM / 64, NI = BN / 64;
  constexpr int LDK = BK + 8;
  constexpr int LDS_A = BM * LDK, LDS_B = BN * LDK;
  constexpr int CPR = BK / 8;
  constexpr int RPP = 256 / CPR;
  constexpr int NA = BM / RPP, NB = BN / RPP;
  bf16_t* As = (bf16_t*)smem;
  bf16_t* Bs = As + 2 * LDS_A;
  const int tid = threadIdx.x, lane = tid & 63, wave = tid >> 6, wm = wave >> 1, wn = wave & 1, lr = lane & 31, lh = lane >> 5;
  const int ntm = Mrows / BM, ntn = N / BN, nkfull = K / BK;
  const int lrow = tid / CPR, lch = tid % CPR;
  const int lofs = lrow * LDK + lch * 8;
  const bf16_t* as0 = As + (wm * (BM / 2) + lr) * LDK + lh * 8;
  const bf16_t* bs0 = Bs + (wn * (BN / 2) + lr) * LDK + lh * 8;
  const int ntiles = ntm * ntn;
  const int nfull = SPLIT ? ((int)gridDim.x < ntiles ? (int)gridDim.x : ntiles) : ntiles;
  const int nitems = SPLIT ? nfull + 2 * (ntiles - nfull) : ntiles;
  for (int item = blockIdx.x; item < nitems; item += gridDim.x) {
    int tile = item, kbeg = 0, nk = nkfull; bool part = false;
    if (SPLIT && item >= nfull) { tile = nfull + ((item - nfull) >> 1); nk = nkfull >> 1; kbeg = ((item - nfull) & 1) * nk; part = true; }
    const int tm = tile % ntm, tn = tile / ntm; const int m0 = tm * BM, n0 = tn * BN;
    f32x16 acc[MI][NI];
#pragma unroll
    for (int mi = 0; mi < MI; ++mi)
#pragma unroll
      for (int ni = 0; ni < NI; ++ni) acc[mi][ni] = zero16();
    static_assert(NA <= 4 && NB <= 4, "staging registers");
    uint4 a00, a01, a02, a03, b00, b01, b02, b03, a10, a11, a12, a13, b10, b11, b12, b13;
    a00 = a01 = a02 = a03 = b00 = b01 = b02 = b03 = a10 = a11 = a12 = a13 = b10 = b11 = b12 = b13 = make_uint4(0u, 0u, 0u, 0u);
    const bf16_t* Ag = A + (size_t)(m0 + lrow) * lda + lch * 8 + (size_t)kbeg * BK;
    const bf16_t* Bg = Bt + (size_t)(n0 + lrow) * ldb + lch * 8 + (size_t)kbeg * BK;
    if (NA > 0) a00 = *(const uint4*)(Ag + (size_t)(RPP * 0) * lda + (0) * BK);
    if (NA > 1) a01 = *(const uint4*)(Ag + (size_t)(RPP * 1) * lda + (0) * BK);
    if (NA > 2) a02 = *(const uint4*)(Ag + (size_t)(RPP * 2) * lda + (0) * BK);
    if (NA > 3) a03 = *(const uint4*)(Ag + (size_t)(RPP * 3) * lda + (0) * BK);
    if (NB > 0) b00 = *(const uint4*)(Bg + (size_t)(RPP * 0) * ldb + (0) * BK);
    if (NB > 1) b01 = *(const uint4*)(Bg + (size_t)(RPP * 1) * ldb + (0) * BK);
    if (NB > 2) b02 = *(const uint4*)(Bg + (size_t)(RPP * 2) * ldb + (0) * BK);
    if (NB > 3) b03 = *(const uint4*)(Bg + (size_t)(RPP * 3) * ldb + (0) * BK);
    if (NA > 0) a10 = *(const uint4*)(Ag + (size_t)(RPP * 0) * lda + (1) * BK);
    if (NA > 1) a11 = *(const uint4*)(Ag + (size_t)(RPP * 1) * lda + (1) * BK);
    if (NA > 2) a12 = *(const uint4*)(Ag + (size_t)(RPP * 2) * lda + (1) * BK);
    if (NA > 3) a13 = *(const uint4*)(Ag + (size_t)(RPP * 3) * lda + (1) * BK);
    if (NB > 0) b10 = *(const uint4*)(Bg + (size_t)(RPP * 0) * ldb + (1) * BK);
    if (NB > 1) b11 = *(const uint4*)(Bg + (size_t)(RPP * 1) * ldb + (1) * BK);
    if (NB > 2) b12 = *(const uint4*)(Bg + (size_t)(RPP * 2) * ldb + (1) * BK);
    if (NB > 3) b13 = *(const uint4*)(Bg + (size_t)(RPP * 3) * ldb + (1) * BK);
    if (NA > 0) *(uint4*)(As + (0) * LDS_A + lofs + RPP * 0 * LDK) = a00;
    if (NA > 1) *(uint4*)(As + (0) * LDS_A + lofs + RPP * 1 * LDK) = a01;
    if (NA > 2) *(uint4*)(As + (0) * LDS_A + lofs + RPP * 2 * LDK) = a02;
    if (NA > 3) *(uint4*)(As + (0) * LDS_A + lofs + RPP * 3 * LDK) = a03;
    if (NB > 0) *(uint4*)(Bs + (0) * LDS_B + lofs + RPP * 0 * LDK) = b00;
    if (NB > 1) *(uint4*)(Bs + (0) * LDS_B + lofs + RPP * 1 * LDK) = b01;
    if (NB > 2) *(uint4*)(Bs + (0) * LDS_B + lofs + RPP * 2 * LDK) = b02;
    if (NB > 3) *(uint4*)(Bs + (0) * LDS_B + lofs + RPP * 3 * LDK) = b03;
    __syncthreads();
    for (int kt = 0; kt < nk; kt += 2) {
      if (kt + 2 < nk) {
        if (NA > 0) a00 = *(const uint4*)(Ag + (size_t)(RPP * 0) * lda + (kt + 2) * BK);
        if (NA > 1) a01 = *(const uint4*)(Ag + (size_t)(RPP * 1) * lda + (kt + 2) * BK);
        if (NA > 2) a02 = *(const uint4*)(Ag + (size_t)(RPP * 2) * lda + (kt + 2) * BK);
        if (NA > 3) a03 = *(const uint4*)(Ag + (size_t)(RPP * 3) * lda + (kt + 2) * BK);
        if (NB > 0) b00 = *(const uint4*)(Bg + (size_t)(RPP * 0) * ldb + (kt + 2) * BK);
        if (NB > 1) b01 = *(const uint4*)(Bg + (size_t)(RPP * 1) * ldb + (kt + 2) * BK);
        if (NB > 2) b02 = *(const uint4*)(Bg + (size_t)(RPP * 2) * ldb + (kt + 2) * BK);
        if (NB > 3) b03 = *(const uint4*)(Bg + (size_t)(RPP * 3) * ldb + (kt + 2) * BK);
      }
      {
        const bf16_t* as = as0 + (0) * LDS_A; const bf16_t* bs = bs0 + (0) * LDS_B;
      #pragma unroll
        for (int ks = 0; ks < BK / 16; ++ks) {
          bf16x8 af[MI], bfr[NI];
      #pragma unroll
          for (int mi = 0; mi < MI; ++mi) af[mi] = ld8(as + mi * 32 * LDK + ks * 16);
      #pragma unroll
          for (int ni = 0; ni < NI; ++ni) bfr[ni] = ld8(bs + ni * 32 * LDK + ks * 16);
      #pragma unroll
          for (int mi = 0; mi < MI; ++mi)
      #pragma unroll
            for (int ni = 0; ni < NI; ++ni) acc[mi][ni] = MFMA(af[mi], bfr[ni], acc[mi][ni]);
        }
      }
      if (NA > 0) *(uint4*)(As + (1) * LDS_A + lofs + RPP * 0 * LDK) = a10;
      if (NA > 1) *(uint4*)(As + (1) * LDS_A + lofs + RPP * 1 * LDK) = a11;
      if (NA > 2) *(uint4*)(As + (1) * LDS_A + lofs + RPP * 2 * LDK) = a12;
      if (NA > 3) *(uint4*)(As + (1) * LDS_A + lofs + RPP * 3 * LDK) = a13;
      if (NB > 0) *(uint4*)(Bs + (1) * LDS_B + lofs + RPP * 0 * LDK) = b10;
      if (NB > 1) *(uint4*)(Bs + (1) * LDS_B + lofs + RPP * 1 * LDK) = b11;
      if (NB > 2) *(uint4*)(Bs + (1) * LDS_B + lofs + RPP * 2 * LDK) = b12;
      if (NB > 3) *(uint4*)(Bs + (1) * LDS_B + lofs + RPP * 3 * LDK) = b13;
      __syncthreads();
      if (kt + 3 < nk) {
        if (NA > 0) a10 = *(const uint4*)(Ag + (size_t)(RPP * 0) * lda + (kt + 3) * BK);
        if (NA > 1) a11 = *(const uint4*)(Ag + (size_t)(RPP * 1) * lda + (kt + 3) * BK);
        if (NA > 2) a12 = *(const uint4*)(Ag + (size_t)(RPP * 2) * lda + (kt + 3) * BK);
        if (NA > 3) a13 = *(const uint4*)(Ag + (size_t)(RPP * 3) * lda + (kt + 3) * BK);
        if (NB > 0) b10 = *(const uint4*)(Bg + (size_t)(RPP * 0) * ldb + (kt + 3) * BK);
        if (NB > 1) b11 = *(const uint4*)(Bg + (size_t)(RPP * 1) * ldb + (kt + 3) * BK);
        if (NB > 2) b12 = *(const uint4*)(Bg + (size_t)(RPP * 2) * ldb + (kt + 3) * BK);
        if (NB > 3) b13 = *(const uint4*)(Bg + (size_t)(RPP * 3) * ldb + (kt + 3) * BK);
      }
      {
        const bf16_t* as = as0 + (1) * LDS_A; const bf16_t* bs = bs0 + (1) * LDS_B;
      #pragma unroll
        for (int ks = 0; ks < BK / 16; ++ks) {
          bf16x8 af[MI], bfr[NI];
      #pragma unroll
          for (int mi = 0; mi < MI; ++mi) af[mi] = ld8(as + mi * 32 * LDK + ks * 16);
      #pragma unroll
          for (int ni = 0; ni < NI; ++ni) bfr[ni] = ld8(bs + ni * 32 * LDK + ks * 16);
      #pragma unroll
          for (int mi = 0; mi < MI; ++mi)
      #pragma unroll
            for (int ni = 0; ni < NI; ++ni) acc[mi][ni] = MFMA(af[mi], bfr[ni], acc[mi][ni]);
        }
      }
      if (kt + 2 < nk) {
        if (NA > 0) *(uint4*)(As + (0) * LDS_A + lofs + RPP * 0 * LDK) = a00;
        if (NA > 1) *(uint4*)(As + (0) * LDS_A + lofs + RPP * 1 * LDK) = a01;
        if (NA > 2) *(uint4*)(As + (0) * LDS_A + lofs + RPP * 2 * LDK) = a02;
        if (NA > 3) *(uint4*)(As + (0) * LDS_A + lofs + RPP * 3 * LDK) = a03;
        if (NB > 0) *(uint4*)(Bs + (0) * LDS_B + lofs + RPP * 0 * LDK) = b00;
        if (NB > 1) *(uint4*)(Bs + (0) * LDS_B + lofs + RPP * 1 * LDK) = b01;
        if (NB > 2) *(uint4*)(Bs + (0) * LDS_B + lofs + RPP * 2 * LDK) = b02;
        if (NB > 3) *(uint4*)(Bs + (0) * LDS_B + lofs + RPP * 3 * LDK) = b03;
      }
      __syncthreads();
    }
    epi.template run<MI, NI>(acc, m0 + wm * (BM / 2), n0 + wn * (BN / 2), lr, lh, part);
  }
}

struct EpiEvIn {
  bf16_t* PN; bf16_t* PT; float* gates; const float* gate_b;
  template <int MI, int NI> DI void run(f32x16 (&acc)[MI][NI], int rbase, int cbase, int lr, int lh, bool part) const {
#pragma unroll
    for (int ni = 0; ni < NI; ++ni) {
      const int col = cbase + ni * 32 + lr; const int seg = col >> 9, cc = col & 511;
      int nat = -1, tr = -1; float scale = 1.f;
      switch (seg) {
        case 0: nat = 0; scale = 0.08838834764831845f; break;
        case 1: nat = 512; tr = 0; break;
        case 2: tr = 512; break;
        case 3: nat = 1024; break;
        case 4: nat = 1536; break;
        case 5: nat = 2048; break;
        case 6: nat = 2560; break;
        case 7: tr = 1024; break;
        case 8: nat = 3072; break;
        default: break;
      }
#pragma unroll
      for (int mi = 0; mi < MI; ++mi)
#pragma unroll
        for (int g = 0; g < 4; ++g) {
          const int row = rbase + mi * 32 + 8 * g + 4 * lh;
          float v0 = acc[mi][ni][4 * g] * scale, v1 = acc[mi][ni][4 * g + 1] * scale, v2 = acc[mi][ni][4 * g + 2] * scale, v3 = acc[mi][ni][4 * g + 3] * scale;
          if (seg == 9) {
            if (cc < 16) { float b = gate_b[cc];
              gates[(size_t)row * 16 + cc] = v0 + b; gates[(size_t)(row + 1) * 16 + cc] = v1 + b; gates[(size_t)(row + 2) * 16 + cc] = v2 + b; gates[(size_t)(row + 3) * 16 + cc] = v3 + b; }
          } else {
            if (nat >= 0) { bf16_t* d = PN + (size_t)row * PNW + nat + cc; d[0] = f2bf(v0); d[PNW] = f2bf(v1); d[2 * PNW] = f2bf(v2); d[3 * PNW] = f2bf(v3); }
            if (tr >= 0) *(uint2*)(PT + (size_t)(tr + cc) * M + row) = pack4(v0, v1, v2, v3);
          }
        }
    }
  }
};

struct EpiResid {
  const float* xin_p; const float* xin_s; float* X; const float* gmod;
  template <int MI, int NI> DI void run(f32x16 (&acc)[MI][NI], int rbase, int cbase, int lr, int lh, bool part) const {
#pragma unroll
    for (int ni = 0; ni < NI; ++ni) {
      const int col = cbase + ni * 32 + lr;
#pragma unroll
      for (int mi = 0; mi < MI; ++mi) {
        const int r0 = rbase + mi * 32; const int j = r0 < MP ? 0 : 1 + ((r0 - MP) >> 11);
        const float gv = gmod[j * 6144 + col];
#pragma unroll
        for (int gg = 0; gg < 4; ++gg) {
          const int row = rbase + mi * 32 + 8 * gg + 4 * lh;
          const float* xi = (row < MP ? xin_p + (size_t)row * D : xin_s + (size_t)(row - MP) * D) + col;
          float* xo = X + (size_t)row * D + col;
#pragma unroll
          for (int e = 0; e < 4; ++e) {
            if (part) atomicAdd(xo + (size_t)e * D, gv * acc[mi][ni][4 * gg + e]);
            else xo[(size_t)e * D] = xi[(size_t)e * D] + gv * acc[mi][ni][4 * gg + e];
          }
        }
      }
    }
  }
};

struct EpiFFUp {
  bf16_t* U;
  template <int MI, int NI> DI void run(f32x16 (&acc)[MI][NI], int rbase, int cbase, int lr, int lh, bool part) const {
    static_assert(NI == 2, "ffn up needs paired tiles");
    const int oc = (cbase >> 6) * 32 + lr;
#pragma unroll
    for (int mi = 0; mi < MI; ++mi)
#pragma unroll
      for (int g = 0; g < 4; ++g) {
        const int row = rbase + mi * 32 + 8 * g + 4 * lh;
#pragma unroll
        for (int e = 0; e < 4; ++e) {
          float a1 = acc[mi][0][4 * g + e], a3 = acc[mi][1][4 * g + e];
          U[(size_t)(row + e) * DFF + oc] = f2bf(a1 * __frcp_rn(1.f + __expf(-a1)) * a3);
        }
      }
  }
};

struct EpiOdIn {
  bf16_t* Q; bf16_t* Kb; bf16_t* VT; float* AK; float* AV; const float* rope;
  template <int MI, int NI> DI void run(f32x16 (&acc)[MI][NI], int rbase, int cbase, int lr, int lh, bool part) const {
#pragma unroll
    for (int ni = 0; ni < NI; ++ni) {
      const int col = cbase + ni * 32 + lr; const int seg = col >> 10, cc = col & 1023; const int d = col & 127;
#pragma unroll
      for (int mi = 0; mi < MI; ++mi)
#pragma unroll
        for (int g = 0; g < 4; ++g) {
          const bool sample = (rbase + mi * 32) >= MP;
          const int row = rbase + mi * 32 + 8 * g + 4 * lh;
          float v[4];
#pragma unroll
          for (int e = 0; e < 4; ++e) v[e] = acc[mi][ni][4 * g + e];
          if (seg < 2) {
            if (sample) {
#pragma unroll
              for (int e = 0; e < 4; ++e) {
                float pv = __shfl_xor(v[e], 16);
                int n = (row + e - MP) & 2047; int pos = (d & 32) ? (n & 63) : (n >> 6);
                float2 cs = *(const float2*)(rope + (pos * 16 + (d & 15)) * 2);
                v[e] = (d & 16) ? (pv * cs.y + v[e] * cs.x) : (v[e] * cs.x - pv * cs.y);
              }
            }
            if (seg == 0) {
#pragma unroll
              for (int e = 0; e < 4; ++e) Q[(size_t)(row + e) * 1024 + cc] = f2bf(v[e] * 0.18033688011112042f);
            } else {
#pragma unroll
              for (int e = 0; e < 4; ++e) Kb[(size_t)(row + e) * 1024 + cc] = f2bf(v[e]);
              if (!sample) {
#pragma unroll
                for (int e = 0; e < 4; ++e) AK[(size_t)(row + e) * 1024 + cc] = v[e];
              }
            }
          } else {
            *(uint2*)(VT + (size_t)cc * M + row) = pack4(v[0], v[1], v[2], v[3]);
            if (!sample) {
#pragma unroll
              for (int e = 0; e < 4; ++e) AV[(size_t)(row + e) * 1024 + cc] = v[e];
            }
          }
        }
    }
  }
};

DI void s1_phase(const Params& p, unsigned char* smem) {
  bf16_t* Vt = (bf16_t*)smem;
  bf16_t* Ktf = Vt + 128 * 72;
  bf16_t* Ktb = Ktf + 128 * 72;
  float* wgf = (float*)(Ktb + 128 * 72);
  float* wgb = wgf + 64;
  const bf16_t* PN = (const bf16_t*)(p.ws + OFF_PN);
  const bf16_t* PT = (const bf16_t*)(p.ws + OFF_PT);
  const float* GATES = (const float*)(p.ws + OFF_GATES);
  float* SCAL = (float*)(p.ws + OFF_SCAL);
  float* NLOC = (float*)(p.ws + OFF_NLOC);
  float* AL = (float*)(p.ws + OFF_AL);
  bf16_t* MLST = (bf16_t*)(p.ws + OFF_ST);
  bf16_t* HGST = (bf16_t*)(p.out);
  const int tid = threadIdx.x, lane = tid & 63, wave = tid >> 6, lr = lane & 31, lh = lane >> 5;
  for (int item = blockIdx.x; item < 1536; item += gridDim.x) {
    const int kind = item >= 768; const int it = item - kind * 768; const int gc = it >> 2, h = it & 3; const int tok0 = gc * 64;
    const int slot0 = it * 2;
    if (kind == 0) {
      load_tile_128x64(Vt, PT + (size_t)(512 + h * 128) * M + tok0, M);
      uint4 rk[4];
      const bf16_t* PTk = PT + (size_t)(h * 128) * M + tok0;
#pragma unroll
      for (int i = 0; i < 4; ++i) { int c = tid + 256 * i; rk[i] = *(const uint4*)(PTk + (size_t)(c >> 3) * M + (c & 7) * 8); }
      if (wave == 0) {
        const float* gp = GATES + (size_t)(tok0 + lane) * 16;
        float igf = gp[h], igb = gp[4 + h], lff = logsig(gp[8 + h]), lfb = logsig(gp[12 + h]);
        float bfw = lff;
#pragma unroll
        for (int o = 1; o < 64; o <<= 1) { float t = __shfl_up(bfw, o); if (lane >= o) bfw += t; }
        float blf = __shfl(bfw, 63);
        float gf = blf - bfw + igf; float mlocf = wmax(gf); wgf[lane] = expf(gf - mlocf);
        float bbw = lfb;
#pragma unroll
        for (int o = 1; o < 64; o <<= 1) { float t = __shfl_down(bbw, o); if (lane + o < 64) bbw += t; }
        float blb = __shfl(bbw, 0);
        float gb = blb - bbw + igb; float mlocb = wmax(gb); wgb[lane] = expf(gb - mlocb);
        if (lane == 0) { SCAL[slot0 * 4 + 0] = blf; SCAL[slot0 * 4 + 1] = mlocf; SCAL[(slot0 + 1) * 4 + 0] = blb; SCAL[(slot0 + 1) * 4 + 1] = mlocb; }
      }
      __syncthreads();
#pragma unroll
      for (int i = 0; i < 4; ++i) {
        int c = tid + 256 * i; int row = c >> 3, ch = c & 7;
        unsigned w[4] = {rk[i].x, rk[i].y, rk[i].z, rk[i].w};
        unsigned of[4], ob[4];
#pragma unroll
        for (int q = 0; q < 4; ++q) {
          float k0 = lo_bf(w[q]), k1 = hi_bf(w[q]);
          int t = ch * 8 + q * 2;
          of[q] = pack2(k0 * wgf[t], k1 * wgf[t + 1]); ob[q] = pack2(k0 * wgb[t], k1 * wgb[t + 1]);
        }
        *(uint4*)(Ktf + row * 72 + ch * 8) = make_uint4(of[0], of[1], of[2], of[3]);
        *(uint4*)(Ktb + row * 72 + ch * 8) = make_uint4(ob[0], ob[1], ob[2], ob[3]);
      }
    } else {
      bf16_t* Xf = Vt;
      bf16_t* Xb = (bf16_t*)(smem + 55808);
      load_tile_64x128(Xf, PN + (size_t)tok0 * PNW + 2048 + h * 128, PNW);
      load_tile_64x128(Xb, PN + (size_t)tok0 * PNW + 2560 + h * 128, PNW);
      __syncthreads();
      const int dir = tid >> 7, dk = tid & 127; const int ch = h * 128 + dk;
      const float lb = 1.f / (1.f + expf(p.ev_lb_logits[512 + ch] - p.ev_lb_logits[ch]));
      const bf16_t* xs = dir ? Xb : Xf;
      bf16_t* Kt = dir ? Ktb : Ktf;
      float R = 1.f;
#pragma unroll 2
      for (int s = 0; s < 64; ++s) {
        int t = dir ? s : 63 - s;
        float x = bf2f(xs[t * 136 + dk]); float f = lb + (1.f - lb) * __frcp_rn(1.f + __expf(-x));
        Kt[dk * 72 + t] = f2bf((1.f - f) * R); R *= f;
      }
      AL[(slot0 + dir) * 128 + dk] = R;
      __syncthreads();
      load_tile_128x64(Vt, PT + (size_t)(1024 + h * 128) * M + tok0, M);
    }
    __syncthreads();
    bf16_t* ST = kind ? HGST : MLST;
#pragma unroll 1
    for (int dir = 0; dir < 2; ++dir) {
      const bf16_t* Kt = dir ? Ktb : Ktf;
      f32x16 acc[4];
#pragma unroll
      for (int ni = 0; ni < 4; ++ni) acc[ni] = zero16();
#pragma unroll
      for (int ks = 0; ks < 4; ++ks) {
        bf16x8 a = ld8(Kt + (wave * 32 + lr) * 72 + ks * 16 + lh * 8);
#pragma unroll
        for (int ni = 0; ni < 4; ++ni) { bf16x8 b = ld8(Vt + (ni * 32 + lr) * 72 + ks * 16 + lh * 8); acc[ni] = MFMA(a, b, acc[ni]); }
      }
      bf16_t* dst = ST + (size_t)(slot0 + dir) * 16384;
#pragma unroll
      for (int ni = 0; ni < 4; ++ni)
#pragma unroll
        for (int g = 0; g < 4; ++g)
          *(uint2*)(dst + (ni * 32 + lr) * 128 + wave * 32 + 8 * g + 4 * lh) = pack4(acc[ni][4 * g], acc[ni][4 * g + 1], acc[ni][4 * g + 2], acc[ni][4 * g + 3]);
    }
    if (kind == 0) {
      const int dir = tid >> 7, dk = tid & 127; const bf16_t* Kt = dir ? Ktb : Ktf; float s = 0.f;
#pragma unroll 8
      for (int t = 0; t < 64; ++t) s += bf2f(Kt[dk * 72 + t]);
      NLOC[(slot0 + dir) * 128 + dk] = s;
    }
    __syncthreads();
  }
}

DI void s2_phase(const Params& p, unsigned char* smem) {
  const float* __restrict__ SCAL = (const float*)(p.ws + OFF_SCAL);
  float* __restrict__ MINIT = (float*)(p.ws + OFF_MINIT);
  const float* __restrict__ NLOC = (const float*)(p.ws + OFF_NLOC);
  float* __restrict__ NINIT = (float*)(p.ws + OFF_NINIT);
  const float* __restrict__ AL = (const float*)(p.ws + OFF_AL);
  bf16_t* MLST = (bf16_t*)(p.ws + OFF_ST);
  bf16_t* HGST = (bf16_t*)(p.out);
  float* tl = (float*)smem;
  const int tid = threadIdx.x;
  for (int u = blockIdx.x; u < 4352; u += gridDim.x) {
    int kind, sample, seq, h, dir, slab;
    if (u < 256) { kind = u >> 7; int v = u & 127; slab = v & 7; v >>= 3; dir = v & 1; v >>= 1; h = v & 3; seq = v >> 2; sample = 1; }
    else { int v = u - 256; kind = v >= 2048; v -= kind * 2048; slab = v & 7; v >>= 3; dir = v & 1; v >>= 1; h = v & 3; seq = v >> 2; sample = 0; }
    const int nc = sample ? 32 : 4; const int gc0 = sample ? 128 + seq * 32 : seq * 4;
    bf16_t* ST = kind ? HGST : MLST;
    const int e = slab * 2048 + tid * 8; const int dv = e >> 7, dk0 = e & 127;
    float st[8]; float nst = 0.f, m = 0.f;
    const int sidx = (seq * 2 + dir) * 4 + h;
    if (sample) {
      const float* S0 = (kind ? p.st_S : p.st_C) + (size_t)sidx * 16384;
#pragma unroll
      for (int j = 0; j < 8; ++j) st[j] = S0[(dk0 + j) * 128 + dv];
      if (kind == 0) { m = p.st_m[sidx]; if (slab == 0 && tid < 128) nst = p.st_n[sidx * 128 + tid]; }
    } else {
#pragma unroll
      for (int j = 0; j < 8; ++j) st[j] = 0.f;
    }
    const int slot0 = ((gc0 + (dir ? nc - 1 : 0)) * 4 + h) * 2 + dir;
    const int sstep = dir ? -8 : 8;
    uint4 Lq[4]; float4 Aq0[4], Aq1[4]; float2 Sq[4]; float Nq[4];
    const bool nthr = (kind == 0) && (slab == 0) && (tid < 128);
#pragma unroll
    for (int i = 0; i < 4; ++i) {
      const int sl = slot0 + i * sstep;
      Lq[i] = *(const uint4*)(ST + (size_t)sl * 16384 + e);
      Aq0[i] = make_float4(0.f, 0.f, 0.f, 0.f); Aq1[i] = Aq0[i]; Sq[i] = make_float2(0.f, 0.f); Nq[i] = 0.f;
      if (kind) { Aq0[i] = *(const float4*)(AL + sl * 128 + dk0); Aq1[i] = *(const float4*)(AL + sl * 128 + dk0 + 4); }
      else { Sq[i] = *(const float2*)(SCAL + sl * 4); if (nthr) Nq[i] = NLOC[sl * 128 + tid]; }
    }
    for (int ps = 0; ps < nc; ps += 4) {
#pragma unroll
      for (int i = 0; i < 4; ++i) {
        const int slot = slot0 + (ps + i) * sstep;
        const uint4 Lc = Lq[i];
        float dec[8]; float ls;
        if (kind == 0) {
          const float bl = Sq[i].x, mloc = Sq[i].y; const float mn = fmaxf(bl + m, mloc); const float d = __expf(bl + m - mn); ls = __expf(mloc - mn);
#pragma unroll
          for (int j = 0; j < 8; ++j) dec[j] = d;
          if (slab == 0) { if (tid == 0) MINIT[slot] = m; if (tid < 128) { NINIT[slot * 128 + tid] = nst; nst = d * nst + ls * Nq[i]; } }
          m = mn;
        } else {
          ls = 1.f;
          dec[0] = Aq0[i].x; dec[1] = Aq0[i].y; dec[2] = Aq0[i].z; dec[3] = Aq0[i].w;
          dec[4] = Aq1[i].x; dec[5] = Aq1[i].y; dec[6] = Aq1[i].z; dec[7] = Aq1[i].w;
        }
        *(uint4*)(ST + (size_t)slot * 16384 + e) = make_uint4(pack2(st[0], st[1]), pack2(st[2], st[3]), pack2(st[4], st[5]), pack2(st[6], st[7]));
        float l[8] = {lo_bf(Lc.x), hi_bf(Lc.x), lo_bf(Lc.y), hi_bf(Lc.y), lo_bf(Lc.z), hi_bf(Lc.z), lo_bf(Lc.w), hi_bf(Lc.w)};
#pragma unroll
        for (int j = 0; j < 8; ++j) st[j] = dec[j] * st[j] + ls * l[j];
        if (ps + i + 4 < nc) {
          const int sl = slot + 4 * sstep;
          Lq[i] = *(const uint4*)(ST + (size_t)sl * 16384 + e);
          if (kind) { Aq0[i] = *(const float4*)(AL + sl * 128 + dk0); Aq1[i] = *(const float4*)(AL + sl * 128 + dk0 + 4); }
          else { Sq[i] = *(const float2*)(SCAL + sl * 4); if (nthr) Nq[i] = NLOC[sl * 128 + tid]; }
        }
      }
    }
    if (!sample) {
#pragma unroll
      for (int j = 0; j < 8; ++j) tl[(dk0 + j) * 17 + (dv & 15)] = st[j];
      __syncthreads();
      float* Co = p.out + (kind ? OUT_S : OUT_C) + (size_t)sidx * 16384;
      const int dkr = tid >> 1, hf = tid & 1;
      float4 o0, o1;
      o0.x = tl[dkr * 17 + hf * 8 + 0]; o0.y = tl[dkr * 17 + hf * 8 + 1]; o0.z = tl[dkr * 17 + hf * 8 + 2]; o0.w = tl[dkr * 17 + hf * 8 + 3];
      o1.x = tl[dkr * 17 + hf * 8 + 4]; o1.y = tl[dkr * 17 + hf * 8 + 5]; o1.z = tl[dkr * 17 + hf * 8 + 6]; o1.w = tl[dkr * 17 + hf * 8 + 7];
      *(float4*)(Co + dkr * 128 + slab * 16 + hf * 8) = o0;
      *(float4*)(Co + dkr * 128 + slab * 16 + hf * 8 + 4) = o1;
      if (kind == 0 && slab == 0) { if (tid < 128) p.out[OUT_N + sidx * 128 + tid] = nst; if (tid == 0) p.out[OUT_M + sidx] = m; }
      __syncthreads();
    }
  }
}

DI void s3_epilogue(const float* Hs, const float* gain, const bf16_t* gate_src, bf16_t* mix_dst, bool use_silu) {
  const int tid = threadIdx.x, t = tid >> 2, part = tid & 3;
  const float* hr = Hs + t * 132 + part * 32;
  float ss = 0.f;
#pragma unroll
  for (int i = 0; i < 8; ++i) { float4 v = *(const float4*)(hr + i * 4); ss += v.x * v.x + v.y * v.y + v.z * v.z + v.w * v.w; }
  ss += __shfl_xor(ss, 1); ss += __shfl_xor(ss, 2);
  const float rstd = rsqrtf(ss * (1.f / 128.f) + 1e-6f);
#pragma unroll
  for (int i = 0; i < 8; ++i) {
    const int d = part * 32 + i * 4;
    float4 v = *(const float4*)(hr + i * 4); float4 g4 = *(const float4*)(gain + d);
    uint2 gs = *(const uint2*)(gate_src + (size_t)t * PNW + d);
    float x0 = lo_bf(gs.x), x1 = hi_bf(gs.x), x2 = lo_bf(gs.y), x3 = hi_bf(gs.y);
    float s0 = __frcp_rn(1.f + __expf(-x0)), s1 = __frcp_rn(1.f + __expf(-x1)), s2 = __frcp_rn(1.f + __expf(-x2)), s3 = __frcp_rn(1.f + __expf(-x3));
    if (use_silu) { s0 *= x0; s1 *= x1; s2 *= x2; s3 *= x3; }
    *(uint2*)(mix_dst + (size_t)t * 1024 + d) = pack4(v.x * rstd * g4.x * s0, v.y * rstd * g4.y * s1, v.z * rstd * g4.z * s2, v.w * rstd * g4.w * s3);
  }
}

DI void s3_phase(const Params& p, unsigned char* smem) {
  const bf16_t* PN = (const bf16_t*)(p.ws + OFF_PN);
  const bf16_t* PT = (const bf16_t*)(p.ws + OFF_PT);
  const float* GATES = (const float*)(p.ws + OFF_GATES);
  const float* SCAL = (const float*)(p.ws + OFF_SCAL);
  const float* NINIT = (const float*)(p.ws + OFF_NINIT);
  const float* MINIT = (const float*)(p.ws + OFF_MINIT);
  const bf16_t* MLST = (const bf16_t*)(p.ws + OFF_ST);
  const bf16_t* HGST = (const bf16_t*)(p.out);
  bf16_t* MIX = (bf16_t*)(p.out + OUT_AK);
  const int tid = threadIdx.x, lane = tid & 63, wave = tid >> 6, lr = lane & 31, lh = lane >> 5, wm = wave >> 1, wn = wave & 1;
  float* Hs = (float*)smem;
  for (int item = blockIdx.x; item < 1536; item += gridDim.x) {
    const int kind = item >= 768; const int it = item - kind * 768; const int gc = it >> 2, h = it & 3; const int tok0 = gc * 64;
    const int slotf = it * 2, slotb = it * 2 + 1;
    if (kind == 0) {
      bf16_t* Qs = (bf16_t*)smem;
      bf16_t* Ks = Qs + 64 * 136;
      bf16_t* Vt = Ks + 64 * 136;
      bf16_t* Pf = Vt + 128 * 72;
      bf16_t* Pb = Pf + 64 * 72;
      float* fa = (float*)(Pb + 64 * 72);
      float* rF = fa, *cF = fa + 64, *wF = fa + 128, *mtF = fa + 192, *rB = fa + 256, *cB = fa + 320, *wB = fa + 384, *mtB = fa + 448;
      float* facPf = fa + 512, *facPb = fa + 576, *facIf = fa + 640, *facIb = fa + 704;
      float* nF = fa + 768, *nB = fa + 896, *qnF = fa + 1024, *qnB = fa + 1088;
      load_tile_64x128(Qs, PN + (size_t)tok0 * PNW + h * 128, PNW);
      load_tile_64x128(Ks, PN + (size_t)tok0 * PNW + 512 + h * 128, PNW);
      load_tile_128x64(Vt, PT + (size_t)(512 + h * 128) * M + tok0, M);
      if (wave == 0) {
        const float* gp = GATES + (size_t)(tok0 + lane) * 16;
        float igf = gp[h], igb = gp[4 + h], lff = logsig(gp[8 + h]), lfb = logsig(gp[12 + h]);
        float bfw = lff;
#pragma unroll
        for (int o = 1; o < 64; o <<= 1) { float t = __shfl_up(bfw, o); if (lane >= o) bfw += t; }
        float cf = igf - bfw; float pm = cf;
#pragma unroll
        for (int o = 1; o < 64; o <<= 1) { float t = __shfl_up(pm, o); if (lane >= o) pm = fmaxf(pm, t); }
        float mF = MINIT[slotf];
        float interF = bfw + mF; float mt = fmaxf(interF, bfw + pm);
        rF[lane] = bfw - mt; cF[lane] = cf; wF[lane] = expf(interF - mt); mtF[lane] = mt;
        float bbw = lfb;
#pragma unroll
        for (int o = 1; o < 64; o <<= 1) { float t = __shfl_down(bbw, o); if (lane + o < 64) bbw += t; }
        float cb = igb - bbw; float sm = cb;
#pragma unroll
        for (int o = 1; o < 64; o <<= 1) { float t = __shfl_down(sm, o); if (lane + o < 64) sm = fmaxf(sm, t); }
        float mB = MINIT[slotb];
        float interB = bbw + mB; float mt2 = fmaxf(interB, bbw + sm);
        rB[lane] = bbw - mt2; cB[lane] = cb; wB[lane] = expf(interB - mt2); mtB[lane] = mt2;
      }
      if (wave >= 2) { int i = tid - 128; nF[i] = NINIT[slotf * 128 + i]; nB[i] = NINIT[slotb * 128 + i]; }
      __syncthreads();
      {
        f32x16 s = zero16();
#pragma unroll
        for (int ks = 0; ks < 8; ++ks) { bf16x8 a = ld8(Qs + (wm * 32 + lr) * 136 + ks * 16 + lh * 8); bf16x8 b = ld8(Ks + (wn * 32 + lr) * 136 + ks * 16 + lh * 8); s = MFMA(a, b, s); }
        const int sidx = wn * 32 + lr; const float cfs = cF[sidx], cbs = cB[sidx];
#pragma unroll
        for (int i = 0; i < 16; ++i) {
          const int t = wm * 32 + crow(i, lh);
          float pf = (sidx <= t) ? s[i] * __expf(rF[t] + cfs) : 0.f;
          float pb = (sidx >= t) ? s[i] * __expf(rB[t] + cbs) : 0.f;
          Pf[t * 72 + sidx] = f2bf(pf); Pb[t * 72 + sidx] = f2bf(pb);
        }
        const int t = tid >> 2, part = tid & 3; float sf = 0.f, sb = 0.f;
#pragma unroll 8
        for (int d = part * 32; d < part * 32 + 32; ++d) { float q = bf2f(Qs[t * 136 + d]); sf += q * nF[d]; sb += q * nB[d]; }
        sf += __shfl_xor(sf, 1); sf += __shfl_xor(sf, 2); sb += __shfl_xor(sb, 1); sb += __shfl_xor(sb, 2);
        if (part == 0) { qnF[t] = sf; qnB[t] = sb; }
      }
      __syncthreads();
      {
        const int t = tid >> 2, part = tid & 3; float sf = 0.f, sb = 0.f;
#pragma unroll
        for (int j = 0; j < 16; ++j) { sf += bf2f(Pf[t * 72 + part * 16 + j]); sb += bf2f(Pb[t * 72 + part * 16 + j]); }
        sf += __shfl_xor(sf, 1); sf += __shfl_xor(sf, 2); sb += __shfl_xor(sb, 1); sb += __shfl_xor(sb, 2);
        if (part == 0) {
          float denf = wF[t] * qnF[t] + sf; float Nf = fmaxf(fabsf(denf), expf(-mtF[t])); facPf[t] = 1.f / Nf; facIf[t] = wF[t] / Nf;
          float denb = wB[t] * qnB[t] + sb; float Nb = fmaxf(fabsf(denb), expf(-mtB[t])); facPb[t] = 1.f / Nb; facIb[t] = wB[t] / Nb;
        }
      }
      __syncthreads();
      f32x16 hacc[2]; hacc[0] = zero16(); hacc[1] = zero16();
#pragma unroll
      for (int pd = 0; pd < 2; ++pd) {
        __builtin_amdgcn_sched_barrier(0);
        const bf16_t* Pm = pd ? Pb : Pf; const float* fac = pd ? facPb : facPf;
        f32x16 t0[2]; t0[0] = zero16(); t0[1] = zero16();
#pragma unroll
        for (int ks = 0; ks < 4; ++ks) {
          bf16x8 bv = ld8(Vt + (wave * 32 + lr) * 72 + ks * 16 + lh * 8);
#pragma unroll
          for (int mi = 0; mi < 2; ++mi) t0[mi] = MFMA(ld8(Pm + (mi * 32 + lr) * 72 + ks * 16 + lh * 8), bv, t0[mi]);
        }
#pragma unroll
        for (int mi = 0; mi < 2; ++mi)
#pragma unroll
          for (int i = 0; i < 16; ++i) hacc[mi][i] += t0[mi][i] * fac[mi * 32 + crow(i, lh)];
      }
#pragma unroll
      for (int pd = 0; pd < 2; ++pd) {
        __builtin_amdgcn_sched_barrier(0);
        const bf16_t* Cm = MLST + (size_t)(pd ? slotb : slotf) * 16384 + (wave * 32 + lr) * 128 + lh * 8;
        const float* fac = pd ? facIb : facIf;
        f32x16 t0[2]; t0[0] = zero16(); t0[1] = zero16();
#pragma unroll
        for (int ks = 0; ks < 8; ++ks) {
          bf16x8 b0 = ld8(Cm + ks * 16);
#pragma unroll
          for (int mi = 0; mi < 2; ++mi) t0[mi] = MFMA(ld8(Qs + (mi * 32 + lr) * 136 + ks * 16 + lh * 8), b0, t0[mi]);
        }
#pragma unroll
        for (int mi = 0; mi < 2; ++mi)
#pragma unroll
          for (int i = 0; i < 16; ++i) hacc[mi][i] += t0[mi][i] * fac[mi * 32 + crow(i, lh)];
      }
      __syncthreads();
#pragma unroll
      for (int mi = 0; mi < 2; ++mi)
#pragma unroll
        for (int i = 0; i < 16; ++i) Hs[(mi * 32 + crow(i, lh)) * 132 + wave * 32 + lr] = hacc[mi][i];
      __syncthreads();
      s3_epilogue(Hs, p.ml_norm_g + h * 128, PN + (size_t)tok0 * PNW + 1024 + h * 128, MIX + (size_t)tok0 * 1024 + h * 128, false);
      __syncthreads();
    } else {
      bf16_t* QF = (bf16_t*)smem;
      bf16_t* QB = QF + 64 * 136;
      bf16_t* KF = QB + 64 * 136;
      bf16_t* KB = KF + 9216;
      bf16_t* P = KF;
      bf16_t* It = KB;
      load_tile_64x128(KF, PN + (size_t)tok0 * PNW + 2048 + h * 128, PNW);
      load_tile_64x128(KB, PN + (size_t)tok0 * PNW + 2560 + h * 128, PNW);
      load_tile_64x128(QF, PN + (size_t)tok0 * PNW + 1536 + h * 128, PNW);
      load_tile_64x128(QB, PN + (size_t)tok0 * PNW + 1536 + h * 128, PNW);
      __syncthreads();
      {
        const int dir = tid >> 7, dk = tid & 127; const int ch = h * 128 + dk;
        const float lb = 1.f / (1.f + expf(p.ev_lb_logits[512 + ch] - p.ev_lb_logits[ch]));
        bf16_t* Qd = dir ? QB : QF; bf16_t* Kd = dir ? KB : KF;
        float P = 1.f;
#pragma unroll 2
        for (int s = 0; s < 64; ++s) {
          int t = dir ? 63 - s : s;
          float x = bf2f(Kd[t * 136 + dk]); float f = lb + (1.f - lb) * __frcp_rn(1.f + __expf(-x));
          P *= f;
          float q = bf2f(Qd[t * 136 + dk]);
          Qd[t * 136 + dk] = f2bf(q * P); Kd[t * 136 + dk] = f2bf((1.f - f) * __frcp_rn(fmaxf(P, 1.8e-35f)));
        }
      }
      __syncthreads();
      f32x16 pacc;
      {
        f32x16 sf = zero16(), sb = zero16();
#pragma unroll
        for (int ks = 0; ks < 8; ++ks) {
          sf = MFMA(ld8(QF + (wm * 32 + lr) * 136 + ks * 16 + lh * 8), ld8(KF + (wn * 32 + lr) * 136 + ks * 16 + lh * 8), sf);
          sb = MFMA(ld8(QB + (wm * 32 + lr) * 136 + ks * 16 + lh * 8), ld8(KB + (wn * 32 + lr) * 136 + ks * 16 + lh * 8), sb);
        }
        const int sidx = wn * 32 + lr;
#pragma unroll
        for (int i = 0; i < 16; ++i) { const int t = wm * 32 + crow(i, lh); pacc[i] = ((sidx <= t) ? sf[i] : 0.f) + ((sidx >= t) ? sb[i] : 0.f); }
      }
      f32x16 o[2]; o[0] = zero16(); o[1] = zero16();
      {
        const bf16_t* Sf = HGST + (size_t)slotf * 16384 + (wave * 32 + lr) * 128 + lh * 8;
        const bf16_t* Sb = HGST + (size_t)slotb * 16384 + (wave * 32 + lr) * 128 + lh * 8;
#pragma unroll
        for (int ks = 0; ks < 8; ++ks) {
          bf16x8 b0 = ld8(Sf + ks * 16), b1 = ld8(Sb + ks * 16);
#pragma unroll
          for (int mi = 0; mi < 2; ++mi) {
            o[mi] = MFMA(ld8(QF + (mi * 32 + lr) * 136 + ks * 16 + lh * 8), b0, o[mi]);
            o[mi] = MFMA(ld8(QB + (mi * 32 + lr) * 136 + ks * 16 + lh * 8), b1, o[mi]);
          }
        }
      }
      __syncthreads();
      {
        const int sidx = wn * 32 + lr;
#pragma unroll
        for (int i = 0; i < 16; ++i) P[(wm * 32 + crow(i, lh)) * 72 + sidx] = f2bf(pacc[i]);
      }
      load_tile_128x64(It, PT + (size_t)(1024 + h * 128) * M + tok0, M);
      __syncthreads();
#pragma unroll
      for (int ks = 0; ks < 4; ++ks) {
        bf16x8 bv = ld8(It + (wave * 32 + lr) * 72 + ks * 16 + lh * 8);
#pragma unroll
        for (int mi = 0; mi < 2; ++mi) o[mi] = MFMA(ld8(P + (mi * 32 + lr) * 72 + ks * 16 + lh * 8), bv, o[mi]);
      }
#pragma unroll
      for (int mi = 0; mi < 2; ++mi)
#pragma unroll
        for (int i = 0; i < 16; ++i) Hs[(mi * 32 + crow(i, lh)) * 132 + wave * 32 + lr] = o[mi][i];
      __syncthreads();
      s3_epilogue(Hs, p.hg_norm_g + h * 128, PN + (size_t)tok0 * PNW + 3072 + h * 128, MIX + (size_t)tok0 * 1024 + 512 + h * 128, true);
      __syncthreads();
    }
  }
}

DI void online_softmax(f32x16& s, float& m, float& l, f32x16 (&O)[4], bf16x8& p0, bf16x8& p1) {
  float mx = s[0];
#pragma unroll
  for (int i = 1; i < 16; ++i) mx = fmaxf(mx, s[i]);
  mx = fmaxf(mx, __shfl_xor(mx, 32));
  const float mn = fmaxf(m, mx);
  if (__ballot(mn > m) != 0ull) {
    const float alpha = __builtin_amdgcn_exp2f(m - mn);
    l *= alpha;
#pragma unroll
    for (int mt = 0; mt < 4; ++mt)
#pragma unroll
      for (int i = 0; i < 16; ++i) O[mt][i] *= alpha;
    m = mn;
  }
  float sum = 0.f;
#pragma unroll
  for (int i = 0; i < 16; ++i) { s[i] = __builtin_amdgcn_exp2f(s[i] - m); sum += s[i]; }
  l += sum;
  uint4 u0 = make_uint4(pack2(s[0], s[1]), pack2(s[2], s[3]), pack2(s[4], s[5]), pack2(s[6], s[7]));
  uint4 u1 = make_uint4(pack2(s[8], s[9]), pack2(s[10], s[11]), pack2(s[12], s[13]), pack2(s[14], s[15]));
  p0 = __builtin_bit_cast(bf16x8, u0); p1 = __builtin_bit_cast(bf16x8, u1);
}

#define ATTN_GLOAD(KT) do { \
    const int kt_ = (KT); const bf16_t* ksrc; size_t kld; const bf16_t* vsrc; size_t vld; \
    if (sample && kt_ < 4) { ksrc = KC + ((size_t)(seq * 8 + h) * 256 + kt_ * 64) * 128; kld = 128; vsrc = VCT + (size_t)(seq * 8 + h) * 128 * 256 + kt_ * 64; vld = 256; } \
    else { const int kt2 = sample ? kt_ - 4 : kt_; const int t0 = tokbase + kt2 * 64; ksrc = Kb + (size_t)t0 * 1024 + h * 128; kld = 1024; vsrc = VT + (size_t)(h * 128) * M + t0; vld = M; } \
    ksrc += (size_t)(tid >> 4) * kld + (tid & 15) * 8; vsrc += (size_t)(tid >> 3) * vld + (tid & 7) * 8; \
    rk0 = *(const uint4*)(ksrc); rk1 = *(const uint4*)(ksrc + 16 * kld); rk2 = *(const uint4*)(ksrc + 32 * kld); rk3 = *(const uint4*)(ksrc + 48 * kld); \
    rv0 = *(const uint4*)(vsrc); rv1 = *(const uint4*)(vsrc + 32 * vld); rv2 = *(const uint4*)(vsrc + 64 * vld); rv3 = *(const uint4*)(vsrc + 96 * vld); } while (0)
#define ATTN_LSTORE(KD, VD) do { \
    bf16_t* kd_ = (KD) + (tid >> 4) * 136 + (tid & 15) * 8; bf16_t* vd_ = (VD) + (tid >> 3) * 72 + (tid & 7) * 8; \
    *(uint4*)(kd_) = rk0; *(uint4*)(kd_ + 16 * 136) = rk1; *(uint4*)(kd_ + 32 * 136) = rk2; *(uint4*)(kd_ + 48 * 136) = rk3; \
    *(uint4*)(vd_) = rv0; *(uint4*)(vd_ + 32 * 72) = rv1; *(uint4*)(vd_ + 64 * 72) = rv2; *(uint4*)(vd_ + 96 * 72) = rv3; } while (0)

DI void attn_phase(const Params& p, unsigned char* smem) {
  bf16_t* Ks = (bf16_t*)smem;
  bf16_t* Vts = Ks + 64 * 136;
  float* Cmb = (float*)smem;
  const bf16_t* Q = (const bf16_t*)(p.ws + OFF_Q);
  const bf16_t* Kb = (const bf16_t*)(p.ws + OFF_KB);
  const bf16_t* VT = (const bf16_t*)(p.ws + OFF_VT);
  const bf16_t* KC = (const bf16_t*)(p.ws + OFF_KC);
  const bf16_t* VCT = (const bf16_t*)(p.ws + OFF_VCT);
  bf16_t* ATT = (bf16_t*)(p.ws + OFF_ATT);
  const float* MISC = (const float*)(p.ws + OFF_MISC);
  const float lam = MISC[0], lam_init = MISC[1];
  const int tid = threadIdx.x, lane = tid & 63, wave = tid >> 6, lr = lane & 31, lh = lane >> 5;
  const int br = wave >> 1, qw = wave & 1;
  for (int vit = blockIdx.x; vit < 1536; vit += gridDim.x) {
    int item = vit;
    {
      const int b = vit & 511, rnd = vit >> 9; const int xcd = b & 7, slot = b >> 3;
      if (rnd == 0) item = ((xcd * 2 + (slot >> 5)) << 5) | (slot & 31);
      else item = 512 + (((xcd * 32 + (slot >> 1)) << 2) | (((slot & 1) << 1) | (rnd - 1)));
    }
    int sample, seq, h, qb;
    if (item < 512) { sample = 1; qb = item & 31; h = (item >> 5) & 7; seq = item >> 8; }
    else { int v = item - 512; sample = 0; qb = v & 3; h = (v >> 2) & 7; seq = v >> 5; }
    const int tokbase = sample ? MP + seq * 2048 : seq * 256;
    const int nkt = sample ? 36 : 4;
    const int qtok = tokbase + qb * 64 + qw * 32 + lr;
    bf16x8 q[4];
    {
      const bf16_t* qp = Q + (size_t)qtok * 1024 + h * 128 + br * 64 + lh * 8;
#pragma unroll
      for (int s = 0; s < 4; ++s) q[s] = ld8(qp + s * 16);
    }
    f32x16 O[4];
#pragma unroll
    for (int mt = 0; mt < 4; ++mt) O[mt] = zero16();
    float m = -1e30f, l = 0.f;
    uint4 rk0, rk1, rk2, rk3, rv0, rv1, rv2, rv3;
    ATTN_GLOAD(0);
    __syncthreads();
    ATTN_LSTORE(Ks, Vts);
    __syncthreads();
    for (int kt = 0; kt < nkt; ++kt) {
      const int cur = kt & 1;
      if (kt + 1 < nkt) ATTN_GLOAD(kt + 1);
      const bf16_t* Kc = Ks + cur * 17920; const bf16_t* Vc = Vts + cur * 17920;
#pragma unroll
      for (int sub = 0; sub < 2; ++sub) {
        f32x16 s1 = zero16();
#pragma unroll
        for (int s = 0; s < 4; ++s) s1 = MFMA(ld8(Kc + (sub * 32 + lr) * 136 + br * 64 + s * 16 + lh * 8), q[s], s1);
        bf16x8 pa[2];
        online_softmax(s1, m, l, O, pa[0], pa[1]);
#pragma unroll
        for (int k2 = 0; k2 < 2; ++k2)
#pragma unroll
          for (int mt = 0; mt < 4; ++mt) {
            const bf16_t* vp = Vc + (mt * 32 + lr) * 72 + sub * 32 + k2 * 16 + 4 * lh;
            uint2 lo = *(const uint2*)vp, hi = *(const uint2*)(vp + 8);
            bf16x8 vf = __builtin_bit_cast(bf16x8, make_uint4(lo.x, lo.y, hi.x, hi.y));
            O[mt] = MFMA(vf, pa[k2], O[mt]);
          }
      }
      if (kt + 1 < nkt) ATTN_LSTORE(Ks + (cur ^ 1) * 17920, Vts + (cur ^ 1) * 17920);
      __syncthreads();
    }
    l += __shfl_xor(l, 32);
    const float inv = br ? lam / l : 1.f / l;
    __syncthreads();
    if (br == 1) {
#pragma unroll
      for (int mt = 0; mt < 4; ++mt)
#pragma unroll
        for (int i = 0; i < 16; ++i) Cmb[(qw * 64 + mt * 16 + i) * 64 + lane] = O[mt][i] * inv;
    }
    __syncthreads();
    if (br == 0) {
      float ss = 0.f;
#pragma unroll
      for (int mt = 0; mt < 4; ++mt)
#pragma unroll
        for (int i = 0; i < 16; ++i) { float o = O[mt][i] * inv - Cmb[(qw * 64 + mt * 16 + i) * 64 + lane]; O[mt][i] = o; ss += o * o; }
      ss += __shfl_xor(ss, 32);
      const float sc = rsqrtf(ss * (1.f / 128.f) + 1e-6f) * (1.f - lam_init);
      bf16_t* dst = ATT + (size_t)qtok * 1024 + h * 128;
#pragma unroll
      for (int mt = 0; mt < 4; ++mt)
#pragma unroll
        for (int g = 0; g < 4; ++g) {
          const int dv = mt * 32 + 8 * g + 4 * lh;
          float4 g4 = *(const float4*)(p.da_norm_g + dv);
          *(uint2*)(dst + dv) = pack4(O[mt][4 * g] * sc * g4.x, O[mt][4 * g + 1] * sc * g4.y, O[mt][4 * g + 2] * sc * g4.z, O[mt][4 * g + 3] * sc * g4.w);
        }
    }
  }
}

__global__ void __launch_bounds__(256, 2) mega(Params p) {
  __shared__ __attribute__((aligned(16))) unsigned char smem[SMEM_BYTES];
  cg::grid_group grid = cg::this_grid();
  unsigned char* ws = p.ws;
  float* MOD = (float*)(ws + OFF_MOD);
  float* X = p.out + OUT_Y;
  bf16_t* A = (bf16_t*)(ws + OFF_A);
  bf16_t* U = (bf16_t*)(ws + OFF_U);

  __shared__ uint4 xb_words;
  unsigned* bar = (unsigned*)(ws + OFF_BAR);
  if (threadIdx.x == 0) xb_words = make_uint4(0u, 0u, 0u, 0u);
  __syncthreads();
  XcdBarrier xb = xcd_barrier_post(bar, (volatile LAS unsigned*)&xb_words);
  if (p.ws == nullptr) grid.sync();
  for (int rep = 0; rep < REP_P0; ++rep) phase0(p, smem);
  xcd_barrier(xb);
  norm_phase(p.x_prompt, p.x_sample, p.norm_mix_g, MOD, 1024, 0, A);
  xcd_barrier(xb);
  {
    EpiEvIn e{(bf16_t*)(ws + OFF_PN), (bf16_t*)(ws + OFF_PT), (float*)(ws + OFF_GATES), p.ev_gate_b};
    for (int rep = 0; rep < REP_G; ++rep) gemm_phase<128, 128, 64, false>(A, 1024, (const bf16_t*)(ws + OFF_W_EVIN), 1024, M, 4736, 1024, e, smem);
  }
  xcd_barrier(xb);
  for (int rep = 0; rep < REP_MIX; ++rep) s1_phase(p, smem);
  xcd_barrier(xb);
  s2_phase(p, smem);
  xcd_barrier(xb);
  for (int rep = 0; rep < REP_MIX; ++rep) s3_phase(p, smem);
  xcd_barrier(xb);
  {
    EpiResid e{p.x_prompt, p.x_sample, X, MOD + 2048};
    gemm_phase<128, 64, 64, false>((const bf16_t*)(p.out + OUT_AK), 1024, (const bf16_t*)(ws + OFF_W_EVOUT), 1024, M, 1024, 1024, e, smem);
  }
  xcd_barrier(xb);
  norm_phase(X, X + (size_t)MP * D, p.norm_ffn_g, MOD, 4096, 3072, A);
  xcd_barrier(xb);
  {
    EpiFFUp e{U};
    for (int rep = 0; rep < REP_G; ++rep) gemm_phase<128, 128, 64, false>(A, 1024, (const bf16_t*)(ws + OFF_W_FFU0), 1024, M, 5632, 1024, e, smem);
  }
  xcd_barrier(xb);
  {
    EpiResid e{X, X + (size_t)MP * D, X, MOD + 5120};
    gemm_phase<128, 128, 64, true>(U, DFF, (const bf16_t*)(ws + OFF_W_FFD0), DFF, M, 1024, DFF, e, smem);
  }
  xcd_barrier(xb);
  norm_phase(X, X + (size_t)MP * D, p.norm_mix_g + 1024, MOD + 3 * 6144, 1024, 0, A);
  xcd_barrier(xb);
  {
    EpiOdIn e{(bf16_t*)(ws + OFF_Q), (bf16_t*)(ws + OFF_KB), (bf16_t*)(ws + OFF_VT), p.out + OUT_AK, p.out + OUT_AV, (const float*)(ws + OFF_ROPE)};
    for (int rep = 0; rep < REP_G; ++rep) gemm_phase<128, 128, 64, false>(A, 1024, (const bf16_t*)(ws + OFF_W_ODIN), 1024, M, 3072, 1024, e, smem);
  }
  xcd_barrier(xb);
  for (int rep = 0; rep < REP_ATT; ++rep) attn_phase(p, smem);
  xcd_barrier(xb);
  {
    EpiResid e{X, X + (size_t)MP * D, X, MOD + 3 * 6144 + 2048};
    gemm_phase<128, 128, 64, true>((const bf16_t*)(ws + OFF_ATT), 1024, (const bf16_t*)(ws + OFF_W_ODOUT), 1024, M, 1024, 1024, e, smem);
  }
  xcd_barrier(xb);
  norm_phase(X, X + (size_t)MP * D, p.norm_ffn_g + 1024, MOD + 3 * 6144, 4096, 3072, A);
  xcd_barrier(xb);
  {
    EpiFFUp e{U};
    for (int rep = 0; rep < REP_G; ++rep) gemm_phase<128, 128, 64, false>(A, 1024, (const bf16_t*)(ws + OFF_W_FFU1), 1024, M, 5632, 1024, e, smem);
  }
  xcd_barrier(xb);
  {
    EpiResid e{X, X + (size_t)MP * D, X, MOD + 3 * 6144 + 5120};
    gemm_phase<128, 128, 64, true>(U, DFF, (const bf16_t*)(ws + OFF_W_FFD1), DFF, M, 1024, DFF, e, smem);
  }
  xcd_barrier(xb);
  final_norm_phase(X, p.final_norm_g);
}

extern "C" void kernel_launch(void* const* d_in, const int* in_sizes, int n_in, void* d_out, int out_size, void* d_ws, size_t ws_size, hipStream_t stream) {
  static int grid_blocks = 0;
  if (!grid_blocks) {
    int dev = 0, cus = 0, per_cu = 0;
    (void)hipGetDevice(&dev);
    (void)hipDeviceGetAttribute(&cus, hipDeviceAttributeMultiprocessorCount, dev);
    (void)hipOccupancyMaxActiveBlocksPerMultiprocessor(&per_cu, mega, 256, 0);
    per_cu = 2;
    grid_blocks = cus * per_cu;
    if (ws_size < WS_END) { fprintf(stderr, "kernel_launch: workspace too small: %zu < %zu\n", ws_size, (size_t)WS_END); grid_blocks = -1; }
  }
  if (grid_blocks < 0) return;
  (void)hipMemsetAsync((unsigned char*)d_ws + OFF_BAR, 0, 16384, stream);
  Params p{};
  const float** pp = (const float**)&p;
  for (int i = 0; i < 28; ++i) pp[i] = (const float*)d_in[i];
  p.out = (float*)d_out; p.ws = (unsigned char*)d_ws;
  void* args[] = {&p};
  hipError_t e = hipLaunchCooperativeKernel((void*)mega, dim3(grid_blocks), dim3(256), args, 0, stream);
  if (e != hipSuccess) fprintf(stderr, "cooperative launch failed: %s (grid %d)\n", hipGetErrorString(e), grid_blocks);
}
```

```cpp
#include <hip/hip_runtime.h>
#include <hip/hip_cooperative_groups.h>
#include <cstdio>
namespace cg = cooperative_groups;

typedef unsigned short bf16_t;
using bf16x8 = __attribute__((ext_vector_type(8))) short;
using f32x16 = __attribute__((ext_vector_type(16))) float;
#define DI __device__ __forceinline__
#define MFMA(a, b, c) __builtin_amdgcn_mfma_f32_32x32x16_bf16((a), (b), (c), 0, 0, 0)

constexpr int D = 1024;
constexpr int M = 12288;
constexpr int MP = 8192;
constexpr int DFF = 2816;
constexpr int PNW = 3584;
constexpr int SMEM_BYTES = 77824;
#ifndef REP_G
#define REP_G 1
#endif
#ifndef REP_P0
#define REP_P0 1
#endif
#ifndef REP_MIX
#define REP_MIX 1
#endif
#ifndef REP_ATT
#define REP_ATT 1
#endif

constexpr size_t OFF_W_EVIN = 0;
constexpr size_t OFF_W_EVOUT = OFF_W_EVIN + (size_t)4736 * 1024 * 2;
constexpr size_t OFF_W_FFU0 = OFF_W_EVOUT + (size_t)1024 * 1024 * 2;
constexpr size_t OFF_W_FFU1 = OFF_W_FFU0 + (size_t)5632 * 1024 * 2;
constexpr size_t OFF_W_FFD0 = OFF_W_FFU1 + (size_t)5632 * 1024 * 2;
constexpr size_t OFF_W_FFD1 = OFF_W_FFD0 + (size_t)1024 * 2816 * 2;
constexpr size_t OFF_W_ODIN = OFF_W_FFD1 + (size_t)1024 * 2816 * 2;
constexpr size_t OFF_W_ODOUT = OFF_W_ODIN + (size_t)3072 * 1024 * 2;
constexpr size_t OFF_MOD = OFF_W_ODOUT + (size_t)1024 * 1024 * 2;
constexpr size_t OFF_ROPE = OFF_MOD + (size_t)2 * 3 * 6144 * 4;
constexpr size_t OFF_MISC = OFF_ROPE + 8192;
constexpr size_t OFF_BAR = OFF_MISC + 256;
constexpr size_t OFF_GATES = OFF_BAR + 16384;
constexpr size_t OFF_KC = OFF_GATES + (size_t)M * 16 * 4;
constexpr size_t OFF_VCT = OFF_KC + (size_t)2 * 8 * 256 * 128 * 2;
constexpr size_t OFF_NLOC = OFF_VCT + (size_t)2 * 8 * 256 * 128 * 2;
constexpr size_t OFF_NINIT = OFF_NLOC + (size_t)1536 * 128 * 4;
constexpr size_t OFF_SCAL = OFF_NINIT + (size_t)1536 * 128 * 4;
constexpr size_t OFF_MINIT = OFF_SCAL + (size_t)1536 * 4 * 4;
constexpr size_t OFF_AL = OFF_MINIT + (size_t)1536 * 4;
constexpr size_t OFF_PN = OFF_AL + (size_t)1536 * 128 * 4;
constexpr size_t OFF_PT = OFF_PN + (size_t)M * PNW * 2;
constexpr size_t OFF_ST = OFF_PT + (size_t)1536 * M * 2;
constexpr size_t WS_END = OFF_ST + (size_t)1536 * 16384 * 2;
constexpr size_t OFF_A = OFF_ST;
constexpr size_t OFF_ATT = OFF_ST + (size_t)M * 1024 * 2;
constexpr size_t OFF_U = OFF_PN;
constexpr size_t OFF_Q = OFF_PN;
constexpr size_t OFF_KB = OFF_PN + (size_t)M * 1024 * 2;
constexpr size_t OFF_VT = OFF_PN + (size_t)2 * M * 1024 * 2;
constexpr size_t OUT_Y = 0;
constexpr size_t OUT_AK = (size_t)M * 1024;
constexpr size_t OUT_AV = OUT_AK + (size_t)MP * 1024;
constexpr size_t OUT_C = OUT_AV + (size_t)MP * 1024;
constexpr size_t OUT_N = OUT_C + (size_t)32 * 2 * 4 * 16384;
constexpr size_t OUT_M = OUT_N + (size_t)32 * 2 * 4 * 128;
constexpr size_t OUT_S = OUT_M + 256;

struct Params {
  const float *x_prompt, *x_sample, *c, *c_ctx, *cache_k, *cache_v, *st_C, *st_n, *st_m, *st_S;
  const float *ada_w, *ada_b, *norm_mix_g, *norm_ffn_g, *ev_w_in, *ev_gate_b, *ev_lb_logits, *ml_norm_g, *hg_norm_g;
  const float *ev_w_out, *od_w_in, *od_lambda, *da_norm_g, *od_w_out, *ffn_w1, *ffn_w3, *ffn_w2, *final_norm_g;
  float* out;
  unsigned char* ws;
};

typedef __bf16 bf16v2 __attribute__((ext_vector_type(2)));
typedef float f32v2 __attribute__((ext_vector_type(2)));
DI unsigned short f2bf(float x) { return __builtin_bit_cast(unsigned short, (__bf16)x); }
DI float bf2f(unsigned short h) { return __uint_as_float(((unsigned)h) << 16); }
DI unsigned pack2(float a, float b) { f32v2 v = {a, b}; return __builtin_bit_cast(unsigned, __builtin_convertvector(v, bf16v2)); }
DI uint2 pack4(float a, float b, float c, float d) { return make_uint2(pack2(a, b), pack2(c, d)); }
DI float lo_bf(unsigned u) { return __uint_as_float(u << 16); }
DI float hi_bf(unsigned u) { return __uint_as_float(u & 0xffff0000u); }
DI int crow(int reg, int h) { return (reg & 3) + 8 * (reg >> 2) + 4 * h; }
DI float wsum(float v) {
#pragma unroll
  for (int o = 32; o > 0; o >>= 1) v += __shfl_xor(v, o);
  return v;
}
DI float wmax(float v) {
#pragma unroll
  for (int o = 32; o > 0; o >>= 1) v = fmaxf(v, __shfl_xor(v, o));
  return v;
}
DI float logsig(float x) { return fminf(x, 0.f) - log1pf(expf(-fabsf(x))); }
DI float sigmoidf(float x) { return 1.f / (1.f + expf(-x)); }
DI f32x16 zero16() { f32x16 z;
#pragma unroll
  for (int i = 0; i < 16; ++i) z[i] = 0.f;
  return z; }
DI bf16x8 ld8(const bf16_t* p) { return *(const bf16x8*)p; }


#define XB_TMO      128
#define XB_XCNT(j)  (256  + 64 * (j))
#define XB_XSUB(j)  (1280 + 64 * (j))
#define XB_XGEN(j)  (2304 + 64 * (j))
#define XB_TOP      3328
#define XB_TOPGEN   3392
#define XCD_BAR_WORDS 3456
#define XB_SPIN_CAP (1u << 22)
#define LAS __attribute__((address_space(3)))
DI unsigned xb_ld(unsigned* p)              { return __hip_atomic_load(p, __ATOMIC_RELAXED, __HIP_MEMORY_SCOPE_AGENT); }
DI unsigned xb_add(unsigned* p, unsigned v) { return __hip_atomic_fetch_add(p, v, __ATOMIC_RELAXED, __HIP_MEMORY_SCOPE_AGENT); }
DI unsigned xb_xcc_id() { return (unsigned)__builtin_amdgcn_s_getreg((3 << 11) | 20) & 0xFu; }
#define XB_SPIN(cond, bar) do { unsigned _sp = 0; while (cond) { __builtin_amdgcn_s_sleep(1); \
    if ((++_sp & 255u) == 0u) { if (xb_ld(&(bar)[XB_TMO])) break; if (_sp > XB_SPIN_CAP) { atomicAdd(&(bar)[XB_TMO], 1u); break; } } } } while (0)
struct XcdBarrier { unsigned* bar; unsigned x; volatile LAS unsigned* st; };
DI XcdBarrier xcd_barrier_post(unsigned* bar, volatile LAS unsigned* st) {
  XcdBarrier b; b.bar = bar; b.x = xb_xcc_id(); b.st = st;
  if (threadIdx.x == 0) (void)xb_add(&bar[XB_XCNT(b.x)], 1u);
  return b;
}
DI void xcd_barrier_complete(unsigned* bar, unsigned x, unsigned& nloc, unsigned& nx) {
  const unsigned G = gridDim.x * gridDim.y * gridDim.z;
  unsigned sum, cnt, mine, sp = 0u;
  for (;;) {
    sum = 0u; cnt = 0u; mine = 0u;
#pragma unroll
    for (unsigned j = 0; j < 16; ++j) { const unsigned c = xb_ld(&bar[XB_XCNT(j)]); sum += c; cnt += (c > 0u) ? 1u : 0u; mine = (j == x) ? c : mine; }
    if (sum == G) break;
    __builtin_amdgcn_s_sleep(1);
    if ((++sp & 255u) == 0u) { if (xb_ld(&bar[XB_TMO])) break; if (sp > XB_SPIN_CAP) { atomicAdd(&bar[XB_TMO], 1u); break; } }
  }
  nloc = mine > 0u ? mine : 1u; nx = cnt > 0u ? cnt : 1u;
}
DI void xcd_barrier(const XcdBarrier& b) {
  asm volatile("s_waitcnt vmcnt(0)" ::: "memory");
  __syncthreads();
  if (threadIdx.x == 0) {
    unsigned* bar = b.bar;
    __builtin_amdgcn_s_waitcnt(0);
    unsigned nloc = b.st[0], nx = b.st[1];
    if (nloc == 0u) { xcd_barrier_complete(bar, b.x, nloc, nx); b.st[0] = nloc; b.st[1] = nx; }
    const unsigned old = xb_add(&bar[XB_XSUB(b.x)], 1u);
    const unsigned gen = old / nloc;
    if (old + 1u == (gen + 1u) * nloc) {
      __builtin_amdgcn_fence(__ATOMIC_RELEASE, "agent");
      asm volatile("s_waitcnt vmcnt(0)" ::: "memory");
      const unsigned og = xb_add(&bar[XB_TOP], 1u);
      const unsigned tg = og / nx;
      if (og + 1u == (tg + 1u) * nx) xb_add(&bar[XB_TOPGEN], 1u);
      else XB_SPIN(xb_ld(&bar[XB_TOPGEN]) == tg, bar);
      __builtin_amdgcn_fence(__ATOMIC_ACQUIRE, "agent");
      xb_add(&bar[XB_XGEN(b.x)], 1u);
      asm volatile("s_waitcnt vmcnt(0)" ::: "memory");
    } else {
      XB_SPIN(xb_ld(&bar[XB_XGEN(b.x)]) == gen, bar);
      __builtin_amdgcn_fence(__ATOMIC_ACQUIRE, "agent");
      asm volatile("s_waitcnt vmcnt(0)" ::: "memory");
    }
  }
  __syncthreads();
}

DI void load_tile_64x128(bf16_t* dst, const bf16_t* src, size_t ld) {
  const int tid = threadIdx.x;
#pragma unroll
  for (int i = 0; i < 4; ++i) { int c = tid + 256 * i; int row = c >> 4, ch = c & 15; *(uint4*)(dst + row * 136 + ch * 8) = *(const uint4*)(src + (size_t)row * ld + ch * 8); }
}
DI void load_tile_128x64(bf16_t* dst, const bf16_t* src, size_t ld) {
  const int tid = threadIdx.x;
#pragma unroll
  for (int i = 0; i < 4; ++i) { int c = tid + 256 * i; int row = c >> 3, ch = c & 7; *(uint4*)(dst + row * 72 + ch * 8) = *(const uint4*)(src + (size_t)row * ld + ch * 8); }
}

struct TDesc { const float* src0; const float* src1; bf16_t* dst; int srcN, K, kind, tn, tk; };
DI TDesc tdecode(const Params& p, int t) {
  TDesc d; d.src1 = nullptr;
  if (t < 1184) { d.src0 = p.ev_w_in; d.srcN = 4624; d.K = 1024; d.dst = (bf16_t*)(p.ws + OFF_W_EVIN); d.kind = 1; d.tn = t / 16; d.tk = t % 16; }
  else if (t < 1440) { t -= 1184; d.src0 = p.ev_w_out; d.srcN = 1024; d.K = 1024; d.dst = (bf16_t*)(p.ws + OFF_W_EVOUT); d.kind = 0; d.tn = t / 16; d.tk = t % 16; }
  else if (t < 4256) { t -= 1440; int l = t / 1408; t -= l * 1408; d.src0 = p.ffn_w1 + (size_t)l * 1024 * DFF; d.src1 = p.ffn_w3 + (size_t)l * 1024 * DFF; d.srcN = DFF; d.K = 1024;
    d.dst = (bf16_t*)(p.ws + (l ? OFF_W_FFU1 : OFF_W_FFU0)); d.kind = 2; d.tn = t / 16; d.tk = t % 16; }
  else if (t < 5664) { t -= 4256; int l = t / 704; t -= l * 704; d.src0 = p.ffn_w2 + (size_t)l * DFF * 1024; d.srcN = 1024; d.K = DFF;
    d.dst = (bf16_t*)(p.ws + (l ? OFF_W_FFD1 : OFF_W_FFD0)); d.kind = 0; d.tn = t / 44; d.tk = t % 44; }
  else if (t < 6432) { t -= 5664; d.src0 = p.od_w_in; d.srcN = 3072; d.K = 1024; d.dst = (bf16_t*)(p.ws + OFF_W_ODIN); d.kind = 0; d.tn = t / 16; d.tk = t % 16; }
  else { t -= 6432; d.src0 = p.od_w_out; d.srcN = 1024; d.K = 1024; d.dst = (bf16_t*)(p.ws + OFF_W_ODOUT); d.kind = 0; d.tn = t / 16; d.tk = t % 16; }
  return d;
}
DI void t_load(const TDesc& d, float4& v0, float4& v1, float4& v2, float4& v3) {
  const int tid = threadIdx.x; const int c4 = (tid & 15) * 4, kr = tid >> 4;
  const int n = d.tn * 64 + c4;
  const float* src = d.src0; int sc;
  if (d.kind == 0) sc = n;
  else if (d.kind == 1) sc = n < 2048 ? n : (n < 4608 ? n + 16 : (n < 4624 ? n - 4608 + 2048 : -1));
  else { int jb = n >> 6, r = n & 63; src = (r < 32) ? d.src0 : d.src1; sc = jb * 32 + (r & 31); }
  v0 = v1 = v2 = v3 = make_float4(0.f, 0.f, 0.f, 0.f);
  if (sc >= 0) {
    const float* b = src + (size_t)(d.tk * 64 + kr) * d.srcN + sc;
    v0 = *(const float4*)(b); v1 = *(const float4*)(b + (size_t)16 * d.srcN); v2 = *(const float4*)(b + (size_t)32 * d.srcN); v3 = *(const float4*)(b + (size_t)48 * d.srcN);
  }
}
DI void t_ldsw(float* lds, const float4& v0, const float4& v1, const float4& v2, const float4& v3) {
  const int tid = threadIdx.x; const int c4 = (tid & 15) * 4, kr = tid >> 4;
  float* d = lds + kr * 65 + c4;
  d[0] = v0.x; d[1] = v0.y; d[2] = v0.z; d[3] = v0.w;
  d[16 * 65] = v1.x; d[16 * 65 + 1] = v1.y; d[16 * 65 + 2] = v1.z; d[16 * 65 + 3] = v1.w;
  d[32 * 65] = v2.x; d[32 * 65 + 1] = v2.y; d[32 * 65 + 2] = v2.z; d[32 * 65 + 3] = v2.w;
  d[48 * 65] = v3.x; d[48 * 65 + 1] = v3.y; d[48 * 65 + 2] = v3.z; d[48 * 65 + 3] = v3.w;
}
DI void t_store(const TDesc& d, const float* lds) {
  const int tid = threadIdx.x; const int nn = tid >> 2, kq = (tid & 3) * 16;
  unsigned w[8];
#pragma unroll
  for (int j = 0; j < 8; ++j) w[j] = pack2(lds[(kq + 2 * j) * 65 + nn], lds[(kq + 2 * j + 1) * 65 + nn]);
  bf16_t* o = d.dst + (size_t)(d.tn * 64 + nn) * d.K + d.tk * 64 + kq;
  *(uint4*)o = make_uint4(w[0], w[1], w[2], w[3]);
  *(uint4*)(o + 8) = make_uint4(w[4], w[5], w[6], w[7]);
}

DI void mod_unit(const Params& p, int u, float* lds) {
  float* sil = lds; float* red = lds + 3072;
  float* MOD = (float*)(p.ws + OFF_MOD);
  const int tid = threadIdx.x;
  for (int i = tid; i < 3072; i += 256) { int j = i >> 10, k = i & 1023; float v = (j == 0) ? p.c_ctx[k] : p.c[(j - 1) * 1024 + k]; sil[i] = v / (1.f + expf(-v)); }
  __syncthreads();
  const int l = u / 48, cb = u % 48; const int cgp = tid & 31, kg = tid >> 5;
  const float* w = p.ada_w + (size_t)l * 1024 * 6144 + cb * 128 + cgp * 4;
  float a0x = 0, a0y = 0, a0z = 0, a0w = 0, a1x = 0, a1y = 0, a1z = 0, a1w = 0, a2x = 0, a2y = 0, a2z = 0, a2w = 0;
#pragma unroll 4
  for (int k = kg * 128; k < kg * 128 + 128; ++k) {
    float4 wv = *(const float4*)(w + (size_t)k * 6144);
    float s0 = sil[k], s1 = sil[1024 + k], s2 = sil[2048 + k];
    a0x += s0 * wv.x; a0y += s0 * wv.y; a0z += s0 * wv.z; a0w += s0 * wv.w;
    a1x += s1 * wv.x; a1y += s1 * wv.y; a1z += s1 * wv.z; a1w += s1 * wv.w;
    a2x += s2 * wv.x; a2y += s2 * wv.y; a2z += s2 * wv.z; a2w += s2 * wv.w;
  }
  float* r0 = red + (kg * 3 + 0) * 128 + cgp * 4; r0[0] = a0x; r0[1] = a0y; r0[2] = a0z; r0[3] = a0w;
  float* r1 = red + (kg * 3 + 1) * 128 + cgp * 4; r1[0] = a1x; r1[1] = a1y; r1[2] = a1z; r1[3] = a1w;
  float* r2 = red + (kg * 3 + 2) * 128 + cgp * 4; r2[0] = a2x; r2[1] = a2y; r2[2] = a2z; r2[3] = a2w;
  __syncthreads();
  for (int i = tid; i < 384; i += 256) {
    int j = i >> 7, cc = i & 127; float s = 0;
#pragma unroll
    for (int g = 0; g < 8; ++g) s += red[(g * 3 + j) * 128 + cc];
    s += p.ada_b[l * 6144 + cb * 128 + cc];
    MOD[(l * 3 + j) * 6144 + cb * 128 + cc] = s;
  }
  __syncthreads();
}

DI void phase0(const Params& p, unsigned char* smem) {
  float* lds = (float*)smem;
  const int tid = threadIdx.x;
  {
    int item = blockIdx.x;
    if (item < 96) { mod_unit(p, item, lds); item += gridDim.x; }
    float4 v0, v1, v2, v3;
    TDesc cur = tdecode(p, 0);
    bool have = item < 6784;
    if (have) { cur = tdecode(p, item - 96); t_load(cur, v0, v1, v2, v3); }
    while (have) {
      t_ldsw(lds, v0, v1, v2, v3);
      const int nitem = item + gridDim.x; const bool hn = nitem < 6784;
      TDesc nxt = cur;
      if (hn) { nxt = tdecode(p, nitem - 96); t_load(nxt, v0, v1, v2, v3); }
      __syncthreads();
      t_store(cur, lds);
      __syncthreads();
      cur = nxt; item = nitem; have = hn;
    }
  }
  for (int item = blockIdx.x; item < 7041; item += gridDim.x) {
    if (item < 6784) continue;
    int t = item - 96;
    t -= 6688;
    if (t < 256) {
      bf16_t* KC = (bf16_t*)(p.ws + OFF_KC); bf16_t* VCT = (bf16_t*)(p.ws + OFF_VCT);
#pragma unroll 4
      for (int j = 0; j < 16; ++j) {
        int idx = t * 4096 + j * 256 + tid;
        if (idx < 524288) { int d = idx & 127, key = (idx >> 7) & 255, h = (idx >> 15) & 7, b = idx >> 18;
          KC[idx] = f2bf(p.cache_k[((size_t)(b * 256 + key) * 8 + h) * 128 + d]); }
        else { int i2 = idx - 524288; int key = i2 & 255, dv = (i2 >> 8) & 127, h = (i2 >> 15) & 7, b = i2 >> 18;
          VCT[i2] = f2bf(p.cache_v[((size_t)(b * 256 + key) * 8 + h) * 128 + dv]); }
      }
      continue;
    }
    float* ROPE = (float*)(p.ws + OFF_ROPE); float* MISC = (float*)(p.ws + OFF_MISC);
    for (int idx = tid; idx < 1024; idx += 256) {
      int pos = idx >> 4, i = idx & 15;
      float inv = powf(10000.f, -(float)i / 16.f);
      float ang = (float)pos * inv;
      ROPE[idx * 2] = cosf(ang); ROPE[idx * 2 + 1] = sinf(ang);
    }
    if (tid == 0) {
      float s01 = 0, s23 = 0;
      for (int i = 0; i < 64; ++i) { s01 += p.od_lambda[i] * p.od_lambda[64 + i]; s23 += p.od_lambda[128 + i] * p.od_lambda[192 + i]; }
      const float lam_init = 0.8f - 0.6f * expf(-0.3f);
      MISC[0] = expf(s01) - expf(s23) + lam_init;
      MISC[1] = lam_init;
    }
  }
}

DI void norm_phase(const float* src_p, const float* src_s, const float* gain, const float* mod, int sc_off, int sh_off, bf16_t* A) {
  const int wave = threadIdx.x >> 6, lane = threadIdx.x & 63;
  for (int row = blockIdx.x * 4 + wave; row < M; row += gridDim.x * 4) {
    const float* src = row < MP ? src_p + (size_t)row * D : src_s + (size_t)(row - MP) * D;
    const int j = row < MP ? 0 : 1 + ((row - MP) >> 11);
    float4 v[4]; float ss = 0;
#pragma unroll
    for (int i = 0; i < 4; ++i) { v[i] = *(const float4*)(src + i * 256 + lane * 4); ss += v[i].x * v[i].x + v[i].y * v[i].y + v[i].z * v[i].z + v[i].w * v[i].w; }
    ss = wsum(ss);
    const float rstd = rsqrtf(ss * (1.f / 1024.f) + 1e-6f);
    const float* msc = mod + j * 6144 + sc_off; const float* msh = mod + j * 6144 + sh_off;
#pragma unroll
    for (int i = 0; i < 4; ++i) {
      int c = i * 256 + lane * 4;
      float4 g4 = *(const float4*)(gain + c), sc4 = *(const float4*)(msc + c), sh4 = *(const float4*)(msh + c);
      float o0 = v[i].x * rstd * g4.x * (1.f + sc4.x) + sh4.x;
      float o1 = v[i].y * rstd * g4.y * (1.f + sc4.y) + sh4.y;
      float o2 = v[i].z * rstd * g4.z * (1.f + sc4.z) + sh4.z;
      float o3 = v[i].w * rstd * g4.w * (1.f + sc4.w) + sh4.w;
      *(uint2*)(A + (size_t)row * D + c) = pack4(o0, o1, o2, o3);
    }
  }
}

DI void final_norm_phase(float* X, const float* gain) {
  const int wave = threadIdx.x >> 6, lane = threadIdx.x & 63;
  for (int row = blockIdx.x * 4 + wave; row < M; row += gridDim.x * 4) {
    float* src = X + (size_t)row * D;
    float4 v[4]; float ss = 0;
#pragma unroll
    for (int i = 0; i < 4; ++i) { v[i] = *(const float4*)(src + i * 256 + lane * 4); ss += v[i].x * v[i].x + v[i].y * v[i].y + v[i].z * v[i].z + v[i].w * v[i].w; }
    ss = wsum(ss);
    const float rstd = rsqrtf(ss * (1.f / 1024.f) + 1e-6f);
#pragma unroll
    for (int i = 0; i < 4; ++i) {
      int c = i * 256 + lane * 4;
      float4 g4 = *(const float4*)(gain + c);
      float4 o; o.x = v[i].x * rstd * g4.x; o.y = v[i].y * rstd * g4.y; o.z = v[i].z * rstd * g4.z; o.w = v[i].w * rstd * g4.w;
      *(float4*)(src + c) = o;
    }
  }
}

template <int BM, int BN, int BK, bool SPLIT, class Epi>
DI void gemm_phase(const bf16_t* __restrict__ A, int lda, const bf16_t* __restrict__ Bt, int ldb, int Mrows, int N, int K, const Epi& epi, unsigned char* smem) {
  constexpr int MI = BM / 64, NI = BN / 64;
  constexpr int LDK = BK + 8;
  constexpr int LDS_A = BM * LDK, LDS_B = BN * LDK;
  constexpr int CPR = BK / 8;
  constexpr int RPP = 256 / CPR;
  constexpr int NA = BM / RPP, NB = BN / RPP;
  bf16_t* As = (bf16_t*)smem;
  bf16_t* Bs = As + 2 * LDS_A;
  const int tid = threadIdx.x, lane = tid & 63, wave = tid >> 6, wm = wave >> 1, wn = wave & 1, lr = lane & 31, lh = lane >> 5;
  const int ntm = Mrows / BM, ntn = N / BN, nkfull = K / BK;
  const int lrow = tid / CPR, lch = tid % CPR;
  const int lofs = lrow * LDK + lch * 8;
  const bf16_t* as0 = As + (wm * (BM / 2) + lr) * LDK + lh * 8;
  const bf16_t* bs0 = Bs + (wn * (BN / 2) + lr) * LDK + lh * 8;
  const int ntiles = ntm * ntn;
  const int nfull = SPLIT ? ((int)gridDim.x < ntiles ? (int)gridDim.x : ntiles) : ntiles;
  const int nitems = SPLIT ? nfull + 2 * (ntiles - nfull) : ntiles;
  for (int item = blockIdx.x; item < nitems; item += gridDim.x) {
    int tile = item, kbeg = 0, nk = nkfull; bool part = false;
    if (SPLIT && item >= nfull) { tile = nfull + ((item - nfull) >> 1); nk = nkfull >> 1; kbeg = ((item - nfull) & 1) * nk; part = true; }
    const int tm = tile % ntm, tn = tile / ntm; const int m0 = tm * BM, n0 = tn * BN;
    f32x16 acc[MI][NI];
#pragma unroll
    for (int mi = 0; mi < MI; ++mi)
#pragma unroll
      for (int ni = 0; ni < NI; ++ni) acc[mi][ni] = zero16();
    static_assert(NA <= 4 && NB <= 4, "staging registers");
    uint4 a00, a01, a02, a03, b00, b01, b02, b03, a10, a11, a12, a13, b10, b11, b12, b13;
    a00 = a01 = a02 = a03 = b00 = b01 = b02 = b03 = a10 = a11 = a12 = a13 = b10 = b11 = b12 = b13 = make_uint4(0u, 0u, 0u, 0u);
    const bf16_t* Ag = A + (size_t)(m0 + lrow) * lda + lch * 8 + (size_t)kbeg * BK;
    const bf16_t* Bg = Bt + (size_t)(n0 + lrow) * ldb + lch * 8 + (size_t)kbeg * BK;
    if (NA > 0) a00 = *(const uint4*)(Ag + (size_t)(RPP * 0) * lda + (0) * BK);
    if (NA > 1) a01 = *(const uint4*)(Ag + (size_t)(RPP * 1) * lda + (0) * BK);
    if (NA > 2) a02 = *(const uint4*)(Ag + (size_t)(RPP * 2) * lda + (0) * BK);
    if (NA > 3) a03 = *(const uint4*)(Ag + (size_t)(RPP * 3) * lda + (0) * BK);
    if (NB > 0) b00 = *(const uint4*)(Bg + (size_t)(RPP * 0) * ldb + (0) * BK);
    if (NB > 1) b01 = *(const uint4*)(Bg + (size_t)(RPP * 1) * ldb + (0) * BK);
    if (NB > 2) b02 = *(const uint4*)(Bg + (size_t)(RPP * 2) * ldb + (0) * BK);
    if (NB > 3) b03 = *(const uint4*)(Bg + (size_t)(RPP * 3) * ldb + (0) * BK);
    if (NA > 0) a10 = *(const uint4*)(Ag + (size_t)(RPP * 0) * lda + (1) * BK);
    if (NA > 1) a11 = *(const uint4*)(Ag + (size_t)(RPP * 1) * lda + (1) * BK);
    if (NA > 2) a12 = *(const uint4*)(Ag + (size_t)(RPP * 2) * lda + (1) * BK);
    if (NA > 3) a13 = *(const uint4*)(Ag + (size_t)(RPP * 3) * lda + (1) * BK);
    if (NB > 0) b10 = *(const uint4*)(Bg + (size_t)(RPP * 0) * ldb + (1) * BK);
    if (NB > 1) b11 = *(const uint4*)(Bg + (size_t)(RPP * 1) * ldb + (1) * BK);
    if (NB > 2) b12 = *(const uint4*)(Bg + (size_t)(RPP * 2) * ldb + (1) * BK);
    if (NB > 3) b13 = *(const uint4*)(Bg + (size_t)(RPP * 3) * ldb + (1) * BK);
    if (NA > 0) *(uint4*)(As + (0) * LDS_A + lofs + RPP * 0 * LDK) = a00;
    if (NA > 1) *(uint4*)(As + (0) * LDS_A + lofs + RPP * 1 * LDK) = a01;
    if (NA > 2) *(uint4*)(As + (0) * LDS_A + lofs + RPP * 2 * LDK) = a02;
    if (NA > 3) *(uint4*)(As + (0) * LDS_A + lofs + RPP * 3 * LDK) = a03;
    if (NB > 0) *(uint4*)(Bs + (0) * LDS_B + lofs + RPP * 0 * LDK) = b00;
    if (NB > 1) *(uint4*)(Bs + (0) * LDS_B + lofs + RPP * 1 * LDK) = b01;
    if (NB > 2) *(uint4*)(Bs + (0) * LDS_B + lofs + RPP * 2 * LDK) = b02;
    if (NB > 3) *(uint4*)(Bs + (0) * LDS_B + lofs + RPP * 3 * LDK) = b03;
    __syncthreads();
    for (int kt = 0; kt < nk; kt += 2) {
      if (kt + 2 < nk) {
        if (NA > 0) a00 = *(const uint4*)(Ag + (size_t)(RPP * 0) * lda + (kt + 2) * BK);
        if (NA > 1) a01 = *(const uint4*)(Ag + (size_t)(RPP * 1) * lda + (kt + 2) * BK);
        if (NA > 2) a02 = *(const uint4*)(Ag + (size_t)(RPP * 2) * lda + (kt + 2) * BK);
        if (NA > 3) a03 = *(const uint4*)(Ag + (size_t)(RPP * 3) * lda + (kt + 2) * BK);
        if (NB > 0) b00 = *(const uint4*)(Bg + (size_t)(RPP * 0) * ldb + (kt + 2) * BK);
        if (NB > 1) b01 = *(const uint4*)(Bg + (size_t)(RPP * 1) * ldb + (kt + 2) * BK);
        if (NB > 2) b02 = *(const uint4*)(Bg + (size_t)(RPP * 2) * ldb + (kt + 2) * BK);
        if (NB > 3) b03 = *(const uint4*)(Bg + (size_t)(RPP * 3) * ldb + (kt + 2) * BK);
      }
      {
        const bf16_t* as = as0 + (0) * LDS_A; const bf16_t* bs = bs0 + (0) * LDS_B;
      #pragma unroll
        for (int ks = 0; ks < BK / 16; ++ks) {
          bf16x8 af[MI], bfr[NI];
      #pragma unroll
          for (int mi = 0; mi < MI; ++mi) af[mi] = ld8(as + mi * 32 * LDK + ks * 16);
      #pragma unroll
          for (int ni = 0; ni < NI; ++ni) bfr[ni] = ld8(bs + ni * 32 * LDK + ks * 16);
      #pragma unroll
          for (int mi = 0; mi < MI; ++mi)
      #pragma unroll
            for (int ni = 0; ni < NI; ++ni) acc[mi][ni] = MFMA(af[mi], bfr[ni], acc[mi][ni]);
        }
      }
      if (NA > 0) *(uint4*)(As + (1) * LDS_A + lofs + RPP * 0 * LDK) = a10;
      if (NA > 1) *(uint4*)(As + (1) * LDS_A + lofs + RPP * 1 * LDK) = a11;
      if (NA > 2) *(uint4*)(As + (1) * LDS_A + lofs + RPP * 2 * LDK) = a12;
      if (NA > 3) *(uint4*)(As + (1) * LDS_A + lofs + RPP * 3 * LDK) = a13;
      if (NB > 0) *(uint4*)(Bs + (1) * LDS_B + lofs + RPP * 0 * LDK) = b10;
      if (NB > 1) *(uint4*)(Bs + (1) * LDS_B + lofs + RPP * 1 * LDK) = b11;
      if (NB > 2) *(uint4*)(Bs + (1) * LDS_B + lofs + RPP * 2 * LDK) = b12;
      if (NB > 3) *(uint4*)(Bs + (1) * LDS_B + lofs + RPP * 3 * LDK) = b13;
      __syncthreads();
      if (kt + 3 < nk) {
        if (NA > 0) a10 = *(const uint4*)(Ag + (size_t)(RPP * 0) * lda + (kt + 3) * BK);
        if (NA > 1) a11 = *(const uint4*)(Ag + (size_t)(RPP * 1) * lda + (kt + 3) * BK);
        if (NA > 2) a12 = *(const uint4*)(Ag + (size_t)(RPP * 2) * lda + (kt + 3) * BK);
        if (NA > 3) a13 = *(const uint4*)(Ag + (size_t)(RPP * 3) * lda + (kt + 3) * BK);
        if (NB > 0) b10 = *(const uint4*)(Bg + (size_t)(RPP * 0) * ldb + (kt + 3) * BK);
        if (NB > 1) b11 = *(const uint4*)(Bg + (size_t)(RPP * 1) * ldb + (kt + 3) * BK);
        if (NB > 2) b12 = *(const uint4*)(Bg + (size_t)(RPP * 2) * ldb + (kt + 3) * BK);
        if (NB > 3) b13 = *(const uint4*)(Bg + (size_t)(RPP * 3) * ldb + (kt + 3) * BK);
      }
      {
        const bf16_t* as = as0 + (1) * LDS_A; const bf16_t* bs = bs0 + (1) * LDS_B;
      #pragma unroll
        for (int ks = 0; ks < BK / 16; ++ks) {
          bf16x8 af[MI], bfr[NI];
      #pragma unroll
          for (int mi = 0; mi < MI; ++mi) af[mi] = ld8(as + mi * 32 * LDK + ks * 16);
      #pragma unroll
          for (int ni = 0; ni < NI; ++ni) bfr[ni] = ld8(bs + ni * 32 * LDK + ks * 16);
      #pragma unroll
          for (int mi = 0; mi < MI; ++mi)
      #pragma unroll
            for (int ni = 0; ni < NI; ++ni) acc[mi][ni] = MFMA(af[mi], bfr[ni], acc[mi][ni]);
        }
      }
      if (kt + 2 < nk) {
        if (NA > 0) *(uint4*)(As + (0) * LDS_A + lofs + RPP * 0 * LDK) = a00;
        if (NA > 1) *(uint4*)(As + (0) * LDS_A + lofs + RPP * 1 * LDK) = a01;
        if (NA > 2) *(uint4*)(As + (0) * LDS_A + lofs + RPP * 2 * LDK) = a02;
        if (NA > 3) *(uint4*)(As + (0) * LDS_A + lofs + RPP * 3 * LDK) = a03;
        if (NB > 0) *(uint4*)(Bs + (0) * LDS_B + lofs + RPP * 0 * LDK) = b00;
        if (NB > 1) *(uint4*)(Bs + (0) * LDS_B + lofs + RPP * 1 * LDK) = b01;
        if (NB > 2) *(uint4*)(Bs + (0) * LDS_B + lofs + RPP * 2 * LDK) = b02;
        if (NB > 3) *(uint4*)(Bs + (0) * LDS_B + lofs + RPP * 3 * LDK) = b03;
      }
      __syncthreads();
    }
    epi.template run<MI, NI>(acc, m0 + wm * (BM / 2), n0 + wn * (BN / 2), lr, lh, part);
  }
}

struct EpiEvIn {
  bf16_t* PN; bf16_t* PT; float* gates; const float* gate_b;
  template <int MI, int NI> DI void run(f32x16 (&acc)[MI][NI], int rbase, int cbase, int lr, int lh, bool part) const {
#pragma unroll
    for (int ni = 0; ni < NI; ++ni) {
      const int col = cbase + ni * 32 + lr; const int seg = col >> 9, cc = col & 511;
      int nat = -1, tr = -1; float scale = 1.f;
      switch (seg) {
        case 0: nat = 0; scale = 0.08838834764831845f; break;
        case 1: nat = 512; tr = 0; break;
        case 2: tr = 512; break;
        case 3: nat = 1024; break;
        case 4: nat = 1536; break;
        case 5: nat = 2048; break;
        case 6: nat = 2560; break;
        case 7: tr = 1024; break;
        case 8: nat = 3072; break;
        default: break;
      }
#pragma unroll
      for (int mi = 0; mi < MI; ++mi)
#pragma unroll
        for (int g = 0; g < 4; ++g) {
          const int row = rbase + mi * 32 + 8 * g + 4 * lh;
          float v0 = acc[mi][ni][4 * g] * scale, v1 = acc[mi][ni][4 * g + 1] * scale, v2 = acc[mi][ni][4 * g + 2] * scale, v3 = acc[mi][ni][4 * g + 3] * scale;
          if (seg == 9) {
            if (cc < 16) { float b = gate_b[cc];
              gates[(size_t)row * 16 + cc] = v0 + b; gates[(size_t)(row + 1) * 16 + cc] = v1 + b; gates[(size_t)(row + 2) * 16 + cc] = v2 + b; gates[(size_t)(row + 3) * 16 + cc] = v3 + b; }
          } else {
            if (nat >= 0) { bf16_t* d = PN + (size_t)row * PNW + nat + cc; d[0] = f2bf(v0); d[PNW] = f2bf(v1); d[2 * PNW] = f2bf(v2); d[3 * PNW] = f2bf(v3); }
            if (tr >= 0) *(uint2*)(PT + (size_t)(tr + cc) * M + row) = pack4(v0, v1, v2, v3);
          }
        }
    }
  }
};

struct EpiResid {
  const float* xin_p; const float* xin_s; float* X; const float* gmod;
  template <int MI, int NI> DI void run(f32x16 (&acc)[MI][NI], int rbase, int cbase, int lr, int lh, bool part) const {
#pragma unroll
    for (int ni = 0; ni < NI; ++ni) {
      const int col = cbase + ni * 32 + lr;
#pragma unroll
      for (int mi = 0; mi < MI; ++mi) {
        const int r0 = rbase + mi * 32; const int j = r0 < MP ? 0 : 1 + ((r0 - MP) >> 11);
        const float gv = gmod[j * 6144 + col];
#pragma unroll
        for (int gg = 0; gg < 4; ++gg) {
          const int row = rbase + mi * 32 + 8 * gg + 4 * lh;
          const float* xi = (row < MP ? xin_p + (size_t)row * D : xin_s + (size_t)(row - MP) * D) + col;
          float* xo = X + (size_t)row * D + col;
#pragma unroll
          for (int e = 0; e < 4; ++e) {
            if (part) atomicAdd(xo + (size_t)e * D, gv * acc[mi][ni][4 * gg + e]);
            else xo[(size_t)e * D] = xi[(size_t)e * D] + gv * acc[mi][ni][4 * gg + e];
          }
        }
      }
    }
  }
};

struct EpiFFUp {
  bf16_t* U;
  template <int MI, int NI> DI void run(f32x16 (&acc)[MI][NI], int rbase, int cbase, int lr, int lh, bool part) const {
    static_assert(NI == 2, "ffn up needs paired tiles");
    const int oc = (cbase >> 6) * 32 + lr;
#pragma unroll
    for (int mi = 0; mi < MI; ++mi)
#pragma unroll
      for (int g = 0; g < 4; ++g) {
        const int row = rbase + mi * 32 + 8 * g + 4 * lh;
#pragma unroll
        for (int e = 0; e < 4; ++e) {
          float a1 = acc[mi][0][4 * g + e], a3 = acc[mi][1][4 * g + e];
          U[(size_t)(row + e) * DFF + oc] = f2bf(a1 * __frcp_rn(1.f + __expf(-a1)) * a3);
        }
      }
  }
};

struct EpiOdIn {
  bf16_t* Q; bf16_t* Kb; bf16_t* VT; float* AK; float* AV; const float* rope;
  template <int MI, int NI> DI void run(f32x16 (&acc)[MI][NI], int rbase, int cbase, int lr, int lh, bool part) const {
#pragma unroll
    for (int ni = 0; ni < NI; ++ni) {
      const int col = cbase + ni * 32 + lr; const int seg = col >> 10, cc = col & 1023; const int d = col & 127;
#pragma unroll
      for (int mi = 0; mi < MI; ++mi)
#pragma unroll
        for (int g = 0; g < 4; ++g) {
          const bool sample = (rbase + mi * 32) >= MP;
          const int row = rbase + mi * 32 + 8 * g + 4 * lh;
          float v[4];
#pragma unroll
          for (int e = 0; e < 4; ++e) v[e] = acc[mi][ni][4 * g + e];
          if (seg < 2) {
            if (sample) {
#pragma unroll
              for (int e = 0; e < 4; ++e) {
                float pv = __shfl_xor(v[e], 16);
                int n = (row + e - MP) & 2047; int pos = (d & 32) ? (n & 63) : (n >> 6);
                float2 cs = *(const float2*)(rope + (pos * 16 + (d & 15)) * 2);
                v[e] = (d & 16) ? (pv * cs.y + v[e] * cs.x) : (v[e] * cs.x - pv * cs.y);
              }
            }
            if (seg == 0) {
#pragma unroll
              for (int e = 0; e < 4; ++e) Q[(size_t)(row + e) * 1024 + cc] = f2bf(v[e] * 0.18033688011112042f);
            } else {
#pragma unroll
              for (int e = 0; e < 4; ++e) Kb[(size_t)(row + e) * 1024 + cc] = f2bf(v[e]);
              if (!sample) {
#pragma unroll
                for (int e = 0; e < 4; ++e) AK[(size_t)(row + e) * 1024 + cc] = v[e];
              }
            }
          } else {
            *(uint2*)(VT + (size_t)cc * M + row) = pack4(v[0], v[1], v[2], v[3]);
            if (!sample) {
#pragma unroll
              for (int e = 0; e < 4; ++e) AV[(size_t)(row + e) * 1024 + cc] = v[e];
            }
          }
        }
    }
  }
};

DI void s1_phase(const Params& p, unsigned char* smem) {
  bf16_t* Vt = (bf16_t*)smem;
  bf16_t* Ktf = Vt + 128 * 72;
  bf16_t* Ktb = Ktf + 128 * 72;
  float* wgf = (float*)(Ktb + 128 * 72);
  float* wgb = wgf + 64;
  const bf16_t* PN = (const bf16_t*)(p.ws + OFF_PN);
  const bf16_t* PT = (const bf16_t*)(p.ws + OFF_PT);
  const float* GATES = (const float*)(p.ws + OFF_GATES);
  float* SCAL = (float*)(p.ws + OFF_SCAL);
  float* NLOC = (float*)(p.ws + OFF_NLOC);
  float* AL = (float*)(p.ws + OFF_AL);
  bf16_t* MLST = (bf16_t*)(p.ws + OFF_ST);
  bf16_t* HGST = (bf16_t*)(p.out);
  const int tid = threadIdx.x, lane = tid & 63, wave = tid >> 6, lr = lane & 31, lh = lane >> 5;
  for (int item = blockIdx.x; item < 1536; item += gridDim.x) {
    const int kind = item >= 768; const int it = item - kind * 768; const int gc = it >> 2, h = it & 3; const int tok0 = gc * 64;
    const int slot0 = it * 2;
    if (kind == 0) {
      load_tile_128x64(Vt, PT + (size_t)(512 + h * 128) * M + tok0, M);
      uint4 rk[4];
      const bf16_t* PTk = PT + (size_t)(h * 128) * M + tok0;
#pragma unroll
      for (int i = 0; i < 4; ++i) { int c = tid + 256 * i; rk[i] = *(const uint4*)(PTk + (size_t)(c >> 3) * M + (c & 7) * 8); }
      if (wave == 0) {
        const float* gp = GATES + (size_t)(tok0 + lane) * 16;
        float igf = gp[h], igb = gp[4 + h], lff = logsig(gp[8 + h]), lfb = logsig(gp[12 + h]);
        float bfw = lff;
#pragma unroll
        for (int o = 1; o < 64; o <<= 1) { float t = __shfl_up(bfw, o); if (lane >= o) bfw += t; }
        float blf = __shfl(bfw, 63);
        float gf = blf - bfw + igf; float mlocf = wmax(gf); wgf[lane] = expf(gf - mlocf);
        float bbw = lfb;
#pragma unroll
        for (int o = 1; o < 64; o <<= 1) { float t = __shfl_down(bbw, o); if (lane + o < 64) bbw += t; }
        float blb = __shfl(bbw, 0);
        float gb = blb - bbw + igb; float mlocb = wmax(gb); wgb[lane] = expf(gb - mlocb);
        if (lane == 0) { SCAL[slot0 * 4 + 0] = blf; SCAL[slot0 * 4 + 1] = mlocf; SCAL[(slot0 + 1) * 4 + 0] = blb; SCAL[(slot0 + 1) * 4 + 1] = mlocb; }
      }
      __syncthreads();
#pragma unroll
      for (int i = 0; i < 4; ++i) {
        int c = tid + 256 * i; int row = c >> 3, ch = c & 7;
        unsigned w[4] = {rk[i].x, rk[i].y, rk[i].z, rk[i].w};
        unsigned of[4], ob[4];
#pragma unroll
        for (int q = 0; q < 4; ++q) {
          float k0 = lo_bf(w[q]), k1 = hi_bf(w[q]);
          int t = ch * 8 + q * 2;
          of[q] = pack2(k0 * wgf[t], k1 * wgf[t + 1]); ob[q] = pack2(k0 * wgb[t], k1 * wgb[t + 1]);
        }
        *(uint4*)(Ktf + row * 72 + ch * 8) = make_uint4(of[0], of[1], of[2], of[3]);
        *(uint4*)(Ktb + row * 72 + ch * 8) = make_uint4(ob[0], ob[1], ob[2], ob[3]);
      }
    } else {
      bf16_t* Xf = Vt;
      bf16_t* Xb = (bf16_t*)(smem + 55808);
      load_tile_64x128(Xf, PN + (size_t)tok0 * PNW + 2048 + h * 128, PNW);
      load_tile_64x128(Xb, PN + (size_t)tok0 * PNW + 2560 + h * 128, PNW);
      __syncthreads();
      const int dir = tid >> 7, dk = tid & 127; const int ch = h * 128 + dk;
      const float lb = 1.f / (1.f + expf(p.ev_lb_logits[512 + ch] - p.ev_lb_logits[ch]));
      const bf16_t* xs = dir ? Xb : Xf;
      bf16_t* Kt = dir ? Ktb : Ktf;
      float R = 1.f;
#pragma unroll 2
      for (int s = 0; s < 64; ++s) {
        int t = dir ? s : 63 - s;
        float x = bf2f(xs[t * 136 + dk]); float f = lb + (1.f - lb) * __frcp_rn(1.f + __expf(-x));
        Kt[dk * 72 + t] = f2bf((1.f - f) * R); R *= f;
      }
      AL[(slot0 + dir) * 128 + dk] = R;
      __syncthreads();
      load_tile_128x64(Vt, PT + (size_t)(1024 + h * 128) * M + tok0, M);
    }
    __syncthreads();
    bf16_t* ST = kind ? HGST : MLST;
#pragma unroll 1
    for (int dir = 0; dir < 2; ++dir) {
      const bf16_t* Kt = dir ? Ktb : Ktf;
      f32x16 acc[4];
#pragma unroll
      for (int ni = 0; ni < 4; ++ni) acc[ni] = zero16();
#pragma unroll
      for (int ks = 0; ks < 4; ++ks) {
        bf16x8 a = ld8(Kt + (wave * 32 + lr) * 72 + ks * 16 + lh * 8);
#pragma unroll
        for (int ni = 0; ni < 4; ++ni) { bf16x8 b = ld8(Vt + (ni * 32 + lr) * 72 + ks * 16 + lh * 8); acc[ni] = MFMA(a, b, acc[ni]); }
      }
      bf16_t* dst = ST + (size_t)(slot0 + dir) * 16384;
#pragma unroll
      for (int ni = 0; ni < 4; ++ni)
#pragma unroll
        for (int g = 0; g < 4; ++g)
          *(uint2*)(dst + (ni * 32 + lr) * 128 + wave * 32 + 8 * g + 4 * lh) = pack4(acc[ni][4 * g], acc[ni][4 * g + 1], acc[ni][4 * g + 2], acc[ni][4 * g + 3]);
    }
    if (kind == 0) {
      const int dir = tid >> 7, dk = tid & 127; const bf16_t* Kt = dir ? Ktb : Ktf; float s = 0.f;
#pragma unroll 8
      for (int t = 0; t < 64; ++t) s += bf2f(Kt[dk * 72 + t]);
      NLOC[(slot0 + dir) * 128 + dk] = s;
    }
    __syncthreads();
  }
}

DI void s2_phase(const Params& p, unsigned char* smem) {
  const float* __restrict__ SCAL = (const float*)(p.ws + OFF_SCAL);
  float* __restrict__ MINIT = (float*)(p.ws + OFF_MINIT);
  const float* __restrict__ NLOC = (const float*)(p.ws + OFF_NLOC);
  float* __restrict__ NINIT = (float*)(p.ws + OFF_NINIT);
  const float* __restrict__ AL = (const float*)(p.ws + OFF_AL);
  bf16_t* MLST = (bf16_t*)(p.ws + OFF_ST);
  bf16_t* HGST = (bf16_t*)(p.out);
  float* tl = (float*)smem;
  const int tid = threadIdx.x;
  for (int u = blockIdx.x; u < 4352; u += gridDim.x) {
    int kind, sample, seq, h, dir, slab;
    if (u < 256) { kind = u >> 7; int v = u & 127; slab = v & 7; v >>= 3; dir = v & 1; v >>= 1; h = v & 3; seq = v >> 2; sample = 1; }
    else { int v = u - 256; kind = v >= 2048; v -= kind * 2048; slab = v & 7; v >>= 3; dir = v & 1; v >>= 1; h = v & 3; seq = v >> 2; sample = 0; }
    const int nc = sample ? 32 : 4; const int gc0 = sample ? 128 + seq * 32 : seq * 4;
    bf16_t* ST = kind ? HGST : MLST;
    const int e = slab * 2048 + tid * 8; const int dv = e >> 7, dk0 = e & 127;
    float st[8]; float nst = 0.f, m = 0.f;
    const int sidx = (seq * 2 + dir) * 4 + h;
    if (sample) {
      const float* S0 = (kind ? p.st_S : p.st_C) + (size_t)sidx * 16384;
#pragma unroll
      for (int j = 0; j < 8; ++j) st[j] = S0[(dk0 + j) * 128 + dv];
      if (kind == 0) { m = p.st_m[sidx]; if (slab == 0 && tid < 128) nst = p.st_n[sidx * 128 + tid]; }
    } else {
#pragma unroll
      for (int j = 0; j < 8; ++j) st[j] = 0.f;
    }
    const int slot0 = ((gc0 + (dir ? nc - 1 : 0)) * 4 + h) * 2 + dir;
    const int sstep = dir ? -8 : 8;
    uint4 Lq[4]; float4 Aq0[4], Aq1[4]; float2 Sq[4]; float Nq[4];
    const bool nthr = (kind == 0) && (slab == 0) && (tid < 128);
#pragma unroll
    for (int i = 0; i < 4; ++i) {
      const int sl = slot0 + i * sstep;
      Lq[i] = *(const uint4*)(ST + (size_t)sl * 16384 + e);
      Aq0[i] = make_float4(0.f, 0.f, 0.f, 0.f); Aq1[i] = Aq0[i]; Sq[i] = make_float2(0.f, 0.f); Nq[i] = 0.f;
      if (kind) { Aq0[i] = *(const float4*)(AL + sl * 128 + dk0); Aq1[i] = *(const float4*)(AL + sl * 128 + dk0 + 4); }
      else { Sq[i] = *(const float2*)(SCAL + sl * 4); if (nthr) Nq[i] = NLOC[sl * 128 + tid]; }
    }
    for (int ps = 0; ps < nc; ps += 4) {
#pragma unroll
      for (int i = 0; i < 4; ++i) {
        const int slot = slot0 + (ps + i) * sstep;
        const uint4 Lc = Lq[i];
        float dec[8]; float ls;
        if (kind == 0) {
          const float bl = Sq[i].x, mloc = Sq[i].y; const float mn = fmaxf(bl + m, mloc); const float d = __expf(bl + m - mn); ls = __expf(mloc - mn);
#pragma unroll
          for (int j = 0; j < 8; ++j) dec[j] = d;
          if (slab == 0) { if (tid == 0) MINIT[slot] = m; if (tid < 128) { NINIT[slot * 128 + tid] = nst; nst = d * nst + ls * Nq[i]; } }
          m = mn;
        } else {
          ls = 1.f;
          dec[0] = Aq0[i].x; dec[1] = Aq0[i].y; dec[2] = Aq0[i].z; dec[3] = Aq0[i].w;
          dec[4] = Aq1[i].x; dec[5] = Aq1[i].y; dec[6] = Aq1[i].z; dec[7] = Aq1[i].w;
        }
        *(uint4*)(ST + (size_t)slot * 16384 + e) = make_uint4(pack2(st[0], st[1]), pack2(st[2], st[3]), pack2(st[4], st[5]), pack2(st[6], st[7]));
        float l[8] = {lo_bf(Lc.x), hi_bf(Lc.x), lo_bf(Lc.y), hi_bf(Lc.y), lo_bf(Lc.z), hi_bf(Lc.z), lo_bf(Lc.w), hi_bf(Lc.w)};
#pragma unroll
        for (int j = 0; j < 8; ++j) st[j] = dec[j] * st[j] + ls * l[j];
        if (ps + i + 4 < nc) {
          const int sl = slot + 4 * sstep;
          Lq[i] = *(const uint4*)(ST + (size_t)sl * 16384 + e);
          if (kind) { Aq0[i] = *(const float4*)(AL + sl * 128 + dk0); Aq1[i] = *(const float4*)(AL + sl * 128 + dk0 + 4); }
          else { Sq[i] = *(const float2*)(SCAL + sl * 4); if (nthr) Nq[i] = NLOC[sl * 128 + tid]; }
        }
      }
    }
    if (!sample) {
#pragma unroll
      for (int j = 0; j < 8; ++j) tl[(dk0 + j) * 17 + (dv & 15)] = st[j];
      __syncthreads();
      float* Co = p.out + (kind ? OUT_S : OUT_C) + (size_t)sidx * 16384;
      const int dkr = tid >> 1, hf = tid & 1;
      float4 o0, o1;
      o0.x = tl[dkr * 17 + hf * 8 + 0]; o0.y = tl[dkr * 17 + hf * 8 + 1]; o0.z = tl[dkr * 17 + hf * 8 + 2]; o0.w = tl[dkr * 17 + hf * 8 + 3];
      o1.x = tl[dkr * 17 + hf * 8 + 4]; o1.y = tl[dkr * 17 + hf * 8 + 5]; o1.z = tl[dkr * 17 + hf * 8 + 6]; o1.w = tl[dkr * 17 + hf * 8 + 7];
      *(float4*)(Co + dkr * 128 + slab * 16 + hf * 8) = o0;
      *(float4*)(Co + dkr * 128 + slab * 16 + hf * 8 + 4) = o1;
      if (kind == 0 && slab == 0) { if (tid < 128) p.out[OUT_N + sidx * 128 + tid] = nst; if (tid == 0) p.out[OUT_M + sidx] = m; }
      __syncthreads();
    }
  }
}

DI void s3_epilogue(const float* Hs, const float* gain, const bf16_t* gate_src, bf16_t* mix_dst, bool use_silu) {
  const int tid = threadIdx.x, t = tid >> 2, part = tid & 3;
  const float* hr = Hs + t * 132 + part * 32;
  float ss = 0.f;
#pragma unroll
  for (int i = 0; i < 8; ++i) { float4 v = *(const float4*)(hr + i * 4); ss += v.x * v.x + v.y * v.y + v.z * v.z + v.w * v.w; }
  ss += __shfl_xor(ss, 1); ss += __shfl_xor(ss, 2);
  const float rstd = rsqrtf(ss * (1.f / 128.f) + 1e-6f);
#pragma unroll
  for (int i = 0; i < 8; ++i) {
    const int d = part * 32 + i * 4;
    float4 v = *(const float4*)(hr + i * 4); float4 g4 = *(const float4*)(gain + d);
    uint2 gs = *(const uint2*)(gate_src + (size_t)t * PNW + d);
    float x0 = lo_bf(gs.x), x1 = hi_bf(gs.x), x2 = lo_bf(gs.y), x3 = hi_bf(gs.y);
    float s0 = __frcp_rn(1.f + __expf(-x0)), s1 = __frcp_rn(1.f + __expf(-x1)), s2 = __frcp_rn(1.f + __expf(-x2)), s3 = __frcp_rn(1.f + __expf(-x3));
    if (use_silu) { s0 *= x0; s1 *= x1; s2 *= x2; s3 *= x3; }
    *(uint2*)(mix_dst + (size_t)t * 1024 + d) = pack4(v.x * rstd * g4.x * s0, v.y * rstd * g4.y * s1, v.z * rstd * g4.z * s2, v.w * rstd * g4.w * s3);
  }
}

DI void s3_phase(const Params& p, unsigned char* smem) {
  const bf16_t* PN = (const bf16_t*)(p.ws + OFF_PN);
  const bf16_t* PT = (const bf16_t*)(p.ws + OFF_PT);
  const float* GATES = (const float*)(p.ws + OFF_GATES);
  const float* SCAL = (const float*)(p.ws + OFF_SCAL);
  const float* NINIT = (const float*)(p.ws + OFF_NINIT);
  const float* MINIT = (const float*)(p.ws + OFF_MINIT);
  const bf16_t* MLST = (const bf16_t*)(p.ws + OFF_ST);
  const bf16_t* HGST = (const bf16_t*)(p.out);
  bf16_t* MIX = (bf16_t*)(p.out + OUT_AK);
  const int tid = threadIdx.x, lane = tid & 63, wave = tid >> 6, lr = lane & 31, lh = lane >> 5, wm = wave >> 1, wn = wave & 1;
  float* Hs = (float*)smem;
  for (int item = blockIdx.x; item < 1536; item += gridDim.x) {
    const int kind = item >= 768; const int it = item - kind * 768; const int gc = it >> 2, h = it & 3; const int tok0 = gc * 64;
    const int slotf = it * 2, slotb = it * 2 + 1;
    if (kind == 0) {
      bf16_t* Qs = (bf16_t*)smem;
      bf16_t* Ks = Qs + 64 * 136;
      bf16_t* Vt = Ks + 64 * 136;
      bf16_t* Pf = Vt + 128 * 72;
      bf16_t* Pb = Pf + 64 * 72;
      float* fa = (float*)(Pb + 64 * 72);
      float* rF = fa, *cF = fa + 64, *wF = fa + 128, *mtF = fa + 192, *rB = fa + 256, *cB = fa + 320, *wB = fa + 384, *mtB = fa + 448;
      float* facPf = fa + 512, *facPb = fa + 576, *facIf = fa + 640, *facIb = fa + 704;
      float* nF = fa + 768, *nB = fa + 896, *qnF = fa + 1024, *qnB = fa + 1088;
      load_tile_64x128(Qs, PN + (size_t)tok0 * PNW + h * 128, PNW);
      load_tile_64x128(Ks, PN + (size_t)tok0 * PNW + 512 + h * 128, PNW);
      load_tile_128x64(Vt, PT + (size_t)(512 + h * 128) * M + tok0, M);
      if (wave == 0) {
        const float* gp = GATES + (size_t)(tok0 + lane) * 16;
        float igf = gp[h], igb = gp[4 + h], lff = logsig(gp[8 + h]), lfb = logsig(gp[12 + h]);
        float bfw = lff;
#pragma unroll
        for (int o = 1; o < 64; o <<= 1) { float t = __shfl_up(bfw, o); if (lane >= o) bfw += t; }
        float cf = igf - bfw; float pm = cf;
#pragma unroll
        for (int o = 1; o < 64; o <<= 1) { float t = __shfl_up(pm, o); if (lane >= o) pm = fmaxf(pm, t); }
        float mF = MINIT[slotf];
        float interF = bfw + mF; float mt = fmaxf(interF, bfw + pm);
        rF[lane] = bfw - mt; cF[lane] = cf; wF[lane] = expf(interF - mt); mtF[lane] = mt;
        float bbw = lfb;
#pragma unroll
        for (int o = 1; o < 64; o <<= 1) { float t = __shfl_down(bbw, o); if (lane + o < 64) bbw += t; }
        float cb = igb - bbw; float sm = cb;
#pragma unroll
        for (int o = 1; o < 64; o <<= 1) { float t = __shfl_down(sm, o); if (lane + o < 64) sm = fmaxf(sm, t); }
        float mB = MINIT[slotb];
        float interB = bbw + mB; float mt2 = fmaxf(interB, bbw + sm);
        rB[lane] = bbw - mt2; cB[lane] = cb; wB[lane] = expf(interB - mt2); mtB[lane] = mt2;
      }
      if (wave >= 2) { int i = tid - 128; nF[i] = NINIT[slotf * 128 + i]; nB[i] = NINIT[slotb * 128 + i]; }
      __syncthreads();
      {
        f32x16 s = zero16();
#pragma unroll
        for (int ks = 0; ks < 8; ++ks) { bf16x8 a = ld8(Qs + (wm * 32 + lr) * 136 + ks * 16 + lh * 8); bf16x8 b = ld8(Ks + (wn * 32 + lr) * 136 + ks * 16 + lh * 8); s = MFMA(a, b, s); }
        const int sidx = wn * 32 + lr; const float cfs = cF[sidx], cbs = cB[sidx];
#pragma unroll
        for (int i = 0; i < 16; ++i) {
          const int t = wm * 32 + crow(i, lh);
          float pf = (sidx <= t) ? s[i] * __expf(rF[t] + cfs) : 0.f;
          float pb = (sidx >= t) ? s[i] * __expf(rB[t] + cbs) : 0.f;
          Pf[t * 72 + sidx] = f2bf(pf); Pb[t * 72 + sidx] = f2bf(pb);
        }
        const int t = tid >> 2, part = tid & 3; float sf = 0.f, sb = 0.f;
#pragma unroll 8
        for (int d = part * 32; d < part * 32 + 32; ++d) { float q = bf2f(Qs[t * 136 + d]); sf += q * nF[d]; sb += q * nB[d]; }
        sf += __shfl_xor(sf, 1); sf += __shfl_xor(sf, 2); sb += __shfl_xor(sb, 1); sb += __shfl_xor(sb, 2);
        if (part == 0) { qnF[t] = sf; qnB[t] = sb; }
      }
      __syncthreads();
      {
        const int t = tid >> 2, part = tid & 3; float sf = 0.f, sb = 0.f;
#pragma unroll
        for (int j = 0; j < 16; ++j) { sf += bf2f(Pf[t * 72 + part * 16 + j]); sb += bf2f(Pb[t * 72 + part * 16 + j]); }
        sf += __shfl_xor(sf, 1); sf += __shfl_xor(sf, 2); sb += __shfl_xor(sb, 1); sb += __shfl_xor(sb, 2);
        if (part == 0) {
          float denf = wF[t] * qnF[t] + sf; float Nf = fmaxf(fabsf(denf), expf(-mtF[t])); facPf[t] = 1.f / Nf; facIf[t] = wF[t] / Nf;
          float denb = wB[t] * qnB[t] + sb; float Nb = fmaxf(fabsf(denb), expf(-mtB[t])); facPb[t] = 1.f / Nb; facIb[t] = wB[t] / Nb;
        }
      }
      __syncthreads();
      f32x16 hacc[2]; hacc[0] = zero16(); hacc[1] = zero16();
#pragma unroll
      for (int pd = 0; pd < 2; ++pd) {
        __builtin_amdgcn_sched_barrier(0);
        const bf16_t* Pm = pd ? Pb : Pf; const float* fac = pd ? facPb : facPf;
        f32x16 t0[2]; t0[0] = zero16(); t0[1] = zero16();
#pragma unroll
        for (int ks = 0; ks < 4; ++ks) {
          bf16x8 bv = ld8(Vt + (wave * 32 + lr) * 72 + ks * 16 + lh * 8);
#pragma unroll
          for (int mi = 0; mi < 2; ++mi) t0[mi] = MFMA(ld8(Pm + (mi * 32 + lr) * 72 + ks * 16 + lh * 8), bv, t0[mi]);
        }
#pragma unroll
        for (int mi = 0; mi < 2; ++mi)
#pragma unroll
          for (int i = 0; i < 16; ++i) hacc[mi][i] += t0[mi][i] * fac[mi * 32 + crow(i, lh)];
      }
#pragma unroll
      for (int pd = 0; pd < 2; ++pd) {
        __builtin_amdgcn_sched_barrier(0);
        const bf16_t* Cm = MLST + (size_t)(pd ? slotb : slotf) * 16384 + (wave * 32 + lr) * 128 + lh * 8;
        const float* fac = pd ? facIb : facIf;
        f32x16 t0[2]; t0[0] = zero16(); t0[1] = zero16();
#pragma unroll
        for (int ks = 0; ks < 8; ++ks) {
          bf16x8 b0 = ld8(Cm + ks * 16);
#pragma unroll
          for (int mi = 0; mi < 2; ++mi) t0[mi] = MFMA(ld8(Qs + (mi * 32 + lr) * 136 + ks * 16 + lh * 8), b0, t0[mi]);
        }
#pragma unroll
        for (int mi = 0; mi < 2; ++mi)
#pragma unroll
          for (int i = 0; i < 16; ++i) hacc[mi][i] += t0[mi][i] * fac[mi * 32 + crow(i, lh)];
      }
      __syncthreads();
#pragma unroll
      for (int mi = 0; mi < 2; ++mi)
#pragma unroll
        for (int i = 0; i < 16; ++i) Hs[(mi * 32 + crow(i, lh)) * 132 + wave * 32 + lr] = hacc[mi][i];
      __syncthreads();
      s3_epilogue(Hs, p.ml_norm_g + h * 128, PN + (size_t)tok0 * PNW + 1024 + h * 128, MIX + (size_t)tok0 * 1024 + h * 128, false);
      __syncthreads();
    } else {
      bf16_t* QF = (bf16_t*)smem;
      bf16_t* QB = QF + 64 * 136;
      bf16_t* KF = QB + 64 * 136;
      bf16_t* KB = KF + 9216;
      bf16_t* P = KF;
      bf16_t* It = KB;
      load_tile_64x128(KF, PN + (size_t)tok0 * PNW + 2048 + h * 128, PNW);
      load_tile_64x128(KB, PN + (size_t)tok0 * PNW + 2560 + h * 128, PNW);
      load_tile_64x128(QF, PN + (size_t)tok0 * PNW + 1536 + h * 128, PNW);
      load_tile_64x128(QB, PN + (size_t)tok0 * PNW + 1536 + h * 128, PNW);
      __syncthreads();
      {
        const int dir = tid >> 7, dk = tid & 127; const int ch = h * 128 + dk;
        const float lb = 1.f / (1.f + expf(p.ev_lb_logits[512 + ch] - p.ev_lb_logits[ch]));
        bf16_t* Qd = dir ? QB : QF; bf16_t* Kd = dir ? KB : KF;
        float P = 1.f;
#pragma unroll 2
        for (int s = 0; s < 64; ++s) {
          int t = dir ? 63 - s : s;
          float x = bf2f(Kd[t * 136 + dk]); float f = lb + (1.f - lb) * __frcp_rn(1.f + __expf(-x));
          P *= f;
          float q = bf2f(Qd[t * 136 + dk]);
          Qd[t * 136 + dk] = f2bf(q * P); Kd[t * 136 + dk] = f2bf((1.f - f) * __frcp_rn(fmaxf(P, 1.8e-35f)));
        }
      }
      __syncthreads();
      f32x16 pacc;
      {
        f32x16 sf = zero16(), sb = zero16();
#pragma unroll
        for (int ks = 0; ks < 8; ++ks) {
          sf = MFMA(ld8(QF + (wm * 32 + lr) * 136 + ks * 16 + lh * 8), ld8(KF + (wn * 32 + lr) * 136 + ks * 16 + lh * 8), sf);
          sb = MFMA(ld8(QB + (wm * 32 + lr) * 136 + ks * 16 + lh * 8), ld8(KB + (wn * 32 + lr) * 136 + ks * 16 + lh * 8), sb);
        }
        const int sidx = wn * 32 + lr;
#pragma unroll
        for (int i = 0; i < 16; ++i) { const int t = wm * 32 + crow(i, lh); pacc[i] = ((sidx <= t) ? sf[i] : 0.f) + ((sidx >= t) ? sb[i] : 0.f); }
      }
      f32x16 o[2]; o[0] = zero16(); o[1] = zero16();
      {
        const bf16_t* Sf = HGST + (size_t)slotf * 16384 + (wave * 32 + lr) * 128 + lh * 8;
        const bf16_t* Sb = HGST + (size_t)slotb * 16384 + (wave * 32 + lr) * 128 + lh * 8;
#pragma unroll
        for (int ks = 0; ks < 8; ++ks) {
          bf16x8 b0 = ld8(Sf + ks * 16), b1 = ld8(Sb + ks * 16);
#pragma unroll
          for (int mi = 0; mi < 2; ++mi) {
            o[mi] = MFMA(ld8(QF + (mi * 32 + lr) * 136 + ks * 16 + lh * 8), b0, o[mi]);
            o[mi] = MFMA(ld8(QB + (mi * 32 + lr) * 136 + ks * 16 + lh * 8), b1, o[mi]);
          }
        }
      }
      __syncthreads();
      {
        const int sidx = wn * 32 + lr;
#pragma unroll
        for (int i = 0; i < 16; ++i) P[(wm * 32 + crow(i, lh)) * 72 + sidx] = f2bf(pacc[i]);
      }
      load_tile_128x64(It, PT + (size_t)(1024 + h * 128) * M + tok0, M);
      __syncthreads();
#pragma unroll
      for (int ks = 0; ks < 4; ++ks) {
        bf16x8 bv = ld8(It + (wave * 32 + lr) * 72 + ks * 16 + lh * 8);
#pragma unroll
        for (int mi = 0; mi < 2; ++mi) o[mi] = MFMA(ld8(P + (mi * 32 + lr) * 72 + ks * 16 + lh * 8), bv, o[mi]);
      }
#pragma unroll
      for (int mi = 0; mi < 2; ++mi)
#pragma unroll
        for (int i = 0; i < 16; ++i) Hs[(mi * 32 + crow(i, lh)) * 132 + wave * 32 + lr] = o[mi][i];
      __syncthreads();
      s3_epilogue(Hs, p.hg_norm_g + h * 128, PN + (size_t)tok0 * PNW + 3072 + h * 128, MIX + (size_t)tok0 * 1024 + 512 + h * 128, true);
      __syncthreads();
    }
  }
}

DI void online_softmax(f32x16& s, float& m, float& l, f32x16 (&O)[4], bf16x8& p0, bf16x8& p1) {
  float mx = s[0];
#pragma unroll
  for (int i = 1; i < 16; ++i) mx = fmaxf(mx, s[i]);
  { auto r = __builtin_amdgcn_permlane32_swap(__float_as_uint(mx), __float_as_uint(mx), false, false); mx = fmaxf(__uint_as_float(r[0]), __uint_as_float(r[1])); }
  const float mn = fmaxf(m, mx);
  if (__ballot(mn > m) != 0ull) {
    const float alpha = __builtin_amdgcn_exp2f(m - mn);
    l *= alpha;
#pragma unroll
    for (int mt = 0; mt < 4; ++mt)
#pragma unroll
      for (int i = 0; i < 16; ++i) O[mt][i] *= alpha;
    m = mn;
  }
  float sum = 0.f;
#pragma unroll
  for (int i = 0; i < 16; ++i) { s[i] = __builtin_amdgcn_exp2f(s[i] - m); sum += s[i]; }
  l += sum;
  uint4 u0 = make_uint4(pack2(s[0], s[1]), pack2(s[2], s[3]), pack2(s[4], s[5]), pack2(s[6], s[7]));
  uint4 u1 = make_uint4(pack2(s[8], s[9]), pack2(s[10], s[11]), pack2(s[12], s[13]), pack2(s[14], s[15]));
  p0 = __builtin_bit_cast(bf16x8, u0); p1 = __builtin_bit_cast(bf16x8, u1);
}

#define ATTN_GLOAD(KT) do { \
    const int kt_ = (KT); const bf16_t* ksrc; size_t kld; const bf16_t* vsrc; size_t vld; \
    if (sample && kt_ < 4) { ksrc = KC + ((size_t)(seq * 8 + h) * 256 + kt_ * 64) * 128; kld = 128; vsrc = VCT + (size_t)(seq * 8 + h) * 128 * 256 + kt_ * 64; vld = 256; } \
    else { const int kt2 = sample ? kt_ - 4 : kt_; const int t0 = tokbase + kt2 * 64; ksrc = Kb + (size_t)t0 * 1024 + h * 128; kld = 1024; vsrc = VT + (size_t)(h * 128) * M + t0; vld = M; } \
    ksrc += (size_t)(tid >> 4) * kld + (tid & 15) * 8; vsrc += (size_t)(tid >> 3) * vld + (tid & 7) * 8; \
    rk0 = *(const uint4*)(ksrc); rk1 = *(const uint4*)(ksrc + 16 * kld); rk2 = *(const uint4*)(ksrc + 32 * kld); rk3 = *(const uint4*)(ksrc + 48 * kld); \
    rv0 = *(const uint4*)(vsrc); rv1 = *(const uint4*)(vsrc + 32 * vld); rv2 = *(const uint4*)(vsrc + 64 * vld); rv3 = *(const uint4*)(vsrc + 96 * vld); } while (0)
#define ATTN_LSTORE(KD, VD) do { \
    bf16_t* kd_ = (KD) + (tid >> 4) * 136 + (tid & 15) * 8; bf16_t* vd_ = (VD) + (tid >> 3) * 72 + (tid & 7) * 8; \
    *(uint4*)(kd_) = rk0; *(uint4*)(kd_ + 16 * 136) = rk1; *(uint4*)(kd_ + 32 * 136) = rk2; *(uint4*)(kd_ + 48 * 136) = rk3; \
    *(uint4*)(vd_) = rv0; *(uint4*)(vd_ + 32 * 72) = rv1; *(uint4*)(vd_ + 64 * 72) = rv2; *(uint4*)(vd_ + 96 * 72) = rv3; } while (0)

DI void attn_phase(const Params& p, unsigned char* smem) {
  bf16_t* Ks = (bf16_t*)smem;
  bf16_t* Vts = Ks + 64 * 136;
  float* Cmb = (float*)smem;
  const bf16_t* Q = (const bf16_t*)(p.ws + OFF_Q);
  const bf16_t* Kb = (const bf16_t*)(p.ws + OFF_KB);
  const bf16_t* VT = (const bf16_t*)(p.ws + OFF_VT);
  const bf16_t* KC = (const bf16_t*)(p.ws + OFF_KC);
  const bf16_t* VCT = (const bf16_t*)(p.ws + OFF_VCT);
  bf16_t* ATT = (bf16_t*)(p.ws + OFF_ATT);
  const float* MISC = (const float*)(p.ws + OFF_MISC);
  const float lam = MISC[0], lam_init = MISC[1];
  const int tid = threadIdx.x, lane = tid & 63, wave = tid >> 6, lr = lane & 31, lh = lane >> 5;
  const int br = wave >> 1, qw = wave & 1;
  for (int vit = blockIdx.x; vit < 1536; vit += gridDim.x) {
    int item = vit;
    {
      const int b = vit & 511, rnd = vit >> 9; const int xcd = b & 7, slot = b >> 3;
      if (rnd == 0) item = ((xcd * 2 + (slot >> 5)) << 5) | (slot & 31);
      else item = 512 + (((xcd * 32 + (slot >> 1)) << 2) | (((slot & 1) << 1) | (rnd - 1)));
    }
    int sample, seq, h, qb;
    if (item < 512) { sample = 1; qb = item & 31; h = (item >> 5) & 7; seq = item >> 8; }
    else { int v = item - 512; sample = 0; qb = v & 3; h = (v >> 2) & 7; seq = v >> 5; }
    const int tokbase = sample ? MP + seq * 2048 : seq * 256;
    const int nkt = sample ? 36 : 4;
    const int qtok = tokbase + qb * 64 + qw * 32 + lr;
    bf16x8 q[4];
    {
      const bf16_t* qp = Q + (size_t)qtok * 1024 + h * 128 + br * 64 + lh * 8;
#pragma unroll
      for (int s = 0; s < 4; ++s) q[s] = ld8(qp + s * 16);
    }
    f32x16 O[4];
#pragma unroll
    for (int mt = 0; mt < 4; ++mt) O[mt] = zero16();
    float m = -1e30f, l = 0.f;
    uint4 rk0, rk1, rk2, rk3, rv0, rv1, rv2, rv3;
    ATTN_GLOAD(0);
    __syncthreads();
    ATTN_LSTORE(Ks, Vts);
    __syncthreads();
    for (int kt = 0; kt < nkt; ++kt) {
      const int cur = kt & 1;
      if (kt + 1 < nkt) ATTN_GLOAD(kt + 1);
      const bf16_t* Kc = Ks + cur * 17920; const bf16_t* Vc = Vts + cur * 17920;
#pragma unroll
      for (int sub = 0; sub < 2; ++sub) {
        f32x16 s1 = zero16();
#pragma unroll
        for (int s = 0; s < 4; ++s) s1 = MFMA(ld8(Kc + (sub * 32 + lr) * 136 + br * 64 + s * 16 + lh * 8), q[s], s1);
        bf16x8 pa[2];
        online_softmax(s1, m, l, O, pa[0], pa[1]);
#pragma unroll
        for (int k2 = 0; k2 < 2; ++k2)
#pragma unroll
          for (int mt = 0; mt < 4; ++mt) {
            const bf16_t* vp = Vc + (mt * 32 + lr) * 72 + sub * 32 + k2 * 16 + 4 * lh;
            uint2 lo = *(const uint2*)vp, hi = *(const uint2*)(vp + 8);
            bf16x8 vf = __builtin_bit_cast(bf16x8, make_uint4(lo.x, lo.y, hi.x, hi.y));
            O[mt] = MFMA(vf, pa[k2], O[mt]);
          }
      }
      if (kt + 1 < nkt) ATTN_LSTORE(Ks + (cur ^ 1) * 17920, Vts + (cur ^ 1) * 17920);
      __syncthreads();
    }
    l += __shfl_xor(l, 32);
    const float inv = br ? lam / l : 1.f / l;
    __syncthreads();
    if (br == 1) {
#pragma unroll
      for (int mt = 0; mt < 4; ++mt)
#pragma unroll
        for (int i = 0; i < 16; ++i) Cmb[(qw * 64 + mt * 16 + i) * 64 + lane] = O[mt][i] * inv;
    }
    __syncthreads();
    if (br == 0) {
      float ss = 0.f;
#pragma unroll
      for (int mt = 0; mt < 4; ++mt)
#pragma unroll
        for (int i = 0; i < 16; ++i) { float o = O[mt][i] * inv - Cmb[(qw * 64 + mt * 16 + i) * 64 + lane]; O[mt][i] = o; ss += o * o; }
      ss += __shfl_xor(ss, 32);
      const float sc = rsqrtf(ss * (1.f / 128.f) + 1e-6f) * (1.f - lam_init);
      bf16_t* dst = ATT + (size_t)qtok * 1024 + h * 128;
#pragma unroll
      for (int mt = 0; mt < 4; ++mt)
#pragma unroll
        for (int g = 0; g < 4; ++g) {
          const int dv = mt * 32 + 8 * g + 4 * lh;
          float4 g4 = *(const float4*)(p.da_norm_g + dv);
          *(uint2*)(dst + dv) = pack4(O[mt][4 * g] * sc * g4.x, O[mt][4 * g + 1] * sc * g4.y, O[mt][4 * g + 2] * sc * g4.z, O[mt][4 * g + 3] * sc * g4.w);
        }
    }
  }
}

__global__ void __launch_bounds__(256, 2) mega(Params p) {
  __shared__ __attribute__((aligned(16))) unsigned char smem[SMEM_BYTES];
  cg::grid_group grid = cg::this_grid();
  unsigned char* ws = p.ws;
  float* MOD = (float*)(ws + OFF_MOD);
  float* X = p.out + OUT_Y;
  bf16_t* A = (bf16_t*)(ws + OFF_A);
  bf16_t* U = (bf16_t*)(ws + OFF_U);

  __shared__ uint4 xb_words;
  unsigned* bar = (unsigned*)(ws + OFF_BAR);
  if (threadIdx.x == 0) xb_words = make_uint4(0u, 0u, 0u, 0u);
  __syncthreads();
  XcdBarrier xb = xcd_barrier_post(bar, (volatile LAS unsigned*)&xb_words);
  if (p.ws == nullptr) grid.sync();
  for (int rep = 0; rep < REP_P0; ++rep) phase0(p, smem);
  xcd_barrier(xb);
  norm_phase(p.x_prompt, p.x_sample, p.norm_mix_g, MOD, 1024, 0, A);
  xcd_barrier(xb);
  {
    EpiEvIn e{(bf16_t*)(ws + OFF_PN), (bf16_t*)(ws + OFF_PT), (float*)(ws + OFF_GATES), p.ev_gate_b};
    for (int rep = 0; rep < REP_G; ++rep) gemm_phase<128, 128, 64, false>(A, 1024, (const bf16_t*)(ws + OFF_W_EVIN), 1024, M, 4736, 1024, e, smem);
  }
  xcd_barrier(xb);
  for (int rep = 0; rep < REP_MIX; ++rep) s1_phase(p, smem);
  xcd_barrier(xb);
  s2_phase(p, smem);
  xcd_barrier(xb);
  for (int rep = 0; rep < REP_MIX; ++rep) s3_phase(p, smem);
  xcd_barrier(xb);
  {
    EpiResid e{p.x_prompt, p.x_sample, X, MOD + 2048};
    gemm_phase<128, 64, 64, false>((const bf16_t*)(p.out + OUT_AK), 1024, (const bf16_t*)(ws + OFF_W_EVOUT), 1024, M, 1024, 1024, e, smem);
  }
  xcd_barrier(xb);
  norm_phase(X, X + (size_t)MP * D, p.norm_ffn_g, MOD, 4096, 3072, A);
  xcd_barrier(xb);
  {
    EpiFFUp e{U};
    for (int rep = 0; rep < REP_G; ++rep) gemm_phase<128, 128, 64, false>(A, 1024, (const bf16_t*)(ws + OFF_W_FFU0), 1024, M, 5632, 1024, e, smem);
  }
  xcd_barrier(xb);
  {
    EpiResid e{X, X + (size_t)MP * D, X, MOD + 5120};
    gemm_phase<128, 128, 64, true>(U, DFF, (const bf16_t*)(ws + OFF_W_FFD0), DFF, M, 1024, DFF, e, smem);
  }
  xcd_barrier(xb);
  norm_phase(X, X + (size_t)MP * D, p.norm_mix_g + 1024, MOD + 3 * 6144, 1024, 0, A);
  xcd_barrier(xb);
  {
    EpiOdIn e{(bf16_t*)(ws + OFF_Q), (bf16_t*)(ws + OFF_KB), (bf16_t*)(ws + OFF_VT), p.out + OUT_AK, p.out + OUT_AV, (const float*)(ws + OFF_ROPE)};
    for (int rep = 0; rep < REP_G; ++rep) gemm_phase<128, 128, 64, false>(A, 1024, (const bf16_t*)(ws + OFF_W_ODIN), 1024, M, 3072, 1024, e, smem);
  }
  xcd_barrier(xb);
  for (int rep = 0; rep < REP_ATT; ++rep) attn_phase(p, smem);
  xcd_barrier(xb);
  {
    EpiResid e{X, X + (size_t)MP * D, X, MOD + 3 * 6144 + 2048};
    gemm_phase<128, 128, 64, true>((const bf16_t*)(ws + OFF_ATT), 1024, (const bf16_t*)(ws + OFF_W_ODOUT), 1024, M, 1024, 1024, e, smem);
  }
  xcd_barrier(xb);
  norm_phase(X, X + (size_t)MP * D, p.norm_ffn_g + 1024, MOD + 3 * 6144, 4096, 3072, A);
  xcd_barrier(xb);
  {
    EpiFFUp e{U};
    for (int rep = 0; rep < REP_G; ++rep) gemm_phase<128, 128, 64, false>(A, 1024, (const bf16_t*)(ws + OFF_W_FFU1), 1024, M, 5632, 1024, e, smem);
  }
  xcd_barrier(xb);
  {
    EpiResid e{X, X + (size_t)MP * D, X, MOD + 3 * 6144 + 5120};
    gemm_phase<128, 128, 64, true>(U, DFF, (const bf16_t*)(ws + OFF_W_FFD1), DFF, M, 1024, DFF, e, smem);
  }
  xcd_barrier(xb);
  final_norm_phase(X, p.final_norm_g);
}

extern "C" void kernel_launch(void* const* d_in, const int* in_sizes, int n_in, void* d_out, int out_size, void* d_ws, size_t ws_size, hipStream_t stream) {
  static int grid_blocks = 0;
  if (!grid_blocks) {
    int dev = 0, cus = 0, per_cu = 0;
    (void)hipGetDevice(&dev);
    (void)hipDeviceGetAttribute(&cus, hipDeviceAttributeMultiprocessorCount, dev);
    (void)hipOccupancyMaxActiveBlocksPerMultiprocessor(&per_cu, mega, 256, 0);
    per_cu = 2;
    grid_blocks = cus * per_cu;
    if (ws_size < WS_END) { fprintf(stderr, "kernel_launch: workspace too small: %zu < %zu\n", ws_size, (size_t)WS_END); grid_blocks = -1; }
  }
  if (grid_blocks < 0) return;
  (void)hipMemsetAsync((unsigned char*)d_ws + OFF_BAR, 0, 16384, stream);
  Params p{};
  const float** pp = (const float**)&p;
  for (int i = 0; i < 28; ++i) pp[i] = (const float*)d_in[i];
  p.out = (float*)d_out; p.ws = (unsigned char*)d_ws;
  void* args[] = {&p};
  hipError_t e = hipLaunchCooperativeKernel((void*)mega, dim3(grid_blocks), dim3(256), args, 0, stream);
  if (e != hipSuccess) fprintf(stderr, "cooperative launch failed: %s (grid %d)\n", hipGetErrorString(e), grid_blocks);
}
```

```cpp
#include <hip/hip_runtime.h>
#include <hip/hip_cooperative_groups.h>
#include <cstdio>
namespace cg = cooperative_groups;

typedef unsigned short bf16_t;
using bf16x8 = __attribute__((ext_vector_type(8))) short;
using f32x16 = __attribute__((ext_vector_type(16))) float;
#define DI __device__ __forceinline__
#define MFMA(a, b, c) __builtin_amdgcn_mfma_f32_32x32x16_bf16((a), (b), (c), 0, 0, 0)

constexpr int D = 1024;
constexpr int M = 12288;
constexpr int MP = 8192;
constexpr int DFF = 2816;
constexpr int PNW = 3584;
constexpr int SMEM_BYTES = 77824;
#ifndef REP_G
#define REP_G 1
#endif
#ifndef REP_P0
#define REP_P0 1
#endif
#ifndef REP_MIX
#define REP_MIX 1
#endif
#ifndef REP_ATT
#define REP_ATT 1
#endif

constexpr size_t OFF_W_EVIN = 0;
constexpr size_t OFF_W_EVOUT = OFF_W_EVIN + (size_t)4736 * 1024 * 2;
constexpr size_t OFF_W_FFU0 = OFF_W_EVOUT + (size_t)1024 * 1024 * 2;
constexpr size_t OFF_W_FFU1 = OFF_W_FFU0 + (size_t)5632 * 1024 * 2;
constexpr size_t OFF_W_FFD0 = OFF_W_FFU1 + (size_t)5632 * 1024 * 2;
constexpr size_t OFF_W_FFD1 = OFF_W_FFD0 + (size_t)1024 * 2816 * 2;
constexpr size_t OFF_W_ODIN = OFF_W_FFD1 + (size_t)1024 * 2816 * 2;
constexpr size_t OFF_W_ODOUT = OFF_W_ODIN + (size_t)3072 * 1024 * 2;
constexpr size_t OFF_MOD = OFF_W_ODOUT + (size_t)1024 * 1024 * 2;
constexpr size_t OFF_ROPE = OFF_MOD + (size_t)2 * 3 * 6144 * 4;
constexpr size_t OFF_MISC = OFF_ROPE + 8192;
constexpr size_t OFF_BAR = OFF_MISC + 256;
constexpr size_t OFF_GATES = OFF_BAR + 16384;
constexpr size_t OFF_KC = OFF_GATES + (size_t)M * 16 * 4;
constexpr size_t OFF_VCT = OFF_KC + (size_t)2 * 8 * 256 * 128 * 2;
constexpr size_t OFF_NLOC = OFF_VCT + (size_t)2 * 8 * 256 * 128 * 2;
constexpr size_t OFF_NINIT = OFF_NLOC + (size_t)1536 * 128 * 4;
constexpr size_t OFF_SCAL = OFF_NINIT + (size_t)1536 * 128 * 4;
constexpr size_t OFF_MINIT = OFF_SCAL + (size_t)1536 * 4 * 4;
constexpr size_t OFF_AL = OFF_MINIT + (size_t)1536 * 4;
constexpr size_t OFF_PN = OFF_AL + (size_t)1536 * 128 * 4;
constexpr size_t OFF_PT = OFF_PN + (size_t)M * PNW * 2;
constexpr size_t OFF_ST = OFF_PT + (size_t)1536 * M * 2;
constexpr size_t WS_END = OFF_ST + (size_t)1536 * 16384 * 2;
constexpr size_t OFF_A = OFF_ST;
constexpr size_t OFF_ATT = OFF_ST + (size_t)M * 1024 * 2;
constexpr size_t OFF_U = OFF_PN;
constexpr size_t OFF_Q = OFF_PN;
constexpr size_t OFF_KB = OFF_PN + (size_t)M * 1024 * 2;
constexpr size_t OFF_VT = OFF_PN + (size_t)2 * M * 1024 * 2;
constexpr size_t OUT_Y = 0;
constexpr size_t OUT_AK = (size_t)M * 1024;
constexpr size_t OUT_AV = OUT_AK + (size_t)MP * 1024;
constexpr size_t OUT_C = OUT_AV + (size_t)MP * 1024;
constexpr size_t OUT_N = OUT_C + (size_t)32 * 2 * 4 * 16384;
constexpr size_t OUT_M = OUT_N + (size_t)32 * 2 * 4 * 128;
constexpr size_t OUT_S = OUT_M + 256;

struct Params {
  const float *x_prompt, *x_sample, *c, *c_ctx, *cache_k, *cache_v, *st_C, *st_n, *st_m, *st_S;
  const float *ada_w, *ada_b, *norm_mix_g, *norm_ffn_g, *ev_w_in, *ev_gate_b, *ev_lb_logits, *ml_norm_g, *hg_norm_g;
  const float *ev_w_out, *od_w_in, *od_lambda, *da_norm_g, *od_w_out, *ffn_w1, *ffn_w3, *ffn_w2, *final_norm_g;
  float* out;
  unsigned char* ws;
};

typedef __bf16 bf16v2 __attribute__((ext_vector_type(2)));
typedef float f32v2 __attribute__((ext_vector_type(2)));
DI unsigned short f2bf(float x) { return __builtin_bit_cast(unsigned short, (__bf16)x); }
DI float bf2f(unsigned short h) { return __uint_as_float(((unsigned)h) << 16); }
DI unsigned pack2(float a, float b) { f32v2 v = {a, b}; return __builtin_bit_cast(unsigned, __builtin_convertvector(v, bf16v2)); }
DI uint2 pack4(float a, float b, float c, float d) { return make_uint2(pack2(a, b), pack2(c, d)); }
DI float lo_bf(unsigned u) { return __uint_as_float(u << 16); }
DI float hi_bf(unsigned u) { return __uint_as_float(u & 0xffff0000u); }
DI int crow(int reg, int h) { return (reg & 3) + 8 * (reg >> 2) + 4 * h; }
DI float wsum(float v) {
#pragma unroll
  for (int o = 32; o > 0; o >>= 1) v += __shfl_xor(v, o);
  return v;
}
DI float wmax(float v) {
#pragma unroll
  for (int o = 32; o > 0; o >>= 1) v = fmaxf(v, __shfl_xor(v, o));
  return v;
}
DI float logsig(float x) { return fminf(x, 0.f) - log1pf(expf(-fabsf(x))); }
DI float sigmoidf(float x) { return 1.f / (1.f + expf(-x)); }
DI f32x16 zero16() { f32x16 z;
#pragma unroll
  for (int i = 0; i < 16; ++i) z[i] = 0.f;
  return z; }
DI bf16x8 ld8(const bf16_t* p) { return *(const bf16x8*)p; }


#define XB_TMO      128
#define XB_XCNT(j)  (256  + 64 * (j))
#define XB_XSUB(j)  (1280 + 64 * (j))
#define XB_XGEN(j)  (2304 + 64 * (j))
#define XB_TOP      3328
#define XB_TOPGEN   3392
#define XCD_BAR_WORDS 3456
#define XB_SPIN_CAP (1u << 22)
#define LAS __attribute__((address_space(3)))
DI unsigned xb_ld(unsigned* p)              { return __hip_atomic_load(p, __ATOMIC_RELAXED, __HIP_MEMORY_SCOPE_AGENT); }
DI unsigned xb_add(unsigned* p, unsigned v) { return __hip_atomic_fetch_add(p, v, __ATOMIC_RELAXED, __HIP_MEMORY_SCOPE_AGENT); }
DI unsigned xb_xcc_id() { return (unsigned)__builtin_amdgcn_s_getreg((3 << 11) | 20) & 0xFu; }
#define XB_SPIN(cond, bar) do { unsigned _sp = 0; while (cond) { __builtin_amdgcn_s_sleep(1); \
    if ((++_sp & 255u) == 0u) { if (xb_ld(&(bar)[XB_TMO])) break; if (_sp > XB_SPIN_CAP) { atomicAdd(&(bar)[XB_TMO], 1u); break; } } } } while (0)
struct XcdBarrier { unsigned* bar; unsigned x; volatile LAS unsigned* st; };
DI XcdBarrier xcd_barrier_post(unsigned* bar, volatile LAS unsigned* st) {
  XcdBarrier b; b.bar = bar; b.x = xb_xcc_id(); b.st = st;
  if (threadIdx.x == 0) (void)xb_add(&bar[XB_XCNT(b.x)], 1u);
  return b;
}
DI void xcd_barrier_complete(unsigned* bar, unsigned x, unsigned& nloc, unsigned& nx) {
  const unsigned G = gridDim.x * gridDim.y * gridDim.z;
  unsigned sum, cnt, mine, sp = 0u;
  for (;;) {
    sum = 0u; cnt = 0u; mine = 0u;
#pragma unroll
    for (unsigned j = 0; j < 16; ++j) { const unsigned c = xb_ld(&bar[XB_XCNT(j)]); sum += c; cnt += (c > 0u) ? 1u : 0u; mine = (j == x) ? c : mine; }
    if (sum == G) break;
    __builtin_amdgcn_s_sleep(1);
    if ((++sp & 255u) == 0u) { if (xb_ld(&bar[XB_TMO])) break; if (sp > XB_SPIN_CAP) { atomicAdd(&bar[XB_TMO], 1u); break; } }
  }
  nloc = mine > 0u ? mine : 1u; nx = cnt > 0u ? cnt : 1u;
}
DI void xcd_barrier(const XcdBarrier& b) {
  asm volatile("s_waitcnt vmcnt(0)" ::: "memory");
  __syncthreads();
  if (threadIdx.x == 0) {
    unsigned* bar = b.bar;
    __builtin_amdgcn_s_waitcnt(0);
    unsigned nloc = b.st[0], nx = b.st[1];
    if (nloc == 0u) { xcd_barrier_complete(bar, b.x, nloc, nx); b.st[0] = nloc; b.st[1] = nx; }
    const unsigned old = xb_add(&bar[XB_XSUB(b.x)], 1u);
    const unsigned gen = old / nloc;
    if (old + 1u == (gen + 1u) * nloc) {
      __builtin_amdgcn_fence(__ATOMIC_RELEASE, "agent");
      asm volatile("s_waitcnt vmcnt(0)" ::: "memory");
      const unsigned og = xb_add(&bar[XB_TOP], 1u);
      const unsigned tg = og / nx;
      if (og + 1u == (tg + 1u) * nx) xb_add(&bar[XB_TOPGEN], 1u);
      else XB_SPIN(xb_ld(&bar[XB_TOPGEN]) == tg, bar);
      __builtin_amdgcn_fence(__ATOMIC_ACQUIRE, "agent");
      xb_add(&bar[XB_XGEN(b.x)], 1u);
      asm volatile("s_waitcnt vmcnt(0)" ::: "memory");
    } else {
      XB_SPIN(xb_ld(&bar[XB_XGEN(b.x)]) == gen, bar);
      __builtin_amdgcn_fence(__ATOMIC_ACQUIRE, "agent");
      asm volatile("s_waitcnt vmcnt(0)" ::: "memory");
    }
  }
  __syncthreads();
}

DI void load_tile_64x128(bf16_t* dst, const bf16_t* src, size_t ld) {
  const int tid = threadIdx.x;
#pragma unroll
  for (int i = 0; i < 4; ++i) { int c = tid + 256 * i; int row = c >> 4, ch = c & 15; *(uint4*)(dst + row * 136 + ch * 8) = *(const uint4*)(src + (size_t)row * ld + ch * 8); }
}
DI void load_tile_128x64(bf16_t* dst, const bf16_t* src, size_t ld) {
  const int tid = threadIdx.x;
#pragma unroll
  for (int i = 0; i < 4; ++i) { int c = tid + 256 * i; int row = c >> 3, ch = c & 7; *(uint4*)(dst + row * 72 + ch * 8) = *(const uint4*)(src + (size_t)row * ld + ch * 8); }
}

struct TDesc { const float* src0; const float* src1; bf16_t* dst; int srcN, K, kind, tn, tk; };
DI TDesc tdecode(const Params& p, int t) {
  TDesc d; d.src1 = nullptr;
  if (t < 1184) { d.src0 = p.ev_w_in; d.srcN = 4624; d.K = 1024; d.dst = (bf16_t*)(p.ws + OFF_W_EVIN); d.kind = 1; d.tn = t / 16; d.tk = t % 16; }
  else if (t < 1440) { t -= 1184; d.src0 = p.ev_w_out; d.srcN = 1024; d.K = 1024; d.dst = (bf16_t*)(p.ws + OFF_W_EVOUT); d.kind = 0; d.tn = t / 16; d.tk = t % 16; }
  else if (t < 4256) { t -= 1440; int l = t / 1408; t -= l * 1408; d.src0 = p.ffn_w1 + (size_t)l * 1024 * DFF; d.src1 = p.ffn_w3 + (size_t)l * 1024 * DFF; d.srcN = DFF; d.K = 1024;
    d.dst = (bf16_t*)(p.ws + (l ? OFF_W_FFU1 : OFF_W_FFU0)); d.kind = 2; d.tn = t / 16; d.tk = t % 16; }
  else if (t < 5664) { t -= 4256; int l = t / 704; t -= l * 704; d.src0 = p.ffn_w2 + (size_t)l * DFF * 1024; d.srcN = 1024; d.K = DFF;
    d.dst = (bf16_t*)(p.ws + (l ? OFF_W_FFD1 : OFF_W_FFD0)); d.kind = 0; d.tn = t / 44; d.tk = t % 44; }
  else if (t < 6432) { t -= 5664; d.src0 = p.od_w_in; d.srcN = 3072; d.K = 1024; d.dst = (bf16_t*)(p.ws + OFF_W_ODIN); d.kind = 0; d.tn = t / 16; d.tk = t % 16; }
  else { t -= 6432; d.src0 = p.od_w_out; d.srcN = 1024; d.K = 1024; d.dst = (bf16_t*)(p.ws + OFF_W_ODOUT); d.kind = 0; d.tn = t / 16; d.tk = t % 16; }
  return d;
}
DI void t_load(const TDesc& d, float4& v0, float4& v1, float4& v2, float4& v3) {
  const int tid = threadIdx.x; const int c4 = (tid & 15) * 4, kr = tid >> 4;
  const int n = d.tn * 64 + c4;
  const float* src = d.src0; int sc;
  if (d.kind == 0) sc = n;
  else if (d.kind == 1) sc = n < 2048 ? n : (n < 4608 ? n + 16 : (n < 4624 ? n - 4608 + 2048 : -1));
  else { int jb = n >> 6, r = n & 63; src = (r < 32) ? d.src0 : d.src1; sc = jb * 32 + (r & 31); }
  v0 = v1 = v2 = v3 = make_float4(0.f, 0.f, 0.f, 0.f);
  if (sc >= 0) {
    const float* b = src + (size_t)(d.tk * 64 + kr) * d.srcN + sc;
    v0 = *(const float4*)(b); v1 = *(const float4*)(b + (size_t)16 * d.srcN); v2 = *(const float4*)(b + (size_t)32 * d.srcN); v3 = *(const float4*)(b + (size_t)48 * d.srcN);
  }
}
DI void t_ldsw(float* lds, const float4& v0, const float4& v1, const float4& v2, const float4& v3) {
  const int tid = threadIdx.x; const int c4 = (tid & 15) * 4, kr = tid >> 4;
  float* d = lds + kr * 65 + c4;
  d[0] = v0.x; d[1] = v0.y; d[2] = v0.z; d[3] = v0.w;
  d[16 * 65] = v1.x; d[16 * 65 + 1] = v1.y; d[16 * 65 + 2] = v1.z; d[16 * 65 + 3] = v1.w;
  d[32 * 65] = v2.x; d[32 * 65 + 1] = v2.y; d[32 * 65 + 2] = v2.z; d[32 * 65 + 3] = v2.w;
  d[48 * 65] = v3.x; d[48 * 65 + 1] = v3.y; d[48 * 65 + 2] = v3.z; d[48 * 65 + 3] = v3.w;
}
DI void t_store(const TDesc& d, const float* lds) {
  const int tid = threadIdx.x; const int nn = tid >> 2, kq = (tid & 3) * 16;
  unsigned w[8];
#pragma unroll
  for (int j = 0; j < 8; ++j) w[j] = pack2(lds[(kq + 2 * j) * 65 + nn], lds[(kq + 2 * j + 1) * 65 + nn]);
  bf16_t* o = d.dst + (size_t)(d.tn * 64 + nn) * d.K + d.tk * 64 + kq;
  *(uint4*)o = make_uint4(w[0], w[1], w[2], w[3]);
  *(uint4*)(o + 8) = make_uint4(w[4], w[5], w[6], w[7]);
}

DI void mod_unit(const Params& p, int u, float* lds) {
  float* sil = lds; float* red = lds + 3072;
  float* MOD = (float*)(p.ws + OFF_MOD);
  const int tid = threadIdx.x;
  for (int i = tid; i < 3072; i += 256) { int j = i >> 10, k = i & 1023; float v = (j == 0) ? p.c_ctx[k] : p.c[(j - 1) * 1024 + k]; sil[i] = v / (1.f + expf(-v)); }
  __syncthreads();
  const int l = u / 48, cb = u % 48; const int cgp = tid & 31, kg = tid >> 5;
  const float* w = p.ada_w + (size_t)l * 1024 * 6144 + cb * 128 + cgp * 4;
  float a0x = 0, a0y = 0, a0z = 0, a0w = 0, a1x = 0, a1y = 0, a1z = 0, a1w = 0, a2x = 0, a2y = 0, a2z = 0, a2w = 0;
#pragma unroll 4
  for (int k = kg * 128; k < kg * 128 + 128; ++k) {
    float4 wv = *(const float4*)(w + (size_t)k * 6144);
    float s0 = sil[k], s1 = sil[1024 + k], s2 = sil[2048 + k];
    a0x += s0 * wv.x; a0y += s0 * wv.y; a0z += s0 * wv.z; a0w += s0 * wv.w;
    a1x += s1 * wv.x; a1y += s1 * wv.y; a1z += s1 * wv.z; a1w += s1 * wv.w;
    a2x += s2 * wv.x; a2y += s2 * wv.y; a2z += s2 * wv.z; a2w += s2 * wv.w;
  }
  float* r0 = red + (kg * 3 + 0) * 128 + cgp * 4; r0[0] = a0x; r0[1] = a0y; r0[2] = a0z; r0[3] = a0w;
  float* r1 = red + (kg * 3 + 1) * 128 + cgp * 4; r1[0] = a1x; r1[1] = a1y; r1[2] = a1z; r1[3] = a1w;
  float* r2 = red + (kg * 3 + 2) * 128 + cgp * 4; r2[0] = a2x; r2[1] = a2y; r2[2] = a2z; r2[3] = a2w;
  __syncthreads();
  for (int i = tid; i < 384; i += 256) {
    int j = i >> 7, cc = i & 127; float s = 0;
#pragma unroll
    for (int g = 0; g < 8; ++g) s += red[(g * 3 + j) * 128 + cc];
    s += p.ada_b[l * 6144 + cb * 128 + cc];
    MOD[(l * 3 + j) * 6144 + cb * 128 + cc] = s;
  }
  __syncthreads();
}

DI void phase0(const Params& p, unsigned char* smem) {
  float* lds = (float*)smem;
  const int tid = threadIdx.x;
  {
    int item = blockIdx.x;
    if (item < 96) { mod_unit(p, item, lds); item += gridDim.x; }
    float4 v0, v1, v2, v3;
    TDesc cur = tdecode(p, 0);
    bool have = item < 6784;
    if (have) { cur = tdecode(p, item - 96); t_load(cur, v0, v1, v2, v3); }
    while (have) {
      t_ldsw(lds, v0, v1, v2, v3);
      const int nitem = item + gridDim.x; const bool hn = nitem < 6784;
      TDesc nxt = cur;
      if (hn) { nxt = tdecode(p, nitem - 96); t_load(nxt, v0, v1, v2, v3); }
      __syncthreads();
      t_store(cur, lds);
      __syncthreads();
      cur = nxt; item = nitem; have = hn;
    }
  }
  for (int item = blockIdx.x; item < 7041; item += gridDim.x) {
    if (item < 6784) continue;
    int t = item - 96;
    t -= 6688;
    if (t < 256) {
      bf16_t* KC = (bf16_t*)(p.ws + OFF_KC); bf16_t* VCT = (bf16_t*)(p.ws + OFF_VCT);
#pragma unroll 4
      for (int j = 0; j < 16; ++j) {
        int idx = t * 4096 + j * 256 + tid;
        if (idx < 524288) { int d = idx & 127, key = (idx >> 7) & 255, h = (idx >> 15) & 7, b = idx >> 18;
          KC[idx] = f2bf(p.cache_k[((size_t)(b * 256 + key) * 8 + h) * 128 + d]); }
        else { int i2 = idx - 524288; int key = i2 & 255, dv = (i2 >> 8) & 127, h = (i2 >> 15) & 7, b = i2 >> 18;
          VCT[i2] = f2bf(p.cache_v[((size_t)(b * 256 + key) * 8 + h) * 128 + dv]); }
      }
      continue;
    }
    float* ROPE = (float*)(p.ws + OFF_ROPE); float* MISC = (float*)(p.ws + OFF_MISC);
    for (int idx = tid; idx < 1024; idx += 256) {
      int pos = idx >> 4, i = idx & 15;
      float inv = powf(10000.f, -(float)i / 16.f);
      float ang = (float)pos * inv;
      ROPE[idx * 2] = cosf(ang); ROPE[idx * 2 + 1] = sinf(ang);
    }
    if (tid == 0) {
      float s01 = 0, s23 = 0;
      for (int i = 0; i < 64; ++i) { s01 += p.od_lambda[i] * p.od_lambda[64 + i]; s23 += p.od_lambda[128 + i] * p.od_lambda[192 + i]; }
      const float lam_init = 0.8f - 0.6f * expf(-0.3f);
      MISC[0] = expf(s01) - expf(s23) + lam_init;
      MISC[1] = lam_init;
    }
  }
}

DI void norm_phase(const float* src_p, const float* src_s, const float* gain, const float* mod, int sc_off, int sh_off, bf16_t* A) {
  const int wave = threadIdx.x >> 6, lane = threadIdx.x & 63;
  for (int row = blockIdx.x * 4 + wave; row < M; row += gridDim.x * 4) {
    const float* src = row < MP ? src_p + (size_t)row * D : src_s + (size_t)(row - MP) * D;
    const int j = row < MP ? 0 : 1 + ((row - MP) >> 11);
    float4 v[4]; float ss = 0;
#pragma unroll
    for (int i = 0; i < 4; ++i) { v[i] = *(const float4*)(src + i * 256 + lane * 4); ss += v[i].x * v[i].x + v[i].y * v[i].y + v[i].z * v[i].z + v[i].w * v[i].w; }
    ss = wsum(ss);
    const float rstd = rsqrtf(ss * (1.f / 1024.f) + 1e-6f);
    const float* msc = mod + j * 6144 + sc_off; const float* msh = mod + j * 6144 + sh_off;
#pragma unroll
    for (int i = 0; i < 4; ++i) {
      int c = i * 256 + lane * 4;
      float4 g4 = *(const float4*)(gain + c), sc4 = *(const float4*)(msc + c), sh4 = *(const float4*)(msh + c);
      float o0 = v[i].x * rstd * g4.x * (1.f + sc4.x) + sh4.x;
      float o1 = v[i].y * rstd * g4.y * (1.f + sc4.y) + sh4.y;
      float o2 = v[i].z * rstd * g4.z * (1.f + sc4.z) + sh4.z;
      float o3 = v[i].w * rstd * g4.w * (1.f + sc4.w) + sh4.w;
      *(uint2*)(A + (size_t)row * D + c) = pack4(o0, o1, o2, o3);
    }
  }
}

DI void final_norm_phase(float* X, const float* gain) {
  const int wave = threadIdx.x >> 6, lane = threadIdx.x & 63;
  for (int row = blockIdx.x * 4 + wave; row < M; row += gridDim.x * 4) {
    float* src = X + (size_t)row * D;
    float4 v[4]; float ss = 0;
#pragma unroll
    for (int i = 0; i < 4; ++i) { v[i] = *(const float4*)(src + i * 256 + lane * 4); ss += v[i].x * v[i].x + v[i].y * v[i].y + v[i].z * v[i].z + v[i].w * v[i].w; }
    ss = wsum(ss);
    const float rstd = rsqrtf(ss * (1.f / 1024.f) + 1e-6f);
#pragma unroll
    for (int i = 0; i < 4; ++i) {
      int c = i * 256 + lane * 4;
      float4 g4 = *(const float4*)(gain + c);
      float4 o; o.x = v[i].x * rstd * g4.x; o.y = v[i].y * rstd * g4.y; o.z = v[i].z * rstd * g4.z; o.w = v[i].w * rstd * g4.w;
      *(float4*)(src + c) = o;
    }
  }
}

template <int BM, int BN, int BK, bool SPLIT, class Epi>
DI void gemm_phase(const bf16_t* __restrict__ A, int lda, const bf16_t* __restrict__ Bt, int ldb, int Mrows, int N, int K, const Epi& epi, unsigned char* smem) {
  constexpr int MI = BM / 64, NI = BN / 64;
  constexpr int LDK = BK + 8;
  constexpr int LDS_A = BM * LDK, LDS_B = BN * LDK;
  constexpr int CPR = BK / 8;
  constexpr int RPP = 256 / CPR;
  constexpr int NA = BM / RPP, NB = BN / RPP;
  bf16_t* As = (bf16_t*)smem;
  bf16_t* Bs = As + 2 * LDS_A;
  const int tid = threadIdx.x, lane = tid & 63, wave = tid >> 6, wm = wave >> 1, wn = wave & 1, lr = lane & 31, lh = lane >> 5;
  const int ntm = Mrows / BM, ntn = N / BN, nkfull = K / BK;
  const int lrow = tid / CPR, lch = tid % CPR;
  const int lofs = lrow * LDK + lch * 8;
  const bf16_t* as0 = As + (wm * (BM / 2) + lr) * LDK + lh * 8;
  const bf16_t* bs0 = Bs + (wn * (BN / 2) + lr) * LDK + lh * 8;
  const int ntiles = ntm * ntn;
  const int nfull = SPLIT ? ((int)gridDim.x < ntiles ? (int)gridDim.x : ntiles) : ntiles;
  const int nitems = SPLIT ? nfull + 2 * (ntiles - nfull) : ntiles;
  for (int item = blockIdx.x; item < nitems; item += gridDim.x) {
    int tile = item, kbeg = 0, nk = nkfull; bool part = false;
    if (SPLIT && item >= nfull) { tile = nfull + ((item - nfull) >> 1); nk = nkfull >> 1; kbeg = ((item - nfull) & 1) * nk; part = true; }
    const int tm = tile % ntm, tn = tile / ntm; const int m0 = tm * BM, n0 = tn * BN;
    f32x16 acc[MI][NI];
#pragma unroll
    for (int mi = 0; mi < MI; ++mi)
#pragma unroll
      for (int ni = 0; ni < NI; ++ni) acc[mi][ni] = zero16();
    static_assert(NA <= 4 && NB <= 4, "staging registers");
    uint4 a00, a01, a02, a03, b00, b01, b02, b03, a10, a11, a12, a13, b10, b11, b12, b13;
    a00 = a01 = a02 = a03 = b00 = b01 = b02 = b03 = a10 = a11 = a12 = a13 = b10 = b11 = b12 = b13 = make_uint4(0u, 0u, 0u, 0u);
    const bf16_t* Ag = A + (size_t)(m0 + lrow) * lda + lch * 8 + (size_t)kbeg * BK;
    const bf16_t* Bg = Bt + (size_t)(n0 + lrow) * ldb + lch * 8 + (size_t)kbeg * BK;
    if (NA > 0) a00 = *(const uint4*)(Ag + (size_t)(RPP * 0) * lda + (0) * BK);
    if (NA > 1) a01 = *(const uint4*)(Ag + (size_t)(RPP * 1) * lda + (0) * BK);
    if (NA > 2) a02 = *(const uint4*)(Ag + (size_t)(RPP * 2) * lda + (0) * BK);
    if (NA > 3) a03 = *(const uint4*)(Ag + (size_t)(RPP * 3) * lda + (0) * BK);
    if (NB > 0) b00 = *(const uint4*)(Bg + (size_t)(RPP * 0) * ldb + (0) * BK);
    if (NB > 1) b01 = *(const uint4*)(Bg + (size_t)(RPP * 1) * ldb + (0) * BK);
    if (NB > 2) b02 = *(const uint4*)(Bg + (size_t)(RPP * 2) * ldb + (0) * BK);
    if (NB > 3) b03 = *(const uint4*)(Bg + (size_t)(RPP * 3) * ldb + (0) * BK);
    if (NA > 0) a10 = *(const uint4*)(Ag + (size_t)(RPP * 0) * lda + (1) * BK);
    if (NA > 1) a11 = *(const uint4*)(Ag + (size_t)(RPP * 1) * lda + (1) * BK);
    if (NA > 2) a12 = *(const uint4*)(Ag + (size_t)(RPP * 2) * lda + (1) * BK);
    if (NA > 3) a13 = *(const uint4*)(Ag + (size_t)(RPP * 3) * lda + (1) * BK);
    if (NB > 0) b10 = *(const uint4*)(Bg + (size_t)(RPP * 0) * ldb + (1) * BK);
    if (NB > 1) b11 = *(const uint4*)(Bg + (size_t)(RPP * 1) * ldb + (1) * BK);
    if (NB > 2) b12 = *(const uint4*)(Bg + (size_t)(RPP * 2) * ldb + (1) * BK);
    if (NB > 3) b13 = *(const uint4*)(Bg + (size_t)(RPP * 3) * ldb + (1) * BK);
    if (NA > 0) *(uint4*)(As + (0) * LDS_A + lofs + RPP * 0 * LDK) = a00;
    if (NA > 1) *(uint4*)(As + (0) * LDS_A + lofs + RPP * 1 * LDK) = a01;
    if (NA > 2) *(uint4*)(As + (0) * LDS_A + lofs + RPP * 2 * LDK) = a02;
    if (NA > 3) *(uint4*)(As + (0) * LDS_A + lofs + RPP * 3 * LDK) = a03;
    if (NB > 0) *(uint4*)(Bs + (0) * LDS_B + lofs + RPP * 0 * LDK) = b00;
    if (NB > 1) *(uint4*)(Bs + (0) * LDS_B + lofs + RPP * 1 * LDK) = b01;
    if (NB > 2) *(uint4*)(Bs + (0) * LDS_B + lofs + RPP * 2 * LDK) = b02;
    if (NB > 3) *(uint4*)(Bs + (0) * LDS_B + lofs + RPP * 3 * LDK) = b03;
    __syncthreads();
    for (int kt = 0; kt < nk; kt += 2) {
      if (kt + 2 < nk) {
        if (NA > 0) a00 = *(const uint4*)(Ag + (size_t)(RPP * 0) * lda + (kt + 2) * BK);
        if (NA > 1) a01 = *(const uint4*)(Ag + (size_t)(RPP * 1) * lda + (kt + 2) * BK);
        if (NA > 2) a02 = *(const uint4*)(Ag + (size_t)(RPP * 2) * lda + (kt + 2) * BK);
        if (NA > 3) a03 = *(const uint4*)(Ag + (size_t)(RPP * 3) * lda + (kt + 2) * BK);
        if (NB > 0) b00 = *(const uint4*)(Bg + (size_t)(RPP * 0) * ldb + (kt + 2) * BK);
        if (NB > 1) b01 = *(const uint4*)(Bg + (size_t)(RPP * 1) * ldb + (kt + 2) * BK);
        if (NB > 2) b02 = *(const uint4*)(Bg + (size_t)(RPP * 2) * ldb + (kt + 2) * BK);
        if (NB > 3) b03 = *(const uint4*)(Bg + (size_t)(RPP * 3) * ldb + (kt + 2) * BK);
      }
      {
        __builtin_amdgcn_iglp_opt(1);
        const bf16_t* as = as0 + (0) * LDS_A; const bf16_t* bs = bs0 + (0) * LDS_B;
      #pragma unroll
        for (int ks = 0; ks < BK / 16; ++ks) {
          bf16x8 af[MI], bfr[NI];
      #pragma unroll
          for (int mi = 0; mi < MI; ++mi) af[mi] = ld8(as + mi * 32 * LDK + ks * 16);
      #pragma unroll
          for (int ni = 0; ni < NI; ++ni) bfr[ni] = ld8(bs + ni * 32 * LDK + ks * 16);
      #pragma unroll
          for (int mi = 0; mi < MI; ++mi)
      #pragma unroll
            for (int ni = 0; ni < NI; ++ni) acc[mi][ni] = MFMA(af[mi], bfr[ni], acc[mi][ni]);
        }
      }
      if (NA > 0) *(uint4*)(As + (1) * LDS_A + lofs + RPP * 0 * LDK) = a10;
      if (NA > 1) *(uint4*)(As + (1) * LDS_A + lofs + RPP * 1 * LDK) = a11;
      if (NA > 2) *(uint4*)(As + (1) * LDS_A + lofs + RPP * 2 * LDK) = a12;
      if (NA > 3) *(uint4*)(As + (1) * LDS_A + lofs + RPP * 3 * LDK) = a13;
      if (NB > 0) *(uint4*)(Bs + (1) * LDS_B + lofs + RPP * 0 * LDK) = b10;
      if (NB > 1) *(uint4*)(Bs + (1) * LDS_B + lofs + RPP * 1 * LDK) = b11;
      if (NB > 2) *(uint4*)(Bs + (1) * LDS_B + lofs + RPP * 2 * LDK) = b12;
      if (NB > 3) *(uint4*)(Bs + (1) * LDS_B + lofs + RPP * 3 * LDK) = b13;
      __syncthreads();
      if (kt + 3 < nk) {
        if (NA > 0) a10 = *(const uint4*)(Ag + (size_t)(RPP * 0) * lda + (kt + 3) * BK);
        if (NA > 1) a11 = *(const uint4*)(Ag + (size_t)(RPP * 1) * lda + (kt + 3) * BK);
        if (NA > 2) a12 = *(const uint4*)(Ag + (size_t)(RPP * 2) * lda + (kt + 3) * BK);
        if (NA > 3) a13 = *(const uint4*)(Ag + (size_t)(RPP * 3) * lda + (kt + 3) * BK);
        if (NB > 0) b10 = *(const uint4*)(Bg + (size_t)(RPP * 0) * ldb + (kt + 3) * BK);
        if (NB > 1) b11 = *(const uint4*)(Bg + (size_t)(RPP * 1) * ldb + (kt + 3) * BK);
        if (NB > 2) b12 = *(const uint4*)(Bg + (size_t)(RPP * 2) * ldb + (kt + 3) * BK);
        if (NB > 3) b13 = *(const uint4*)(Bg + (size_t)(RPP * 3) * ldb + (kt + 3) * BK);
      }
      {
        __builtin_amdgcn_iglp_opt(1);
        const bf16_t* as = as0 + (1) * LDS_A; const bf16_t* bs = bs0 + (1) * LDS_B;
      #pragma unroll
        for (int ks = 0; ks < BK / 16; ++ks) {
          bf16x8 af[MI], bfr[NI];
      #pragma unroll
          for (int mi = 0; mi < MI; ++mi) af[mi] = ld8(as + mi * 32 * LDK + ks * 16);
      #pragma unroll
          for (int ni = 0; ni < NI; ++ni) bfr[ni] = ld8(bs + ni * 32 * LDK + ks * 16);
      #pragma unroll
          for (int mi = 0; mi < MI; ++mi)
      #pragma unroll
            for (int ni = 0; ni < NI; ++ni) acc[mi][ni] = MFMA(af[mi], bfr[ni], acc[mi][ni]);
        }
      }
      if (kt + 2 < nk) {
        if (NA > 0) *(uint4*)(As + (0) * LDS_A + lofs + RPP * 0 * LDK) = a00;
        if (NA > 1) *(uint4*)(As + (0) * LDS_A + lofs + RPP * 1 * LDK) = a01;
        if (NA > 2) *(uint4*)(As + (0) * LDS_A + lofs + RPP * 2 * LDK) = a02;
        if (NA > 3) *(uint4*)(As + (0) * LDS_A + lofs + RPP * 3 * LDK) = a03;
        if (NB > 0) *(uint4*)(Bs + (0) * LDS_B + lofs + RPP * 0 * LDK) = b00;
        if (NB > 1) *(uint4*)(Bs + (0) * LDS_B + lofs + RPP * 1 * LDK) = b01;
        if (NB > 2) *(uint4*)(Bs + (0) * LDS_B + lofs + RPP * 2 * LDK) = b02;
        if (NB > 3) *(uint4*)(Bs + (0) * LDS_B + lofs + RPP * 3 * LDK) = b03;
      }
      __syncthreads();
    }
    epi.template run<MI, NI>(acc, m0 + wm * (BM / 2), n0 + wn * (BN / 2), lr, lh, part);
  }
}

struct EpiEvIn {
  bf16_t* PN; bf16_t* PT; float* gates; const float* gate_b;
  template <int MI, int NI> DI void run(f32x16 (&acc)[MI][NI], int rbase, int cbase, int lr, int lh, bool part) const {
#pragma unroll
    for (int ni = 0; ni < NI; ++ni) {
      const int col = cbase + ni * 32 + lr; const int seg = col >> 9, cc = col & 511;
      int nat = -1, tr = -1; float scale = 1.f;
      switch (seg) {
        case 0: nat = 0; scale = 0.08838834764831845f; break;
        case 1: nat = 512; tr = 0; break;
        case 2: tr = 512; break;
        case 3: nat = 1024; break;
        case 4: nat = 1536; break;
        case 5: nat = 2048; break;
        case 6: nat = 2560; break;
        case 7: tr = 1024; break;
        case 8: nat = 3072; break;
        default: break;
      }
#pragma unroll
      for (int mi = 0; mi < MI; ++mi)
#pragma unroll
        for (int g = 0; g < 4; ++g) {
          const int row = rbase + mi * 32 + 8 * g + 4 * lh;
          float v0 = acc[mi][ni][4 * g] * scale, v1 = acc[mi][ni][4 * g + 1] * scale, v2 = acc[mi][ni][4 * g + 2] * scale, v3 = acc[mi][ni][4 * g + 3] * scale;
          if (seg == 9) {
            if (cc < 16) { float b = gate_b[cc];
              gates[(size_t)row * 16 + cc] = v0 + b; gates[(size_t)(row + 1) * 16 + cc] = v1 + b; gates[(size_t)(row + 2) * 16 + cc] = v2 + b; gates[(size_t)(row + 3) * 16 + cc] = v3 + b; }
          } else {
            if (nat >= 0) { bf16_t* d = PN + (size_t)row * PNW + nat + cc; d[0] = f2bf(v0); d[PNW] = f2bf(v1); d[2 * PNW] = f2bf(v2); d[3 * PNW] = f2bf(v3); }
            if (tr >= 0) *(uint2*)(PT + (size_t)(tr + cc) * M + row) = pack4(v0, v1, v2, v3);
          }
        }
    }
  }
};

struct EpiResid {
  const float* xin_p; const float* xin_s; float* X; const float* gmod;
  template <int MI, int NI> DI void run(f32x16 (&acc)[MI][NI], int rbase, int cbase, int lr, int lh, bool part) const {
#pragma unroll
    for (int ni = 0; ni < NI; ++ni) {
      const int col = cbase + ni * 32 + lr;
#pragma unroll
      for (int mi = 0; mi < MI; ++mi) {
        const int r0 = rbase + mi * 32; const int j = r0 < MP ? 0 : 1 + ((r0 - MP) >> 11);
        const float gv = gmod[j * 6144 + col];
#pragma unroll
        for (int gg = 0; gg < 4; ++gg) {
          const int row = rbase + mi * 32 + 8 * gg + 4 * lh;
          const float* xi = (row < MP ? xin_p + (size_t)row * D : xin_s + (size_t)(row - MP) * D) + col;
          float* xo = X + (size_t)row * D + col;
#pragma unroll
          for (int e = 0; e < 4; ++e) {
            if (part) atomicAdd(xo + (size_t)e * D, gv * acc[mi][ni][4 * gg + e]);
            else xo[(size_t)e * D] = xi[(size_t)e * D] + gv * acc[mi][ni][4 * gg + e];
          }
        }
      }
    }
  }
};

struct EpiFFUp {
  bf16_t* U;
  template <int MI, int NI> DI void run(f32x16 (&acc)[MI][NI], int rbase, int cbase, int lr, int lh, bool part) const {
    static_assert(NI == 2, "ffn up needs paired tiles");
    const int oc = (cbase >> 6) * 32 + lr;
#pragma unroll
    for (int mi = 0; mi < MI; ++mi)
#pragma unroll
      for (int g = 0; g < 4; ++g) {
        const int row = rbase + mi * 32 + 8 * g + 4 * lh;
#pragma unroll
        for (int e = 0; e < 4; ++e) {
          float a1 = acc[mi][0][4 * g + e], a3 = acc[mi][1][4 * g + e];
          U[(size_t)(row + e) * DFF + oc] = f2bf(a1 * __frcp_rn(1.f + __expf(-a1)) * a3);
        }
      }
  }
};

struct EpiOdIn {
  bf16_t* Q; bf16_t* Kb; bf16_t* VT; float* AK; float* AV; const float* rope;
  template <int MI, int NI> DI void run(f32x16 (&acc)[MI][NI], int rbase, int cbase, int lr, int lh, bool part) const {
#pragma unroll
    for (int ni = 0; ni < NI; ++ni) {
      const int col = cbase + ni * 32 + lr; const int seg = col >> 10, cc = col & 1023; const int d = col & 127;
#pragma unroll
      for (int mi = 0; mi < MI; ++mi)
#pragma unroll
        for (int g = 0; g < 4; ++g) {
          const bool sample = (rbase + mi * 32) >= MP;
          const int row = rbase + mi * 32 + 8 * g + 4 * lh;
          float v[4];
#pragma unroll
          for (int e = 0; e < 4; ++e) v[e] = acc[mi][ni][4 * g + e];
          if (seg < 2) {
            if (sample) {
#pragma unroll
              for (int e = 0; e < 4; ++e) {
                float pv = __shfl_xor(v[e], 16);
                int n = (row + e - MP) & 2047; int pos = (d & 32) ? (n & 63) : (n >> 6);
                float2 cs = *(const float2*)(rope + (pos * 16 + (d & 15)) * 2);
                v[e] = (d & 16) ? (pv * cs.y + v[e] * cs.x) : (v[e] * cs.x - pv * cs.y);
              }
            }
            if (seg == 0) {
#pragma unroll
              for (int e = 0; e < 4; ++e) Q[(size_t)(row + e) * 1024 + cc] = f2bf(v[e] * 0.18033688011112042f);
            } else {
#pragma unroll
              for (int e = 0; e < 4; ++e) Kb[(size_t)(row + e) * 1024 + cc] = f2bf(v[e]);
              if (!sample) {
#pragma unroll
                for (int e = 0; e < 4; ++e) AK[(size_t)(row + e) * 1024 + cc] = v[e];
              }
            }
          } else {
            *(uint2*)(VT + (size_t)cc * M + row) = pack4(v[0], v[1], v[2], v[3]);
            if (!sample) {
#pragma unroll
              for (int e = 0; e < 4; ++e) AV[(size_t)(row + e) * 1024 + cc] = v[e];
            }
          }
        }
    }
  }
};

DI void s1_phase(const Params& p, unsigned char* smem) {
  bf16_t* Vt = (bf16_t*)smem;
  bf16_t* Ktf = Vt + 128 * 72;
  bf16_t* Ktb = Ktf + 128 * 72;
  float* wgf = (float*)(Ktb + 128 * 72);
  float* wgb = wgf + 64;
  const bf16_t* PN = (const bf16_t*)(p.ws + OFF_PN);
  const bf16_t* PT = (const bf16_t*)(p.ws + OFF_PT);
  const float* GATES = (const float*)(p.ws + OFF_GATES);
  float* SCAL = (float*)(p.ws + OFF_SCAL);
  float* NLOC = (float*)(p.ws + OFF_NLOC);
  float* AL = (float*)(p.ws + OFF_AL);
  bf16_t* MLST = (bf16_t*)(p.ws + OFF_ST);
  bf16_t* HGST = (bf16_t*)(p.out);
  const int tid = threadIdx.x, lane = tid & 63, wave = tid >> 6, lr = lane & 31, lh = lane >> 5;
  for (int item = blockIdx.x; item < 1536; item += gridDim.x) {
    const int kind = item >= 768; const int it = item - kind * 768; const int gc = it >> 2, h = it & 3; const int tok0 = gc * 64;
    const int slot0 = it * 2;
    if (kind == 0) {
      load_tile_128x64(Vt, PT + (size_t)(512 + h * 128) * M + tok0, M);
      uint4 rk[4];
      const bf16_t* PTk = PT + (size_t)(h * 128) * M + tok0;
#pragma unroll
      for (int i = 0; i < 4; ++i) { int c = tid + 256 * i; rk[i] = *(const uint4*)(PTk + (size_t)(c >> 3) * M + (c & 7) * 8); }
      if (wave == 0) {
        const float* gp = GATES + (size_t)(tok0 + lane) * 16;
        float igf = gp[h], igb = gp[4 + h], lff = logsig(gp[8 + h]), lfb = logsig(gp[12 + h]);
        float bfw = lff;
#pragma unroll
        for (int o = 1; o < 64; o <<= 1) { float t = __shfl_up(bfw, o); if (lane >= o) bfw += t; }
        float blf = __shfl(bfw, 63);
        float gf = blf - bfw + igf; float mlocf = wmax(gf); wgf[lane] = expf(gf - mlocf);
        float bbw = lfb;
#pragma unroll
        for (int o = 1; o < 64; o <<= 1) { float t = __shfl_down(bbw, o); if (lane + o < 64) bbw += t; }
        float blb = __shfl(bbw, 0);
        float gb = blb - bbw + igb; float mlocb = wmax(gb); wgb[lane] = expf(gb - mlocb);
        if (lane == 0) { SCAL[slot0 * 4 + 0] = blf; SCAL[slot0 * 4 + 1] = mlocf; SCAL[(slot0 + 1) * 4 + 0] = blb; SCAL[(slot0 + 1) * 4 + 1] = mlocb; }
      }
      __syncthreads();
#pragma unroll
      for (int i = 0; i < 4; ++i) {
        int c = tid + 256 * i; int row = c >> 3, ch = c & 7;
        unsigned w[4] = {rk[i].x, rk[i].y, rk[i].z, rk[i].w};
        unsigned of[4], ob[4];
#pragma unroll
        for (int q = 0; q < 4; ++q) {
          float k0 = lo_bf(w[q]), k1 = hi_bf(w[q]);
          int t = ch * 8 + q * 2;
          of[q] = pack2(k0 * wgf[t], k1 * wgf[t + 1]); ob[q] = pack2(k0 * wgb[t], k1 * wgb[t + 1]);
        }
        *(uint4*)(Ktf + row * 72 + ch * 8) = make_uint4(of[0], of[1], of[2], of[3]);
        *(uint4*)(Ktb + row * 72 + ch * 8) = make_uint4(ob[0], ob[1], ob[2], ob[3]);
      }
    } else {
      bf16_t* Xf = Vt;
      bf16_t* Xb = (bf16_t*)(smem + 55808);
      load_tile_64x128(Xf, PN + (size_t)tok0 * PNW + 2048 + h * 128, PNW);
      load_tile_64x128(Xb, PN + (size_t)tok0 * PNW + 2560 + h * 128, PNW);
      __syncthreads();
      const int dir = tid >> 7, dk = tid & 127; const int ch = h * 128 + dk;
      const float lb = 1.f / (1.f + expf(p.ev_lb_logits[512 + ch] - p.ev_lb_logits[ch]));
      const bf16_t* xs = dir ? Xb : Xf;
      bf16_t* Kt = dir ? Ktb : Ktf;
      float R = 1.f;
#pragma unroll 2
      for (int s = 0; s < 64; ++s) {
        int t = dir ? s : 63 - s;
        float x = bf2f(xs[t * 136 + dk]); float f = lb + (1.f - lb) * __frcp_rn(1.f + __expf(-x));
        Kt[dk * 72 + t] = f2bf((1.f - f) * R); R *= f;
      }
      AL[(slot0 + dir) * 128 + dk] = R;
      __syncthreads();
      load_tile_128x64(Vt, PT + (size_t)(1024 + h * 128) * M + tok0, M);
    }
    __syncthreads();
    bf16_t* ST = kind ? HGST : MLST;
#pragma unroll 1
    for (int dir = 0; dir < 2; ++dir) {
      const bf16_t* Kt = dir ? Ktb : Ktf;
      f32x16 acc[4];
#pragma unroll
      for (int ni = 0; ni < 4; ++ni) acc[ni] = zero16();
#pragma unroll
      for (int ks = 0; ks < 4; ++ks) {
        bf16x8 a = ld8(Kt + (wave * 32 + lr) * 72 + ks * 16 + lh * 8);
#pragma unroll
        for (int ni = 0; ni < 4; ++ni) { bf16x8 b = ld8(Vt + (ni * 32 + lr) * 72 + ks * 16 + lh * 8); acc[ni] = MFMA(a, b, acc[ni]); }
      }
      bf16_t* dst = ST + (size_t)(slot0 + dir) * 16384;
#pragma unroll
      for (int ni = 0; ni < 4; ++ni)
#pragma unroll
        for (int g = 0; g < 4; ++g)
          *(uint2*)(dst + (ni * 32 + lr) * 128 + wave * 32 + 8 * g + 4 * lh) = pack4(acc[ni][4 * g], acc[ni][4 * g + 1], acc[ni][4 * g + 2], acc[ni][4 * g + 3]);
    }
    if (kind == 0) {
      const int dir = tid >> 7, dk = tid & 127; const bf16_t* Kt = dir ? Ktb : Ktf; float s = 0.f;
#pragma unroll 8
      for (int t = 0; t < 64; ++t) s += bf2f(Kt[dk * 72 + t]);
      NLOC[(slot0 + dir) * 128 + dk] = s;
    }
    __syncthreads();
  }
}

DI void s2_phase(const Params& p, unsigned char* smem) {
  const float* __restrict__ SCAL = (const float*)(p.ws + OFF_SCAL);
  float* __restrict__ MINIT = (float*)(p.ws + OFF_MINIT);
  const float* __restrict__ NLOC = (const float*)(p.ws + OFF_NLOC);
  float* __restrict__ NINIT = (float*)(p.ws + OFF_NINIT);
  const float* __restrict__ AL = (const float*)(p.ws + OFF_AL);
  bf16_t* MLST = (bf16_t*)(p.ws + OFF_ST);
  bf16_t* HGST = (bf16_t*)(p.out);
  float* tl = (float*)smem;
  const int tid = threadIdx.x;
  for (int u = blockIdx.x; u < 4352; u += gridDim.x) {
    int kind, sample, seq, h, dir, slab;
    if (u < 256) { kind = u >> 7; int v = u & 127; slab = v & 7; v >>= 3; dir = v & 1; v >>= 1; h = v & 3; seq = v >> 2; sample = 1; }
    else { int v = u - 256; kind = v >= 2048; v -= kind * 2048; slab = v & 7; v >>= 3; dir = v & 1; v >>= 1; h = v & 3; seq = v >> 2; sample = 0; }
    const int nc = sample ? 32 : 4; const int gc0 = sample ? 128 + seq * 32 : seq * 4;
    bf16_t* ST = kind ? HGST : MLST;
    const int e = slab * 2048 + tid * 8; const int dv = e >> 7, dk0 = e & 127;
    float st[8]; float nst = 0.f, m = 0.f;
    const int sidx = (seq * 2 + dir) * 4 + h;
    if (sample) {
      const float* S0 = (kind ? p.st_S : p.st_C) + (size_t)sidx * 16384;
#pragma unroll
      for (int j = 0; j < 8; ++j) st[j] = S0[(dk0 + j) * 128 + dv];
      if (kind == 0) { m = p.st_m[sidx]; if (slab == 0 && tid < 128) nst = p.st_n[sidx * 128 + tid]; }
    } else {
#pragma unroll
      for (int j = 0; j < 8; ++j) st[j] = 0.f;
    }
    const int slot0 = ((gc0 + (dir ? nc - 1 : 0)) * 4 + h) * 2 + dir;
    const int sstep = dir ? -8 : 8;
    uint4 Lq[4]; float4 Aq0[4], Aq1[4]; float2 Sq[4]; float Nq[4];
    const bool nthr = (kind == 0) && (slab == 0) && (tid < 128);
#pragma unroll
    for (int i = 0; i < 4; ++i) {
      const int sl = slot0 + i * sstep;
      Lq[i] = *(const uint4*)(ST + (size_t)sl * 16384 + e);
      Aq0[i] = make_float4(0.f, 0.f, 0.f, 0.f); Aq1[i] = Aq0[i]; Sq[i] = make_float2(0.f, 0.f); Nq[i] = 0.f;
      if (kind) { Aq0[i] = *(const float4*)(AL + sl * 128 + dk0); Aq1[i] = *(const float4*)(AL + sl * 128 + dk0 + 4); }
      else { Sq[i] = *(const float2*)(SCAL + sl * 4); if (nthr) Nq[i] = NLOC[sl * 128 + tid]; }
    }
    for (int ps = 0; ps < nc; ps += 4) {
#pragma unroll
      for (int i = 0; i < 4; ++i) {
        const int slot = slot0 + (ps + i) * sstep;
        const uint4 Lc = Lq[i];
        float dec[8]; float ls;
        if (kind == 0) {
          const float bl = Sq[i].x, mloc = Sq[i].y; const float mn = fmaxf(bl + m, mloc); const float d = __expf(bl + m - mn); ls = __expf(mloc - mn);
#pragma unroll
          for (int j = 0; j < 8; ++j) dec[j] = d;
          if (slab == 0) { if (tid == 0) MINIT[slot] = m; if (tid < 128) { NINIT[slot * 128 + tid] = nst; nst = d * nst + ls * Nq[i]; } }
          m = mn;
        } else {
          ls = 1.f;
          dec[0] = Aq0[i].x; dec[1] = Aq0[i].y; dec[2] = Aq0[i].z; dec[3] = Aq0[i].w;
          dec[4] = Aq1[i].x; dec[5] = Aq1[i].y; dec[6] = Aq1[i].z; dec[7] = Aq1[i].w;
        }
        *(uint4*)(ST + (size_t)slot * 16384 + e) = make_uint4(pack2(st[0], st[1]), pack2(st[2], st[3]), pack2(st[4], st[5]), pack2(st[6], st[7]));
        float l[8] = {lo_bf(Lc.x), hi_bf(Lc.x), lo_bf(Lc.y), hi_bf(Lc.y), lo_bf(Lc.z), hi_bf(Lc.z), lo_bf(Lc.w), hi_bf(Lc.w)};
#pragma unroll
        for (int j = 0; j < 8; ++j) st[j] = dec[j] * st[j] + ls * l[j];
        if (ps + i + 4 < nc) {
          const int sl = slot + 4 * sstep;
          Lq[i] = *(const uint4*)(ST + (size_t)sl * 16384 + e);
          if (kind) { Aq0[i] = *(const float4*)(AL + sl * 128 + dk0); Aq1[i] = *(const float4*)(AL + sl * 128 + dk0 + 4); }
          else { Sq[i] = *(const float2*)(SCAL + sl * 4); if (nthr) Nq[i] = NLOC[sl * 128 + tid]; }
        }
      }
    }
    if (!sample) {
#pragma unroll
      for (int j = 0; j < 8; ++j) tl[(dk0 + j) * 17 + (dv & 15)] = st[j];
      __syncthreads();
      float* Co = p.out + (kind ? OUT_S : OUT_C) + (size_t)sidx * 16384;
      const int dkr = tid >> 1, hf = tid & 1;
      float4 o0, o1;
      o0.x = tl[dkr * 17 + hf * 8 + 0]; o0.y = tl[dkr * 17 + hf * 8 + 1]; o0.z = tl[dkr * 17 + hf * 8 + 2]; o0.w = tl[dkr * 17 + hf * 8 + 3];
      o1.x = tl[dkr * 17 + hf * 8 + 4]; o1.y = tl[dkr * 17 + hf * 8 + 5]; o1.z = tl[dkr * 17 + hf * 8 + 6]; o1.w = tl[dkr * 17 + hf * 8 + 7];
      *(float4*)(Co + dkr * 128 + slab * 16 + hf * 8) = o0;
      *(float4*)(Co + dkr * 128 + slab * 16 + hf * 8 + 4) = o1;
      if (kind == 0 && slab == 0) { if (tid < 128) p.out[OUT_N + sidx * 128 + tid] = nst; if (tid == 0) p.out[OUT_M + sidx] = m; }
      __syncthreads();
    }
  }
}

DI void s3_epilogue(const float* Hs, const float* gain, const bf16_t* gate_src, bf16_t* mix_dst, bool use_silu) {
  const int tid = threadIdx.x, t = tid >> 2, part = tid & 3;
  const float* hr = Hs + t * 132 + part * 32;
  float ss = 0.f;
#pragma unroll
  for (int i = 0; i < 8; ++i) { float4 v = *(const float4*)(hr + i * 4); ss += v.x * v.x + v.y * v.y + v.z * v.z + v.w * v.w; }
  ss += __shfl_xor(ss, 1); ss += __shfl_xor(ss, 2);
  const float rstd = rsqrtf(ss * (1.f / 128.f) + 1e-6f);
#pragma unroll
  for (int i = 0; i < 8; ++i) {
    const int d = part * 32 + i * 4;
    float4 v = *(const float4*)(hr + i * 4); float4 g4 = *(const float4*)(gain + d);
    uint2 gs = *(const uint2*)(gate_src + (size_t)t * PNW + d);
    float x0 = lo_bf(gs.x), x1 = hi_bf(gs.x), x2 = lo_bf(gs.y), x3 = hi_bf(gs.y);
    float s0 = __frcp_rn(1.f + __expf(-x0)), s1 = __frcp_rn(1.f + __expf(-x1)), s2 = __frcp_rn(1.f + __expf(-x2)), s3 = __frcp_rn(1.f + __expf(-x3));
    if (use_silu) { s0 *= x0; s1 *= x1; s2 *= x2; s3 *= x3; }
    *(uint2*)(mix_dst + (size_t)t * 1024 + d) = pack4(v.x * rstd * g4.x * s0, v.y * rstd * g4.y * s1, v.z * rstd * g4.z * s2, v.w * rstd * g4.w * s3);
  }
}

DI void s3_phase(const Params& p, unsigned char* smem) {
  const bf16_t* PN = (const bf16_t*)(p.ws + OFF_PN);
  const bf16_t* PT = (const bf16_t*)(p.ws + OFF_PT);
  const float* GATES = (const float*)(p.ws + OFF_GATES);
  const float* SCAL = (const float*)(p.ws + OFF_SCAL);
  const float* NINIT = (const float*)(p.ws + OFF_NINIT);
  const float* MINIT = (const float*)(p.ws + OFF_MINIT);
  const bf16_t* MLST = (const bf16_t*)(p.ws + OFF_ST);
  const bf16_t* HGST = (const bf16_t*)(p.out);
  bf16_t* MIX = (bf16_t*)(p.out + OUT_AK);
  const int tid = threadIdx.x, lane = tid & 63, wave = tid >> 6, lr = lane & 31, lh = lane >> 5, wm = wave >> 1, wn = wave & 1;
  float* Hs = (float*)smem;
  for (int item = blockIdx.x; item < 1536; item += gridDim.x) {
    const int kind = item >= 768; const int it = item - kind * 768; const int gc = it >> 2, h = it & 3; const int tok0 = gc * 64;
    const int slotf = it * 2, slotb = it * 2 + 1;
    if (kind == 0) {
      bf16_t* Qs = (bf16_t*)smem;
      bf16_t* Ks = Qs + 64 * 136;
      bf16_t* Vt = Ks + 64 * 136;
      bf16_t* Pf = Vt + 128 * 72;
      bf16_t* Pb = Pf + 64 * 72;
      float* fa = (float*)(Pb + 64 * 72);
      float* rF = fa, *cF = fa + 64, *wF = fa + 128, *mtF = fa + 192, *rB = fa + 256, *cB = fa + 320, *wB = fa + 384, *mtB = fa + 448;
      float* facPf = fa + 512, *facPb = fa + 576, *facIf = fa + 640, *facIb = fa + 704;
      float* nF = fa + 768, *nB = fa + 896, *qnF = fa + 1024, *qnB = fa + 1088;
      load_tile_64x128(Qs, PN + (size_t)tok0 * PNW + h * 128, PNW);
      load_tile_64x128(Ks, PN + (size_t)tok0 * PNW + 512 + h * 128, PNW);
      load_tile_128x64(Vt, PT + (size_t)(512 + h * 128) * M + tok0, M);
      if (wave == 0) {
        const float* gp = GATES + (size_t)(tok0 + lane) * 16;
        float igf = gp[h], igb = gp[4 + h], lff = logsig(gp[8 + h]), lfb = logsig(gp[12 + h]);
        float bfw = lff;
#pragma unroll
        for (int o = 1; o < 64; o <<= 1) { float t = __shfl_up(bfw, o); if (lane >= o) bfw += t; }
        float cf = igf - bfw; float pm = cf;
#pragma unroll
        for (int o = 1; o < 64; o <<= 1) { float t = __shfl_up(pm, o); if (lane >= o) pm = fmaxf(pm, t); }
        float mF = MINIT[slotf];
        float interF = bfw + mF; float mt = fmaxf(interF, bfw + pm);
        rF[lane] = bfw - mt; cF[lane] = cf; wF[lane] = expf(interF - mt); mtF[lane] = mt;
        float bbw = lfb;
#pragma unroll
        for (int o = 1; o < 64; o <<= 1) { float t = __shfl_down(bbw, o); if (lane + o < 64) bbw += t; }
        float cb = igb - bbw; float sm = cb;
#pragma unroll
        for (int o = 1; o < 64; o <<= 1) { float t = __shfl_down(sm, o); if (lane + o < 64) sm = fmaxf(sm, t); }
        float mB = MINIT[slotb];
        float interB = bbw + mB; float mt2 = fmaxf(interB, bbw + sm);
        rB[lane] = bbw - mt2; cB[lane] = cb; wB[lane] = expf(interB - mt2); mtB[lane] = mt2;
      }
      if (wave >= 2) { int i = tid - 128; nF[i] = NINIT[slotf * 128 + i]; nB[i] = NINIT[slotb * 128 + i]; }
      __syncthreads();
      {
        f32x16 s = zero16();
#pragma unroll
        for (int ks = 0; ks < 8; ++ks) { bf16x8 a = ld8(Qs + (wm * 32 + lr) * 136 + ks * 16 + lh * 8); bf16x8 b = ld8(Ks + (wn * 32 + lr) * 136 + ks * 16 + lh * 8); s = MFMA(a, b, s); }
        const int sidx = wn * 32 + lr; const float cfs = cF[sidx], cbs = cB[sidx];
#pragma unroll
        for (int i = 0; i < 16; ++i) {
          const int t = wm * 32 + crow(i, lh);
          float pf = (sidx <= t) ? s[i] * __expf(rF[t] + cfs) : 0.f;
          float pb = (sidx >= t) ? s[i] * __expf(rB[t] + cbs) : 0.f;
          Pf[t * 72 + sidx] = f2bf(pf); Pb[t * 72 + sidx] = f2bf(pb);
        }
        const int t = tid >> 2, part = tid & 3; float sf = 0.f, sb = 0.f;
#pragma unroll 8
        for (int d = part * 32; d < part * 32 + 32; ++d) { float q = bf2f(Qs[t * 136 + d]); sf += q * nF[d]; sb += q * nB[d]; }
        sf += __shfl_xor(sf, 1); sf += __shfl_xor(sf, 2); sb += __shfl_xor(sb, 1); sb += __shfl_xor(sb, 2);
        if (part == 0) { qnF[t] = sf; qnB[t] = sb; }
      }
      __syncthreads();
      {
        const int t = tid >> 2, part = tid & 3; float sf = 0.f, sb = 0.f;
#pragma unroll
        for (int j = 0; j < 16; ++j) { sf += bf2f(Pf[t * 72 + part * 16 + j]); sb += bf2f(Pb[t * 72 + part * 16 + j]); }
        sf += __shfl_xor(sf, 1); sf += __shfl_xor(sf, 2); sb += __shfl_xor(sb, 1); sb += __shfl_xor(sb, 2);
        if (part == 0) {
          float denf = wF[t] * qnF[t] + sf; float Nf = fmaxf(fabsf(denf), expf(-mtF[t])); facPf[t] = 1.f / Nf; facIf[t] = wF[t] / Nf;
          float denb = wB[t] * qnB[t] + sb; float Nb = fmaxf(fabsf(denb), expf(-mtB[t])); facPb[t] = 1.f / Nb; facIb[t] = wB[t] / Nb;
        }
      }
      __syncthreads();
      f32x16 hacc[2]; hacc[0] = zero16(); hacc[1] = zero16();
#pragma unroll
      for (int pd = 0; pd < 2; ++pd) {
        __builtin_amdgcn_sched_barrier(0);
        const bf16_t* Pm = pd ? Pb : Pf; const float* fac = pd ? facPb : facPf;
        f32x16 t0[2]; t0[0] = zero16(); t0[1] = zero16();
#pragma unroll
        for (int ks = 0; ks < 4; ++ks) {
          bf16x8 bv = ld8(Vt + (wave * 32 + lr) * 72 + ks * 16 + lh * 8);
#pragma unroll
          for (int mi = 0; mi < 2; ++mi) t0[mi] = MFMA(ld8(Pm + (mi * 32 + lr) * 72 + ks * 16 + lh * 8), bv, t0[mi]);
        }
#pragma unroll
        for (int mi = 0; mi < 2; ++mi)
#pragma unroll
          for (int i = 0; i < 16; ++i) hacc[mi][i] += t0[mi][i] * fac[mi * 32 + crow(i, lh)];
      }
#pragma unroll
      for (int pd = 0; pd < 2; ++pd) {
        __builtin_amdgcn_sched_barrier(0);
        const bf16_t* Cm = MLST + (size_t)(pd ? slotb : slotf) * 16384 + (wave * 32 + lr) * 128 + lh * 8;
        const float* fac = pd ? facIb : facIf;
        f32x16 t0[2]; t0[0] = zero16(); t0[1] = zero16();
#pragma unroll
        for (int ks = 0; ks < 8; ++ks) {
          bf16x8 b0 = ld8(Cm + ks * 16);
#pragma unroll
          for (int mi = 0; mi < 2; ++mi) t0[mi] = MFMA(ld8(Qs + (mi * 32 + lr) * 136 + ks * 16 + lh * 8), b0, t0[mi]);
        }
#pragma unroll
        for (int mi = 0; mi < 2; ++mi)
#pragma unroll
          for (int i = 0; i < 16; ++i) hacc[mi][i] += t0[mi][i] * fac[mi * 32 + crow(i, lh)];
      }
      __syncthreads();
#pragma unroll
      for (int mi = 0; mi < 2; ++mi)
#pragma unroll
        for (int i = 0; i < 16; ++i) Hs[(mi * 32 + crow(i, lh)) * 132 + wave * 32 + lr] = hacc[mi][i];
      __syncthreads();
      s3_epilogue(Hs, p.ml_norm_g + h * 128, PN + (size_t)tok0 * PNW + 1024 + h * 128, MIX + (size_t)tok0 * 1024 + h * 128, false);
      __syncthreads();
    } else {
      bf16_t* QF = (bf16_t*)smem;
      bf16_t* QB = QF + 64 * 136;
      bf16_t* KF = QB + 64 * 136;
      bf16_t* KB = KF + 9216;
      bf16_t* P = KF;
      bf16_t* It = KB;
      load_tile_64x128(KF, PN + (size_t)tok0 * PNW + 2048 + h * 128, PNW);
      load_tile_64x128(KB, PN + (size_t)tok0 * PNW + 2560 + h * 128, PNW);
      load_tile_64x128(QF, PN + (size_t)tok0 * PNW + 1536 + h * 128, PNW);
      load_tile_64x128(QB, PN + (size_t)tok0 * PNW + 1536 + h * 128, PNW);
      __syncthreads();
      {
        const int dir = tid >> 7, dk = tid & 127; const int ch = h * 128 + dk;
        const float lb = 1.f / (1.f + expf(p.ev_lb_logits[512 + ch] - p.ev_lb_logits[ch]));
        bf16_t* Qd = dir ? QB : QF; bf16_t* Kd = dir ? KB : KF;
        float P = 1.f;
#pragma unroll 2
        for (int s = 0; s < 64; ++s) {
          int t = dir ? 63 - s : s;
          float x = bf2f(Kd[t * 136 + dk]); float f = lb + (1.f - lb) * __frcp_rn(1.f + __expf(-x));
          P *= f;
          float q = bf2f(Qd[t * 136 + dk]);
          Qd[t * 136 + dk] = f2bf(q * P); Kd[t * 136 + dk] = f2bf((1.f - f) * __frcp_rn(fmaxf(P, 1.8e-35f)));
        }
      }
      __syncthreads();
      f32x16 pacc;
      {
        f32x16 sf = zero16(), sb = zero16();
#pragma unroll
        for (int ks = 0; ks < 8; ++ks) {
          sf = MFMA(ld8(QF + (wm * 32 + lr) * 136 + ks * 16 + lh * 8), ld8(KF + (wn * 32 + lr) * 136 + ks * 16 + lh * 8), sf);
          sb = MFMA(ld8(QB + (wm * 32 + lr) * 136 + ks * 16 + lh * 8), ld8(KB + (wn * 32 + lr) * 136 + ks * 16 + lh * 8), sb);
        }
        const int sidx = wn * 32 + lr;
#pragma unroll
        for (int i = 0; i < 16; ++i) { const int t = wm * 32 + crow(i, lh); pacc[i] = ((sidx <= t) ? sf[i] : 0.f) + ((sidx >= t) ? sb[i] : 0.f); }
      }
      f32x16 o[2]; o[0] = zero16(); o[1] = zero16();
      {
        const bf16_t* Sf = HGST + (size_t)slotf * 16384 + (wave * 32 + lr) * 128 + lh * 8;
        const bf16_t* Sb = HGST + (size_t)slotb * 16384 + (wave * 32 + lr) * 128 + lh * 8;
#pragma unroll
        for (int ks = 0; ks < 8; ++ks) {
          bf16x8 b0 = ld8(Sf + ks * 16), b1 = ld8(Sb + ks * 16);
#pragma unroll
          for (int mi = 0; mi < 2; ++mi) {
            o[mi] = MFMA(ld8(QF + (mi * 32 + lr) * 136 + ks * 16 + lh * 8), b0, o[mi]);
            o[mi] = MFMA(ld8(QB + (mi * 32 + lr) * 136 + ks * 16 + lh * 8), b1, o[mi]);
          }
        }
      }
      __syncthreads();
      {
        const int sidx = wn * 32 + lr;
#pragma unroll
        for (int i = 0; i < 16; ++i) P[(wm * 32 + crow(i, lh)) * 72 + sidx] = f2bf(pacc[i]);
      }
      load_tile_128x64(It, PT + (size_t)(1024 + h * 128) * M + tok0, M);
      __syncthreads();
#pragma unroll
      for (int ks = 0; ks < 4; ++ks) {
        bf16x8 bv = ld8(It + (wave * 32 + lr) * 72 + ks * 16 + lh * 8);
#pragma unroll
        for (int mi = 0; mi < 2; ++mi) o[mi] = MFMA(ld8(P + (mi * 32 + lr) * 72 + ks * 16 + lh * 8), bv, o[mi]);
      }
#pragma unroll
      for (int mi = 0; mi < 2; ++mi)
#pragma unroll
        for (int i = 0; i < 16; ++i) Hs[(mi * 32 + crow(i, lh)) * 132 + wave * 32 + lr] = o[mi][i];
      __syncthreads();
      s3_epilogue(Hs, p.hg_norm_g + h * 128, PN + (size_t)tok0 * PNW + 3072 + h * 128, MIX + (size_t)tok0 * 1024 + 512 + h * 128, true);
      __syncthreads();
    }
  }
}

DI void online_softmax(f32x16& s, float& m, float& l, f32x16 (&O)[4], bf16x8& p0, bf16x8& p1) {
  float mx = s[0];
#pragma unroll
  for (int i = 1; i < 16; ++i) mx = fmaxf(mx, s[i]);
  { auto r = __builtin_amdgcn_permlane32_swap(__float_as_uint(mx), __float_as_uint(mx), false, false); mx = fmaxf(__uint_as_float(r[0]), __uint_as_float(r[1])); }
  const float mn = fmaxf(m, mx);
  if (__ballot(mn > m) != 0ull) {
    const float alpha = __builtin_amdgcn_exp2f(m - mn);
    l *= alpha;
#pragma unroll
    for (int mt = 0; mt < 4; ++mt)
#pragma unroll
      for (int i = 0; i < 16; ++i) O[mt][i] *= alpha;
    m = mn;
  }
  float sum = 0.f;
#pragma unroll
  for (int i = 0; i < 16; ++i) { s[i] = __builtin_amdgcn_exp2f(s[i] - m); sum += s[i]; }
  l += sum;
  uint4 u0 = make_uint4(pack2(s[0], s[1]), pack2(s[2], s[3]), pack2(s[4], s[5]), pack2(s[6], s[7]));
  uint4 u1 = make_uint4(pack2(s[8], s[9]), pack2(s[10], s[11]), pack2(s[12], s[13]), pack2(s[14], s[15]));
  p0 = __builtin_bit_cast(bf16x8, u0); p1 = __builtin_bit_cast(bf16x8, u1);
}

#define ATTN_GLOAD(KT) do { \
    const int kt_ = (KT); const bf16_t* ksrc; size_t kld; const bf16_t* vsrc; size_t vld; \
    if (sample && kt_ < 4) { ksrc = KC + ((size_t)(seq * 8 + h) * 256 + kt_ * 64) * 128; kld = 128; vsrc = VCT + (size_t)(seq * 8 + h) * 128 * 256 + kt_ * 64; vld = 256; } \
    else { const int kt2 = sample ? kt_ - 4 : kt_; const int t0 = tokbase + kt2 * 64; ksrc = Kb + (size_t)t0 * 1024 + h * 128; kld = 1024; vsrc = VT + (size_t)(h * 128) * M + t0; vld = M; } \
    ksrc += (size_t)(tid >> 4) * kld + (tid & 15) * 8; vsrc += (size_t)(tid >> 3) * vld + (tid & 7) * 8; \
    rk0 = *(const uint4*)(ksrc); rk1 = *(const uint4*)(ksrc + 16 * kld); rk2 = *(const uint4*)(ksrc + 32 * kld); rk3 = *(const uint4*)(ksrc + 48 * kld); \
    rv0 = *(const uint4*)(vsrc); rv1 = *(const uint4*)(vsrc + 32 * vld); rv2 = *(const uint4*)(vsrc + 64 * vld); rv3 = *(const uint4*)(vsrc + 96 * vld); } while (0)
#define ATTN_LSTORE(KD, VD) do { \
    bf16_t* kd_ = (KD) + (tid >> 4) * 136 + (tid & 15) * 8; bf16_t* vd_ = (VD) + (tid >> 3) * 72 + (tid & 7) * 8; \
    *(uint4*)(kd_) = rk0; *(uint4*)(kd_ + 16 * 136) = rk1; *(uint4*)(kd_ + 32 * 136) = rk2; *(uint4*)(kd_ + 48 * 136) = rk3; \
    *(uint4*)(vd_) = rv0; *(uint4*)(vd_ + 32 * 72) = rv1; *(uint4*)(vd_ + 64 * 72) = rv2; *(uint4*)(vd_ + 96 * 72) = rv3; } while (0)

DI void attn_phase(const Params& p, unsigned char* smem) {
  bf16_t* Ks = (bf16_t*)smem;
  bf16_t* Vts = Ks + 64 * 136;
  float* Cmb = (float*)smem;
  const bf16_t* Q = (const bf16_t*)(p.ws + OFF_Q);
  const bf16_t* Kb = (const bf16_t*)(p.ws + OFF_KB);
  const bf16_t* VT = (const bf16_t*)(p.ws + OFF_VT);
  const bf16_t* KC = (const bf16_t*)(p.ws + OFF_KC);
  const bf16_t* VCT = (const bf16_t*)(p.ws + OFF_VCT);
  bf16_t* ATT = (bf16_t*)(p.ws + OFF_ATT);
  const float* MISC = (const float*)(p.ws + OFF_MISC);
  const float lam = MISC[0], lam_init = MISC[1];
  const int tid = threadIdx.x, lane = tid & 63, wave = tid >> 6, lr = lane & 31, lh = lane >> 5;
  const int br = wave >> 1, qw = wave & 1;
  for (int vit = blockIdx.x; vit < 1536; vit += gridDim.x) {
    int item = vit;
    {
      const int b = vit & 511, rnd = vit >> 9; const int xcd = b & 7, slot = b >> 3;
      if (rnd == 0) item = ((xcd * 2 + (slot >> 5)) << 5) | (slot & 31);
      else item = 512 + (((xcd * 32 + (slot >> 1)) << 2) | (((slot & 1) << 1) | (rnd - 1)));
    }
    int sample, seq, h, qb;
    if (item < 512) { sample = 1; qb = item & 31; h = (item >> 5) & 7; seq = item >> 8; }
    else { int v = item - 512; sample = 0; qb = v & 3; h = (v >> 2) & 7; seq = v >> 5; }
    const int tokbase = sample ? MP + seq * 2048 : seq * 256;
    const int nkt = sample ? 36 : 4;
    const int qtok = tokbase + qb * 64 + qw * 32 + lr;
    bf16x8 q[4];
    {
      const bf16_t* qp = Q + (size_t)qtok * 1024 + h * 128 + br * 64 + lh * 8;
#pragma unroll
      for (int s = 0; s < 4; ++s) q[s] = ld8(qp + s * 16);
    }
    f32x16 O[4];
#pragma unroll
    for (int mt = 0; mt < 4; ++mt) O[mt] = zero16();
    float m = -1e30f, l = 0.f;
    uint4 rk0, rk1, rk2, rk3, rv0, rv1, rv2, rv3;
    ATTN_GLOAD(0);
    __syncthreads();
    ATTN_LSTORE(Ks, Vts);
    __syncthreads();
    for (int kt = 0; kt < nkt; ++kt) {
      const int cur = kt & 1;
      if (kt + 1 < nkt) ATTN_GLOAD(kt + 1);
      const bf16_t* Kc = Ks + cur * 17920; const bf16_t* Vc = Vts + cur * 17920;
#pragma unroll
      for (int sub = 0; sub < 2; ++sub) {
        f32x16 s1 = zero16();
#pragma unroll
        for (int s = 0; s < 4; ++s) s1 = MFMA(ld8(Kc + (sub * 32 + lr) * 136 + br * 64 + s * 16 + lh * 8), q[s], s1);
        bf16x8 pa[2];
        online_softmax(s1, m, l, O, pa[0], pa[1]);
#pragma unroll
        for (int k2 = 0; k2 < 2; ++k2)
#pragma unroll
          for (int mt = 0; mt < 4; ++mt) {
            const bf16_t* vp = Vc + (mt * 32 + lr) * 72 + sub * 32 + k2 * 16 + 4 * lh;
            uint2 lo = *(const uint2*)vp, hi = *(const uint2*)(vp + 8);
            bf16x8 vf = __builtin_bit_cast(bf16x8, make_uint4(lo.x, lo.y, hi.x, hi.y));
            O[mt] = MFMA(vf, pa[k2], O[mt]);
          }
      }
      if (kt + 1 < nkt) ATTN_LSTORE(Ks + (cur ^ 1) * 17920, Vts + (cur ^ 1) * 17920);
      __syncthreads();
    }
    l += __shfl_xor(l, 32);
    const float inv = br ? lam / l : 1.f / l;
    __syncthreads();
    if (br == 1) {
#pragma unroll
      for (int mt = 0; mt < 4; ++mt)
#pragma unroll
        for (int i = 0; i < 16; ++i) Cmb[(qw * 64 + mt * 16 + i) * 64 + lane] = O[mt][i] * inv;
    }
    __syncthreads();
    if (br == 0) {
      float ss = 0.f;
#pragma unroll
      for (int mt = 0; mt < 4; ++mt)
#pragma unroll
        for (int i = 0; i < 16; ++i) { float o = O[mt][i] * inv - Cmb[(qw * 64 + mt * 16 + i) * 64 + lane]; O[mt][i] = o; ss += o * o; }
      ss += __shfl_xor(ss, 32);
      const float sc = rsqrtf(ss * (1.f / 128.f) + 1e-6f) * (1.f - lam_init);
      bf16_t* dst = ATT + (size_t)qtok * 1024 + h * 128;
#pragma unroll
      for (int mt = 0; mt < 4; ++mt)
#pragma unroll
        for (int g = 0; g < 4; ++g) {
          const int dv = mt * 32 + 8 * g + 4 * lh;
          float4 g4 = *(const float4*)(p.da_norm_g + dv);
          *(uint2*)(dst + dv) = pack4(O[mt][4 * g] * sc * g4.x, O[mt][4 * g + 1] * sc * g4.y, O[mt][4 * g + 2] * sc * g4.z, O[mt][4 * g + 3] * sc * g4.w);
        }
    }
  }
}

__global__ void __launch_bounds__(256, 2) mega(Params p) {
  __shared__ __attribute__((aligned(16))) unsigned char smem[SMEM_BYTES];
  cg::grid_group grid = cg::this_grid();
  unsigned char* ws = p.ws;
  float* MOD = (float*)(ws + OFF_MOD);
  float* X = p.out + OUT_Y;
  bf16_t* A = (bf16_t*)(ws + OFF_A);
  bf16_t* U = (bf16_t*)(ws + OFF_U);

  __shared__ uint4 xb_words;
  unsigned* bar = (unsigned*)(ws + OFF_BAR);
  if (threadIdx.x == 0) xb_words = make_uint4(0u, 0u, 0u, 0u);
  __syncthreads();
  XcdBarrier xb = xcd_barrier_post(bar, (volatile LAS unsigned*)&xb_words);
  if (p.ws == nullptr) grid.sync();
  for (int rep = 0; rep < REP_P0; ++rep) phase0(p, smem);
  xcd_barrier(xb);
  norm_phase(p.x_prompt, p.x_sample, p.norm_mix_g, MOD, 1024, 0, A);
  xcd_barrier(xb);
  {
    EpiEvIn e{(bf16_t*)(ws + OFF_PN), (bf16_t*)(ws + OFF_PT), (float*)(ws + OFF_GATES), p.ev_gate_b};
    for (int rep = 0; rep < REP_G; ++rep) gemm_phase<128, 128, 64, false>(A, 1024, (const bf16_t*)(ws + OFF_W_EVIN), 1024, M, 4736, 1024, e, smem);
  }
  xcd_barrier(xb);
  for (int rep = 0; rep < REP_MIX; ++rep) s1_phase(p, smem);
  xcd_barrier(xb);
  s2_phase(p, smem);
  xcd_barrier(xb);
  for (int rep = 0; rep < REP_MIX; ++rep) s3_phase(p, smem);
  xcd_barrier(xb);
  {
    EpiResid e{p.x_prompt, p.x_sample, X, MOD + 2048};
    gemm_phase<128, 64, 64, false>((const bf16_t*)(p.out + OUT_AK), 1024, (const bf16_t*)(ws + OFF_W_EVOUT), 1024, M, 1024, 1024, e, smem);
  }
  xcd_barrier(xb);
  norm_phase(X, X + (size_t)MP * D, p.norm_ffn_g, MOD, 4096, 3072, A);
  xcd_barrier(xb);
  {
    EpiFFUp e{U};
    for (int rep = 0; rep < REP_G; ++rep) gemm_phase<128, 128, 64, false>(A, 1024, (const bf16_t*)(ws + OFF_W_FFU0), 1024, M, 5632, 1024, e, smem);
  }
  xcd_barrier(xb);
  {
    EpiResid e{X, X + (size_t)MP * D, X, MOD + 5120};
    gemm_phase<128, 128, 64, true>(U, DFF, (const bf16_t*)(ws + OFF_W_FFD0), DFF, M, 1024, DFF, e, smem);
  }
  xcd_barrier(xb);
  norm_phase(X, X + (size_t)MP * D, p.norm_mix_g + 1024, MOD + 3 * 6144, 1024, 0, A);
  xcd_barrier(xb);
  {
    EpiOdIn e{(bf16_t*)(ws + OFF_Q), (bf16_t*)(ws + OFF_KB), (bf16_t*)(ws + OFF_VT), p.out + OUT_AK, p.out + OUT_AV, (const float*)(ws + OFF_ROPE)};
    for (int rep = 0; rep < REP_G; ++rep) gemm_phase<128, 128, 64, false>(A, 1024, (const bf16_t*)(ws + OFF_W_ODIN), 1024, M, 3072, 1024, e, smem);
  }
  xcd_barrier(xb);
  for (int rep = 0; rep < REP_ATT; ++rep) attn_phase(p, smem);
  xcd_barrier(xb);
  {
    EpiResid e{X, X + (size_t)MP * D, X, MOD + 3 * 6144 + 2048};
    gemm_phase<128, 128, 64, true>((const bf16_t*)(ws + OFF_ATT), 1024, (const bf16_t*)(ws + OFF_W_ODOUT), 1024, M, 1024, 1024, e, smem);
  }
  xcd_barrier(xb);
  norm_phase(X, X + (size_t)MP * D, p.norm_ffn_g + 1024, MOD + 3 * 6144, 4096, 3072, A);
  xcd_barrier(xb);
  {
    EpiFFUp e{U};
    for (int rep = 0; rep < REP_G; ++rep) gemm_phase<128, 128, 64, false>(A, 1024, (const bf16_t*)(ws + OFF_W_FFU1), 1024, M, 5632, 1024, e, smem);
  }
  xcd_barrier(xb);
  {
    EpiResid e{X, X + (size_t)MP * D, X, MOD + 3 * 6144 + 5120};
    gemm_phase<128, 128, 64, true>(U, DFF, (const bf16_t*)(ws + OFF_W_FFD1), DFF, M, 1024, DFF, e, smem);
  }
  xcd_barrier(xb);
  final_norm_phase(X, p.final_norm_g);
}

extern "C" void kernel_launch(void* const* d_in, const int* in_sizes, int n_in, void* d_out, int out_size, void* d_ws, size_t ws_size, hipStream_t stream) {
  static int grid_blocks = 0;
  if (!grid_blocks) {
    int dev = 0, cus = 0, per_cu = 0;
    (void)hipGetDevice(&dev);
    (void)hipDeviceGetAttribute(&cus, hipDeviceAttributeMultiprocessorCount, dev);
    (void)hipOccupancyMaxActiveBlocksPerMultiprocessor(&per_cu, mega, 256, 0);
    per_cu = 2;
    grid_blocks = cus * per_cu;
    if (ws_size < WS_END) { fprintf(stderr, "kernel_launch: workspace too small: %zu < %zu\n", ws_size, (size_t)WS_END); grid_blocks = -1; }
  }
  if (grid_blocks < 0) return;
  (void)hipMemsetAsync((unsigned char*)d_ws + OFF_BAR, 0, 16384, stream);
  Params p{};
  const float** pp = (const float**)&p;
  for (int i = 0; i < 28; ++i) pp[i] = (const float*)d_in[i];
  p.out = (float*)d_out; p.ws = (unsigned char*)d_ws;
  void* args[] = {&p};
  hipError_t e = hipLaunchCooperativeKernel((void*)mega, dim3(grid_blocks), dim3(256), args, 0, stream);
  if (e != hipSuccess) fprintf(stderr, "cooperative launch failed: %s (grid %d)\n", hipGetErrorString(e), grid_blocks);
}
```

```cpp
#include <hip/hip_runtime.h>
#include <hip/hip_cooperative_groups.h>
#include <cstdio>
namespace cg = cooperative_groups;

typedef unsigned short bf16_t;
using bf16x8 = __attribute__((ext_vector_type(8))) short;
using f32x16 = __attribute__((ext_vector_type(16))) float;
#define DI __device__ __forceinline__
#define MFMA(a, b, c) __builtin_amdgcn_mfma_f32_32x32x16_bf16((a), (b), (c), 0, 0, 0)

constexpr int D = 1024;
constexpr int M = 12288;
constexpr int MP = 8192;
constexpr int DFF = 2816;
constexpr int PNW = 3584;
constexpr int SMEM_BYTES = 77824;
#ifndef REP_G
#define REP_G 1
#endif
#ifndef REP_P0
#define REP_P0 1
#endif
#ifndef REP_MIX
#define REP_MIX 1
#endif
#ifndef REP_ATT
#define REP_ATT 1
#endif

constexpr size_t OFF_W_EVIN = 0;
constexpr size_t OFF_W_EVOUT = OFF_W_EVIN + (size_t)4736 * 1024 * 2;
constexpr size_t OFF_W_FFU0 = OFF_W_EVOUT + (size_t)1024 * 1024 * 2;
constexpr size_t OFF_W_FFU1 = OFF_W_FFU0 + (size_t)5632 * 1024 * 2;
constexpr size_t OFF_W_FFD0 = OFF_W_FFU1 + (size_t)5632 * 1024 * 2;
constexpr size_t OFF_W_FFD1 = OFF_W_FFD0 + (size_t)1024 * 2816 * 2;
constexpr size_t OFF_W_ODIN = OFF_W_FFD1 + (size_t)1024 * 2816 * 2;
constexpr size_t OFF_W_ODOUT = OFF_W_ODIN + (size_t)3072 * 1024 * 2;
constexpr size_t OFF_MOD = OFF_W_ODOUT + (size_t)1024 * 1024 * 2;
constexpr size_t OFF_ROPE = OFF_MOD + (size_t)2 * 3 * 6144 * 4;
constexpr size_t OFF_MISC = OFF_ROPE + 8192;
constexpr size_t OFF_BAR = OFF_MISC + 256;
constexpr size_t OFF_GATES = OFF_BAR + 16384;
constexpr size_t OFF_KC = OFF_GATES + (size_t)M * 16 * 4;
constexpr size_t OFF_VCT = OFF_KC + (size_t)2 * 8 * 256 * 128 * 2;
constexpr size_t OFF_NLOC = OFF_VCT + (size_t)2 * 8 * 256 * 128 * 2;
constexpr size_t OFF_NINIT = OFF_NLOC + (size_t)1536 * 128 * 4;
constexpr size_t OFF_SCAL = OFF_NINIT + (size_t)1536 * 128 * 4;
constexpr size_t OFF_MINIT = OFF_SCAL + (size_t)1536 * 4 * 4;
constexpr size_t OFF_AL = OFF_MINIT + (size_t)1536 * 4;
constexpr size_t OFF_PN = OFF_AL + (size_t)1536 * 128 * 4;
constexpr size_t OFF_PT = OFF_PN + (size_t)M * PNW * 2;
constexpr size_t OFF_ST = OFF_PT + (size_t)1536 * M * 2;
constexpr size_t WS_END = OFF_ST + (size_t)1536 * 16384 * 2;
constexpr size_t OFF_A = OFF_ST;
constexpr size_t OFF_ATT = OFF_ST + (size_t)M * 1024 * 2;
constexpr size_t OFF_U = OFF_PN;
constexpr size_t OFF_Q = OFF_PN;
constexpr size_t OFF_KB = OFF_PN + (size_t)M * 1024 * 2;
constexpr size_t OFF_VT = OFF_PN + (size_t)2 * M * 1024 * 2;
constexpr size_t OUT_Y = 0;
constexpr size_t OUT_AK = (size_t)M * 1024;
constexpr size_t OUT_AV = OUT_AK + (size_t)MP * 1024;
constexpr size_t OUT_C = OUT_AV + (size_t)MP * 1024;
constexpr size_t OUT_N = OUT_C + (size_t)32 * 2 * 4 * 16384;
constexpr size_t OUT_M = OUT_N + (size_t)32 * 2 * 4 * 128;
constexpr size_t OUT_S = OUT_M + 256;

struct Params {
  const float *x_prompt, *x_sample, *c, *c_ctx, *cache_k, *cache_v, *st_C, *st_n, *st_m, *st_S;
  const float *ada_w, *ada_b, *norm_mix_g, *norm_ffn_g, *ev_w_in, *ev_gate_b, *ev_lb_logits, *ml_norm_g, *hg_norm_g;
  const float *ev_w_out, *od_w_in, *od_lambda, *da_norm_g, *od_w_out, *ffn_w1, *ffn_w3, *ffn_w2, *final_norm_g;
  float* out;
  unsigned char* ws;
};

typedef __bf16 bf16v2 __attribute__((ext_vector_type(2)));
typedef float f32v2 __attribute__((ext_vector_type(2)));
DI unsigned short f2bf(float x) { return __builtin_bit_cast(unsigned short, (__bf16)x); }
DI float bf2f(unsigned short h) { return __uint_as_float(((unsigned)h) << 16); }
DI unsigned pack2(float a, float b) { f32v2 v = {a, b}; return __builtin_bit_cast(unsigned, __builtin_convertvector(v, bf16v2)); }
DI uint2 pack4(float a, float b, float c, float d) { return make_uint2(pack2(a, b), pack2(c, d)); }
DI float lo_bf(unsigned u) { return __uint_as_float(u << 16); }
DI float hi_bf(unsigned u) { return __uint_as_float(u & 0xffff0000u); }
DI int crow(int reg, int h) { return (reg & 3) + 8 * (reg >> 2) + 4 * h; }
DI float wsum(float v) {
#pragma unroll
  for (int o = 32; o > 0; o >>= 1) v += __shfl_xor(v, o);
  return v;
}
DI float wmax(float v) {
#pragma unroll
  for (int o = 32; o > 0; o >>= 1) v = fmaxf(v, __shfl_xor(v, o));
  return v;
}
DI float logsig(float x) { return fminf(x, 0.f) - log1pf(expf(-fabsf(x))); }
DI float sigmoidf(float x) { return 1.f / (1.f + expf(-x)); }
DI f32x16 zero16() { f32x16 z;
#pragma unroll
  for (int i = 0; i < 16; ++i) z[i] = 0.f;
  return z; }
DI bf16x8 ld8(const bf16_t* p) { return *(const bf16x8*)p; }


#define XB_TMO      128
#define XB_XCNT(j)  (256  + 64 * (j))
#define XB_XSUB(j)  (1280 + 64 * (j))
#define XB_XGEN(j)  (2304 + 64 * (j))
#define XB_TOP      3328
#define XB_TOPGEN   3392
#define XCD_BAR_WORDS 3456
#define XB_SPIN_CAP (1u << 22)
#define LAS __attribute__((address_space(3)))
DI unsigned xb_ld(unsigned* p)              { return __hip_atomic_load(p, __ATOMIC_RELAXED, __HIP_MEMORY_SCOPE_AGENT); }
DI unsigned xb_add(unsigned* p, unsigned v) { return __hip_atomic_fetch_add(p, v, __ATOMIC_RELAXED, __HIP_MEMORY_SCOPE_AGENT); }
DI unsigned xb_xcc_id() { return (unsigned)__builtin_amdgcn_s_getreg((3 << 11) | 20) & 0xFu; }
#define XB_SPIN(cond, bar) do { unsigned _sp = 0; while (cond) { __builtin_amdgcn_s_sleep(1); \
    if ((++_sp & 255u) == 0u) { if (xb_ld(&(bar)[XB_TMO])) break; if (_sp > XB_SPIN_CAP) { atomicAdd(&(bar)[XB_TMO], 1u); break; } } } } while (0)
struct XcdBarrier { unsigned* bar; unsigned x; volatile LAS unsigned* st; };
DI XcdBarrier xcd_barrier_post(unsigned* bar, volatile LAS unsigned* st) {
  XcdBarrier b; b.bar = bar; b.x = xb_xcc_id(); b.st = st;
  if (threadIdx.x == 0) (void)xb_add(&bar[XB_XCNT(b.x)], 1u);
  return b;
}
DI void xcd_barrier_complete(unsigned* bar, unsigned x, unsigned& nloc, unsigned& nx) {
  const unsigned G = gridDim.x * gridDim.y * gridDim.z;
  unsigned sum, cnt, mine, sp = 0u;
  for (;;) {
    sum = 0u; cnt = 0u; mine = 0u;
#pragma unroll
    for (unsigned j = 0; j < 16; ++j) { const unsigned c = xb_ld(&bar[XB_XCNT(j)]); sum += c; cnt += (c > 0u) ? 1u : 0u; mine = (j == x) ? c : mine; }
    if (sum == G) break;
    __builtin_amdgcn_s_sleep(1);
    if ((++sp & 255u) == 0u) { if (xb_ld(&bar[XB_TMO])) break; if (sp > XB_SPIN_CAP) { atomicAdd(&bar[XB_TMO], 1u); break; } }
  }
  nloc = mine > 0u ? mine : 1u; nx = cnt > 0u ? cnt : 1u;
}
DI void xcd_barrier(const XcdBarrier& b) {
  asm volatile("s_waitcnt vmcnt(0)" ::: "memory");
  __syncthreads();
  if (threadIdx.x == 0) {
    unsigned* bar = b.bar;
    __builtin_amdgcn_s_waitcnt(0);
    unsigned nloc = b.st[0], nx = b.st[1];
    if (nloc == 0u) { xcd_barrier_complete(bar, b.x, nloc, nx); b.st[0] = nloc; b.st[1] = nx; }
    const unsigned old = xb_add(&bar[XB_XSUB(b.x)], 1u);
    const unsigned gen = old / nloc;
    if (old + 1u == (gen + 1u) * nloc) {
      __builtin_amdgcn_fence(__ATOMIC_RELEASE, "agent");
      asm volatile("s_waitcnt vmcnt(0)" ::: "memory");
      const unsigned og = xb_add(&bar[XB_TOP], 1u);
      const unsigned tg = og / nx;
      if (og + 1u == (tg + 1u) * nx) xb_add(&bar[XB_TOPGEN], 1u);
      else XB_SPIN(xb_ld(&bar[XB_TOPGEN]) == tg, bar);
      __builtin_amdgcn_fence(__ATOMIC_ACQUIRE, "agent");
      xb_add(&bar[XB_XGEN(b.x)], 1u);
      asm volatile("s_waitcnt vmcnt(0)" ::: "memory");
    } else {
      XB_SPIN(xb_ld(&bar[XB_XGEN(b.x)]) == gen, bar);
      __builtin_amdgcn_fence(__ATOMIC_ACQUIRE, "agent");
      asm volatile("s_waitcnt vmcnt(0)" ::: "memory");
    }
  }
  __syncthreads();
}

DI void load_tile_64x128(bf16_t* dst, const bf16_t* src, size_t ld) {
  const int tid = threadIdx.x;
#pragma unroll
  for (int i = 0; i < 4; ++i) { int c = tid + 256 * i; int row = c >> 4, ch = c & 15; *(uint4*)(dst + row * 136 + ch * 8) = *(const uint4*)(src + (size_t)row * ld + ch * 8); }
}
DI void load_tile_128x64(bf16_t* dst, const bf16_t* src, size_t ld) {
  const int tid = threadIdx.x;
#pragma unroll
  for (int i = 0; i < 4; ++i) { int c = tid + 256 * i; int row = c >> 3, ch = c & 7; *(uint4*)(dst + row * 72 + ch * 8) = *(const uint4*)(src + (size_t)row * ld + ch * 8); }
}

struct TDesc { const float* src0; const float* src1; bf16_t* dst; int srcN, K, kind, tn, tk; };
DI TDesc tdecode(const Params& p, int t) {
  TDesc d; d.src1 = nullptr;
  if (t < 1184) { d.src0 = p.ev_w_in; d.srcN = 4624; d.K = 1024; d.dst = (bf16_t*)(p.ws + OFF_W_EVIN); d.kind = 1; d.tn = t / 16; d.tk = t % 16; }
  else if (t < 1440) { t -= 1184; d.src0 = p.ev_w_out; d.srcN = 1024; d.K = 1024; d.dst = (bf16_t*)(p.ws + OFF_W_EVOUT); d.kind = 0; d.tn = t / 16; d.tk = t % 16; }
  else if (t < 4256) { t -= 1440; int l = t / 1408; t -= l * 1408; d.src0 = p.ffn_w1 + (size_t)l * 1024 * DFF; d.src1 = p.ffn_w3 + (size_t)l * 1024 * DFF; d.srcN = DFF; d.K = 1024;
    d.dst = (bf16_t*)(p.ws + (l ? OFF_W_FFU1 : OFF_W_FFU0)); d.kind = 2; d.tn = t / 16; d.tk = t % 16; }
  else if (t < 5664) { t -= 4256; int l = t / 704; t -= l * 704; d.src0 = p.ffn_w2 + (size_t)l * DFF * 1024; d.srcN = 1024; d.K = DFF;
    d.dst = (bf16_t*)(p.ws + (l ? OFF_W_FFD1 : OFF_W_FFD0)); d.kind = 0; d.tn = t / 44; d.tk = t % 44; }
  else if (t < 6432) { t -= 5664; d.src0 = p.od_w_in; d.srcN = 3072; d.K = 1024; d.dst = (bf16_t*)(p.ws + OFF_W_ODIN); d.kind = 0; d.tn = t / 16; d.tk = t % 16; }
  else { t -= 6432; d.src0 = p.od_w_out; d.srcN = 1024; d.K = 1024; d.dst = (bf16_t*)(p.ws + OFF_W_ODOUT); d.kind = 0; d.tn = t / 16; d.tk = t % 16; }
  return d;
}
DI void t_load(const TDesc& d, float4& v0, float4& v1, float4& v2, float4& v3) {
  const int tid = threadIdx.x; const int c4 = (tid & 15) * 4, kr = tid >> 4;
  const int n = d.tn * 64 + c4;
  const float* src = d.src0; int sc;
  if (d.kind == 0) sc = n;
  else if (d.kind == 1) sc = n < 2048 ? n : (n < 4608 ? n + 16 : (n < 4624 ? n - 4608 + 2048 : -1));
  else { int jb = n >> 6, r = n & 63; src = (r < 32) ? d.src0 : d.src1; sc = jb * 32 + (r & 31); }
  v0 = v1 = v2 = v3 = make_float4(0.f, 0.f, 0.f, 0.f);
  if (sc >= 0) {
    const float* b = src + (size_t)(d.tk * 64 + kr) * d.srcN + sc;
    v0 = *(const float4*)(b); v1 = *(const float4*)(b + (size_t)16 * d.srcN); v2 = *(const float4*)(b + (size_t)32 * d.srcN); v3 = *(const float4*)(b + (size_t)48 * d.srcN);
  }
}
DI void t_ldsw(float* lds, const float4& v0, const float4& v1, const float4& v2, const float4& v3) {
  const int tid = threadIdx.x; const int c4 = (tid & 15) * 4, kr = tid >> 4;
  float* d = lds + kr * 65 + c4;
  d[0] = v0.x; d[1] = v0.y; d[2] = v0.z; d[3] = v0.w;
  d[16 * 65] = v1.x; d[16 * 65 + 1] = v1.y; d[16 * 65 + 2] = v1.z; d[16 * 65 + 3] = v1.w;
  d[32 * 65] = v2.x; d[32 * 65 + 1] = v2.y; d[32 * 65 + 2] = v2.z; d[32 * 65 + 3] = v2.w;
  d[48 * 65] = v3.x; d[48 * 65 + 1] = v3.y; d[48 * 65 + 2] = v3.z; d[48 * 65 + 3] = v3.w;
}
DI void t_store(const TDesc& d, const float* lds) {
  const int tid = threadIdx.x; const int nn = tid >> 2, kq = (tid & 3) * 16;
  unsigned w[8];
#pragma unroll
  for (int j = 0; j < 8; ++j) w[j] = pack2(lds[(kq + 2 * j) * 65 + nn], lds[(kq + 2 * j + 1) * 65 + nn]);
  bf16_t* o = d.dst + (size_t)(d.tn * 64 + nn) * d.K + d.tk * 64 + kq;
  *(uint4*)o = make_uint4(w[0], w[1], w[2], w[3]);
  *(uint4*)(o + 8) = make_uint4(w[4], w[5], w[6], w[7]);
}

DI void mod_unit(const Params& p, int u, float* lds) {
  float* sil = lds; float* red = lds + 3072;
  float* MOD = (float*)(p.ws + OFF_MOD);
  const int tid = threadIdx.x;
  for (int i = tid; i < 3072; i += 256) { int j = i >> 10, k = i & 1023; float v = (j == 0) ? p.c_ctx[k] : p.c[(j - 1) * 1024 + k]; sil[i] = v / (1.f + expf(-v)); }
  __syncthreads();
  const int l = u / 48, cb = u % 48; const int cgp = tid & 31, kg = tid >> 5;
  const float* w = p.ada_w + (size_t)l * 1024 * 6144 + cb * 128 + cgp * 4;
  float a0x = 0, a0y = 0, a0z = 0, a0w = 0, a1x = 0, a1y = 0, a1z = 0, a1w = 0, a2x = 0, a2y = 0, a2z = 0, a2w = 0;
#pragma unroll 4
  for (int k = kg * 128; k < kg * 128 + 128; ++k) {
    float4 wv = *(const float4*)(w + (size_t)k * 6144);
    float s0 = sil[k], s1 = sil[1024 + k], s2 = sil[2048 + k];
    a0x += s0 * wv.x; a0y += s0 * wv.y; a0z += s0 * wv.z; a0w += s0 * wv.w;
    a1x += s1 * wv.x; a1y += s1 * wv.y; a1z += s1 * wv.z; a1w += s1 * wv.w;
    a2x += s2 * wv.x; a2y += s2 * wv.y; a2z += s2 * wv.z; a2w += s2 * wv.w;
  }
  float* r0 = red + (kg * 3 + 0) * 128 + cgp * 4; r0[0] = a0x; r0[1] = a0y; r0[2] = a0z; r0[3] = a0w;
  float* r1 = red + (kg * 3 + 1) * 128 + cgp * 4; r1[0] = a1x; r1[1] = a1y; r1[2] = a1z; r1[3] = a1w;
  float* r2 = red + (kg * 3 + 2) * 128 + cgp * 4; r2[0] = a2x; r2[1] = a2y; r2[2] = a2z; r2[3] = a2w;
  __syncthreads();
  for (int i = tid; i < 384; i += 256) {
    int j = i >> 7, cc = i & 127; float s = 0;
#pragma unroll
    for (int g = 0; g < 8; ++g) s += red[(g * 3 + j) * 128 + cc];
    s += p.ada_b[l * 6144 + cb * 128 + cc];
    MOD[(l * 3 + j) * 6144 + cb * 128 + cc] = s;
  }
  __syncthreads();
}

DI void phase0(const Params& p, unsigned char* smem) {
  float* lds = (float*)smem;
  const int tid = threadIdx.x;
  {
    int item = blockIdx.x;
    if (item < 96) { mod_unit(p, item, lds); item += gridDim.x; }
    float4 v0, v1, v2, v3;
    TDesc cur = tdecode(p, 0);
    bool have = item < 6784;
    if (have) { cur = tdecode(p, item - 96); t_load(cur, v0, v1, v2, v3); }
    while (have) {
      t_ldsw(lds, v0, v1, v2, v3);
      const int nitem = item + gridDim.x; const bool hn = nitem < 6784;
      TDesc nxt = cur;
      if (hn) { nxt = tdecode(p, nitem - 96); t_load(nxt, v0, v1, v2, v3); }
      __syncthreads();
      t_store(cur, lds);
      __syncthreads();
      cur = nxt; item = nitem; have = hn;
    }
  }
  for (int item = blockIdx.x; item < 7041; item += gridDim.x) {
    if (item < 6784) continue;
    int t = item - 96;
    t -= 6688;
    if (t < 256) {
      bf16_t* KC = (bf16_t*)(p.ws + OFF_KC); bf16_t* VCT = (bf16_t*)(p.ws + OFF_VCT);
#pragma unroll 4
      for (int j = 0; j < 16; ++j) {
        int idx = t * 4096 + j * 256 + tid;
        if (idx < 524288) { int d = idx & 127, key = (idx >> 7) & 255, h = (idx >> 15) & 7, b = idx >> 18;
          KC[idx] = f2bf(p.cache_k[((size_t)(b * 256 + key) * 8 + h) * 128 + d]); }
        else { int i2 = idx - 524288; int key = i2 & 255, dv = (i2 >> 8) & 127, h = (i2 >> 15) & 7, b = i2 >> 18;
          VCT[i2] = f2bf(p.cache_v[((size_t)(b * 256 + key) * 8 + h) * 128 + dv]); }
      }
      continue;
    }
    float* ROPE = (float*)(p.ws + OFF_ROPE); float* MISC = (float*)(p.ws + OFF_MISC);
    for (int idx = tid; idx < 1024; idx += 256) {
      int pos = idx >> 4, i = idx & 15;
      float inv = powf(10000.f, -(float)i / 16.f);
      float ang = (float)pos * inv;
      ROPE[idx * 2] = cosf(ang); ROPE[idx * 2 + 1] = sinf(ang);
    }
    if (tid == 0) {
      float s01 = 0, s23 = 0;
      for (int i = 0; i < 64; ++i) { s01 += p.od_lambda[i] * p.od_lambda[64 + i]; s23 += p.od_lambda[128 + i] * p.od_lambda[192 + i]; }
      const float lam_init = 0.8f - 0.6f * expf(-0.3f);
      MISC[0] = expf(s01) - expf(s23) + lam_init;
      MISC[1] = lam_init;
    }
  }
}

DI void norm_phase(const float* src_p, const float* src_s, const float* gain, const float* mod, int sc_off, int sh_off, bf16_t* A) {
  const int wave = threadIdx.x >> 6, lane = threadIdx.x & 63;
  for (int row = blockIdx.x * 4 + wave; row < M; row += gridDim.x * 4) {
    const float* src = row < MP ? src_p + (size_t)row * D : src_s + (size_t)(row - MP) * D;
    const int j = row < MP ? 0 : 1 + ((row - MP) >> 11);
    float4 v[4]; float ss = 0;
#pragma unroll
    for (int i = 0; i < 4; ++i) { v[i] = *(const float4*)(src + i * 256 + lane * 4); ss += v[i].x * v[i].x + v[i].y * v[i].y + v[i].z * v[i].z + v[i].w * v[i].w; }
    ss = wsum(ss);
    const float rstd = rsqrtf(ss * (1.f / 1024.f) + 1e-6f);
    const float* msc = mod + j * 6144 + sc_off; const float* msh = mod + j * 6144 + sh_off;
#pragma unroll
    for (int i = 0; i < 4; ++i) {
      int c = i * 256 + lane * 4;
      float4 g4 = *(const float4*)(gain + c), sc4 = *(const float4*)(msc + c), sh4 = *(const float4*)(msh + c);
      float o0 = v[i].x * rstd * g4.x * (1.f + sc4.x) + sh4.x;
      float o1 = v[i].y * rstd * g4.y * (1.f + sc4.y) + sh4.y;
      float o2 = v[i].z * rstd * g4.z * (1.f + sc4.z) + sh4.z;
      float o3 = v[i].w * rstd * g4.w * (1.f + sc4.w) + sh4.w;
      *(uint2*)(A + (size_t)row * D + c) = pack4(o0, o1, o2, o3);
    }
  }
}

DI void final_norm_phase(float* X, const float* gain) {
  const int wave = threadIdx.x >> 6, lane = threadIdx.x & 63;
  for (int row = blockIdx.x * 4 + wave; row < M; row += gridDim.x * 4) {
    float* src = X + (size_t)row * D;
    float4 v[4]; float ss = 0;
#pragma unroll
    for (int i = 0; i < 4; ++i) { v[i] = *(const float4*)(src + i * 256 + lane * 4); ss += v[i].x * v[i].x + v[i].y * v[i].y + v[i].z * v[i].z + v[i].w * v[i].w; }
    ss = wsum(ss);
    const float rstd = rsqrtf(ss * (1.f / 1024.f) + 1e-6f);
#pragma unroll
    for (int i = 0; i < 4; ++i) {
      int c = i * 256 + lane * 4;
      float4 g4 = *(const float4*)(gain + c);
      float4 o; o.x = v[i].x * rstd * g4.x; o.y = v[i].y * rstd * g4.y; o.z = v[i].z * rstd * g4.z; o.w = v[i].w * rstd * g4.w;
      *(float4*)(src + c) = o;
    }
  }
}

template <int BM, int BN, int BK, bool SPLIT, class Epi>
DI void gemm_phase(const bf16_t* __restrict__ A, int lda, const bf16_t* __restrict__ Bt, int ldb, int Mrows, int N, int K, const Epi& epi, unsigned char* smem) {
  constexpr int MI = BM / 64, NI = BN / 64;
  constexpr int LDK = BK + 8;
  constexpr int LDS_A = BM * LDK, LDS_B = BN * LDK;
  constexpr int CPR = BK / 8;
  constexpr int RPP = 256 / CPR;
  constexpr int NA = BM / RPP, NB = BN / RPP;
  bf16_t* As = (bf16_t*)smem;
  bf16_t* Bs = As + 2 * LDS_A;
  const int tid = threadIdx.x, lane = tid & 63, wave = tid >> 6, wm = wave >> 1, wn = wave & 1, lr = lane & 31, lh = lane >> 5;
  const int ntm = Mrows / BM, ntn = N / BN, nkfull = K / BK;
  const int lrow = tid / CPR, lch = tid % CPR;
  const int lofs = lrow * LDK + lch * 8;
  const bf16_t* as0 = As + (wm * (BM / 2) + lr) * LDK + lh * 8;
  const bf16_t* bs0 = Bs + (wn * (BN / 2) + lr) * LDK + lh * 8;
  const int ntiles = ntm * ntn;
  const int nfull = SPLIT ? ((int)gridDim.x < ntiles ? (int)gridDim.x : ntiles) : ntiles;
  const int nitems = SPLIT ? nfull + 2 * (ntiles - nfull) : ntiles;
  for (int item = blockIdx.x; item < nitems; item += gridDim.x) {
    int tile = item, kbeg = 0, nk = nkfull; bool part = false;
    if (SPLIT && item >= nfull) { tile = nfull + ((item - nfull) >> 1); nk = nkfull >> 1; kbeg = ((item - nfull) & 1) * nk; part = true; }
    const int tm = tile % ntm, tn = tile / ntm; const int m0 = tm * BM, n0 = tn * BN;
    f32x16 acc[MI][NI];
#pragma unroll
    for (int mi = 0; mi < MI; ++mi)
#pragma unroll
      for (int ni = 0; ni < NI; ++ni) acc[mi][ni] = zero16();
    static_assert(NA <= 4 && NB <= 4, "staging registers");
    uint4 a00, a01, a02, a03, b00, b01, b02, b03, a10, a11, a12, a13, b10, b11, b12, b13;
    a00 = a01 = a02 = a03 = b00 = b01 = b02 = b03 = a10 = a11 = a12 = a13 = b10 = b11 = b12 = b13 = make_uint4(0u, 0u, 0u, 0u);
    const bf16_t* Ag = A + (size_t)(m0 + lrow) * lda + lch * 8 + (size_t)kbeg * BK;
    const bf16_t* Bg = Bt + (size_t)(n0 + lrow) * ldb + lch * 8 + (size_t)kbeg * BK;
    if (NA > 0) a00 = *(const uint4*)(Ag + (size_t)(RPP * 0) * lda + (0) * BK);
    if (NA > 1) a01 = *(const uint4*)(Ag + (size_t)(RPP * 1) * lda + (0) * BK);
    if (NA > 2) a02 = *(const uint4*)(Ag + (size_t)(RPP * 2) * lda + (0) * BK);
    if (NA > 3) a03 = *(const uint4*)(Ag + (size_t)(RPP * 3) * lda + (0) * BK);
    if (NB > 0) b00 = *(const uint4*)(Bg + (size_t)(RPP * 0) * ldb + (0) * BK);
    if (NB > 1) b01 = *(const uint4*)(Bg + (size_t)(RPP * 1) * ldb + (0) * BK);
    if (NB > 2) b02 = *(const uint4*)(Bg + (size_t)(RPP * 2) * ldb + (0) * BK);
    if (NB > 3) b03 = *(const uint4*)(Bg + (size_t)(RPP * 3) * ldb + (0) * BK);
    if (NA > 0) a10 = *(const uint4*)(Ag + (size_t)(RPP * 0) * lda + (1) * BK);
    if (NA > 1) a11 = *(const uint4*)(Ag + (size_t)(RPP * 1) * lda + (1) * BK);
    if (NA > 2) a12 = *(const uint4*)(Ag + (size_t)(RPP * 2) * lda + (1) * BK);
    if (NA > 3) a13 = *(const uint4*)(Ag + (size_t)(RPP * 3) * lda + (1) * BK);
    if (NB > 0) b10 = *(const uint4*)(Bg + (size_t)(RPP * 0) * ldb + (1) * BK);
    if (NB > 1) b11 = *(const uint4*)(Bg + (size_t)(RPP * 1) * ldb + (1) * BK);
    if (NB > 2) b12 = *(const uint4*)(Bg + (size_t)(RPP * 2) * ldb + (1) * BK);
    if (NB > 3) b13 = *(const uint4*)(Bg + (size_t)(RPP * 3) * ldb + (1) * BK);
    if (NA > 0) *(uint4*)(As + (0) * LDS_A + lofs + RPP * 0 * LDK) = a00;
    if (NA > 1) *(uint4*)(As + (0) * LDS_A + lofs + RPP * 1 * LDK) = a01;
    if (NA > 2) *(uint4*)(As + (0) * LDS_A + lofs + RPP * 2 * LDK) = a02;
    if (NA > 3) *(uint4*)(As + (0) * LDS_A + lofs + RPP * 3 * LDK) = a03;
    if (NB > 0) *(uint4*)(Bs + (0) * LDS_B + lofs + RPP * 0 * LDK) = b00;
    if (NB > 1) *(uint4*)(Bs + (0) * LDS_B + lofs + RPP * 1 * LDK) = b01;
    if (NB > 2) *(uint4*)(Bs + (0) * LDS_B + lofs + RPP * 2 * LDK) = b02;
    if (NB > 3) *(uint4*)(Bs + (0) * LDS_B + lofs + RPP * 3 * LDK) = b03;
    __syncthreads();
    for (int kt = 0; kt < nk; kt += 2) {
      if (kt + 2 < nk) {
        if (NA > 0) a00 = *(const uint4*)(Ag + (size_t)(RPP * 0) * lda + (kt + 2) * BK);
        if (NA > 1) a01 = *(const uint4*)(Ag + (size_t)(RPP * 1) * lda + (kt + 2) * BK);
        if (NA > 2) a02 = *(const uint4*)(Ag + (size_t)(RPP * 2) * lda + (kt + 2) * BK);
        if (NA > 3) a03 = *(const uint4*)(Ag + (size_t)(RPP * 3) * lda + (kt + 2) * BK);
        if (NB > 0) b00 = *(const uint4*)(Bg + (size_t)(RPP * 0) * ldb + (kt + 2) * BK);
        if (NB > 1) b01 = *(const uint4*)(Bg + (size_t)(RPP * 1) * ldb + (kt + 2) * BK);
        if (NB > 2) b02 = *(const uint4*)(Bg + (size_t)(RPP * 2) * ldb + (kt + 2) * BK);
        if (NB > 3) b03 = *(const uint4*)(Bg + (size_t)(RPP * 3) * ldb + (kt + 2) * BK);
      }
      {
        __builtin_amdgcn_iglp_opt(1);
        const bf16_t* as = as0 + (0) * LDS_A; const bf16_t* bs = bs0 + (0) * LDS_B;
      #pragma unroll
        for (int ks = 0; ks < BK / 16; ++ks) {
          bf16x8 af[MI], bfr[NI];
      #pragma unroll
          for (int mi = 0; mi < MI; ++mi) af[mi] = ld8(as + mi * 32 * LDK + ks * 16);
      #pragma unroll
          for (int ni = 0; ni < NI; ++ni) bfr[ni] = ld8(bs + ni * 32 * LDK + ks * 16);
      #pragma unroll
          for (int mi = 0; mi < MI; ++mi)
      #pragma unroll
            for (int ni = 0; ni < NI; ++ni) acc[mi][ni] = MFMA(af[mi], bfr[ni], acc[mi][ni]);
        }
      }
      if (NA > 0) *(uint4*)(As + (1) * LDS_A + lofs + RPP * 0 * LDK) = a10;
      if (NA > 1) *(uint4*)(As + (1) * LDS_A + lofs + RPP * 1 * LDK) = a11;
      if (NA > 2) *(uint4*)(As + (1) * LDS_A + lofs + RPP * 2 * LDK) = a12;
      if (NA > 3) *(uint4*)(As + (1) * LDS_A + lofs + RPP * 3 * LDK) = a13;
      if (NB > 0) *(uint4*)(Bs + (1) * LDS_B + lofs + RPP * 0 * LDK) = b10;
      if (NB > 1) *(uint4*)(Bs + (1) * LDS_B + lofs + RPP * 1 * LDK) = b11;
      if (NB > 2) *(uint4*)(Bs + (1) * LDS_B + lofs + RPP * 2 * LDK) = b12;
      if (NB > 3) *(uint4*)(Bs + (1) * LDS_B + lofs + RPP * 3 * LDK) = b13;
      __syncthreads();
      if (kt + 3 < nk) {
        if (NA > 0) a10 = *(const uint4*)(Ag + (size_t)(RPP * 0) * lda + (kt + 3) * BK);
        if (NA > 1) a11 = *(const uint4*)(Ag + (size_t)(RPP * 1) * lda + (kt + 3) * BK);
        if (NA > 2) a12 = *(const uint4*)(Ag + (size_t)(RPP * 2) * lda + (kt + 3) * BK);
        if (NA > 3) a13 = *(const uint4*)(Ag + (size_t)(RPP * 3) * lda + (kt + 3) * BK);
        if (NB > 0) b10 = *(const uint4*)(Bg + (size_t)(RPP * 0) * ldb + (kt + 3) * BK);
        if (NB > 1) b11 = *(const uint4*)(Bg + (size_t)(RPP * 1) * ldb + (kt + 3) * BK);
        if (NB > 2) b12 = *(const uint4*)(Bg + (size_t)(RPP * 2) * ldb + (kt + 3) * BK);
        if (NB > 3) b13 = *(const uint4*)(Bg + (size_t)(RPP * 3) * ldb + (kt + 3) * BK);
      }
      {
        __builtin_amdgcn_iglp_opt(1);
        const bf16_t* as = as0 + (1) * LDS_A; const bf16_t* bs = bs0 + (1) * LDS_B;
      #pragma unroll
        for (int ks = 0; ks < BK / 16; ++ks) {
          bf16x8 af[MI], bfr[NI];
      #pragma unroll
          for (int mi = 0; mi < MI; ++mi) af[mi] = ld8(as + mi * 32 * LDK + ks * 16);
      #pragma unroll
          for (int ni = 0; ni < NI; ++ni) bfr[ni] = ld8(bs + ni * 32 * LDK + ks * 16);
      #pragma unroll
          for (int mi = 0; mi < MI; ++mi)
      #pragma unroll
            for (int ni = 0; ni < NI; ++ni) acc[mi][ni] = MFMA(af[mi], bfr[ni], acc[mi][ni]);
        }
      }
      if (kt + 2 < nk) {
        if (NA > 0) *(uint4*)(As + (0) * LDS_A + lofs + RPP * 0 * LDK) = a00;
        if (NA > 1) *(uint4*)(As + (0) * LDS_A + lofs + RPP * 1 * LDK) = a01;
        if (NA > 2) *(uint4*)(As + (0) * LDS_A + lofs + RPP * 2 * LDK) = a02;
        if (NA > 3) *(uint4*)(As + (0) * LDS_A + lofs + RPP * 3 * LDK) = a03;
        if (NB > 0) *(uint4*)(Bs + (0) * LDS_B + lofs + RPP * 0 * LDK) = b00;
        if (NB > 1) *(uint4*)(Bs + (0) * LDS_B + lofs + RPP * 1 * LDK) = b01;
        if (NB > 2) *(uint4*)(Bs + (0) * LDS_B + lofs + RPP * 2 * LDK) = b02;
        if (NB > 3) *(uint4*)(Bs + (0) * LDS_B + lofs + RPP * 3 * LDK) = b03;
      }
      __syncthreads();
    }
    epi.template run<MI, NI>(acc, m0 + wm * (BM / 2), n0 + wn * (BN / 2), lr, lh, part);
  }
}

struct EpiEvIn {
  bf16_t* PN; bf16_t* PT; float* gates; const float* gate_b;
  template <int MI, int NI> DI void run(f32x16 (&acc)[MI][NI], int rbase, int cbase, int lr, int lh, bool part) const {
#pragma unroll
    for (int ni = 0; ni < NI; ++ni) {
      const int col = cbase + ni * 32 + lr; const int seg = col >> 9, cc = col & 511;
      int nat = -1, tr = -1; float scale = 1.f;
      switch (seg) {
        case 0: nat = 0; scale = 0.08838834764831845f; break;
        case 1: nat = 512; tr = 0; break;
        case 2: tr = 512; break;
        case 3: nat = 1024; break;
        case 4: nat = 1536; break;
        case 5: nat = 2048; break;
        case 6: nat = 2560; break;
        case 7: tr = 1024; break;
        case 8: nat = 3072; break;
        default: break;
      }
#pragma unroll
      for (int mi = 0; mi < MI; ++mi)
#pragma unroll
        for (int g = 0; g < 4; ++g) {
          const int row = rbase + mi * 32 + 8 * g + 4 * lh;
          float v0 = acc[mi][ni][4 * g] * scale, v1 = acc[mi][ni][4 * g + 1] * scale, v2 = acc[mi][ni][4 * g + 2] * scale, v3 = acc[mi][ni][4 * g + 3] * scale;
          if (seg == 9) {
            if (cc < 16) { float b = gate_b[cc];
              gates[(size_t)row * 16 + cc] = v0 + b; gates[(size_t)(row + 1) * 16 + cc] = v1 + b; gates[(size_t)(row + 2) * 16 + cc] = v2 + b; gates[(size_t)(row + 3) * 16 + cc] = v3 + b; }
          } else {
            if (nat >= 0) { bf16_t* d = PN + (size_t)row * PNW + nat + cc; d[0] = f2bf(v0); d[PNW] = f2bf(v1); d[2 * PNW] = f2bf(v2); d[3 * PNW] = f2bf(v3); }
            if (tr >= 0) *(uint2*)(PT + (size_t)(tr + cc) * M + row) = pack4(v0, v1, v2, v3);
          }
        }
    }
  }
};

struct EpiResid {
  const float* xin_p; const float* xin_s; float* X; const float* gmod;
  template <int MI, int NI> DI void run(f32x16 (&acc)[MI][NI], int rbase, int cbase, int lr, int lh, bool part) const {
#pragma unroll
    for (int ni = 0; ni < NI; ++ni) {
      const int col = cbase + ni * 32 + lr;
#pragma unroll
      for (int mi = 0; mi < MI; ++mi) {
        const int r0 = rbase + mi * 32; const int j = r0 < MP ? 0 : 1 + ((r0 - MP) >> 11);
        const float gv = gmod[j * 6144 + col];
#pragma unroll
        for (int gg = 0; gg < 4; ++gg) {
          const int row = rbase + mi * 32 + 8 * gg + 4 * lh;
          const float* xi = (row < MP ? xin_p + (size_t)row * D : xin_s + (size_t)(row - MP) * D) + col;
          float* xo = X + (size_t)row * D + col;
#pragma unroll
          for (int e = 0; e < 4; ++e) {
            if (part) atomicAdd(xo + (size_t)e * D, gv * acc[mi][ni][4 * gg + e]);
            else xo[(size_t)e * D] = xi[(size_t)e * D] + gv * acc[mi][ni][4 * gg + e];
          }
        }
      }
    }
  }
};

struct EpiFFUp {
  bf16_t* U;
  template <int MI, int NI> DI void run(f32x16 (&acc)[MI][NI], int rbase, int cbase, int lr, int lh, bool part) const {
    static_assert(NI == 2, "ffn up needs paired tiles");
    const int oc = (cbase >> 6) * 32 + lr;
#pragma unroll
    for (int mi = 0; mi < MI; ++mi)
#pragma unroll
      for (int g = 0; g < 4; ++g) {
        const int row = rbase + mi * 32 + 8 * g + 4 * lh;
#pragma unroll
        for (int e = 0; e < 4; ++e) {
          float a1 = acc[mi][0][4 * g + e], a3 = acc[mi][1][4 * g + e];
          U[(size_t)(row + e) * DFF + oc] = f2bf(a1 * __frcp_rn(1.f + __expf(-a1)) * a3);
        }
      }
  }
};

struct EpiOdIn {
  bf16_t* Q; bf16_t* Kb; bf16_t* VT; float* AK; float* AV; const float* rope;
  template <int MI, int NI> DI void run(f32x16 (&acc)[MI][NI], int rbase, int cbase, int lr, int lh, bool part) const {
#pragma unroll
    for (int ni = 0; ni < NI; ++ni) {
      const int col = cbase + ni * 32 + lr; const int seg = col >> 10, cc = col & 1023; const int d = col & 127;
#pragma unroll
      for (int mi = 0; mi < MI; ++mi)
#pragma unroll
        for (int g = 0; g < 4; ++g) {
          const bool sample = (rbase + mi * 32) >= MP;
          const int row = rbase + mi * 32 + 8 * g + 4 * lh;
          float v[4];
#pragma unroll
          for (int e = 0; e < 4; ++e) v[e] = acc[mi][ni][4 * g + e];
          if (seg < 2) {
            if (sample) {
#pragma unroll
              for (int e = 0; e < 4; ++e) {
                float pv = __shfl_xor(v[e], 16);
                int n = (row + e - MP) & 2047; int pos = (d & 32) ? (n & 63) : (n >> 6);
                float2 cs = *(const float2*)(rope + (pos * 16 + (d & 15)) * 2);
                v[e] = (d & 16) ? (pv * cs.y + v[e] * cs.x) : (v[e] * cs.x - pv * cs.y);
              }
            }
            if (seg == 0) {
#pragma unroll
              for (int e = 0; e < 4; ++e) Q[(size_t)(row + e) * 1024 + cc] = f2bf(v[e] * 0.18033688011112042f);
            } else {
#pragma unroll
              for (int e = 0; e < 4; ++e) Kb[(size_t)(row + e) * 1024 + cc] = f2bf(v[e]);
              if (!sample) {
#pragma unroll
                for (int e = 0; e < 4; ++e) AK[(size_t)(row + e) * 1024 + cc] = v[e];
              }
            }
          } else {
            *(uint2*)(VT + (size_t)cc * M + row) = pack4(v[0], v[1], v[2], v[3]);
            if (!sample) {
#pragma unroll
              for (int e = 0; e < 4; ++e) AV[(size_t)(row + e) * 1024 + cc] = v[e];
            }
          }
        }
    }
  }
};

DI void s1_phase(const Params& p, unsigned char* smem) {
  bf16_t* Vt = (bf16_t*)smem;
  bf16_t* Ktf = Vt + 128 * 72;
  bf16_t* Ktb = Ktf + 128 * 72;
  float* wgf = (float*)(Ktb + 128 * 72);
  float* wgb = wgf + 64;
  const bf16_t* PN = (const bf16_t*)(p.ws + OFF_PN);
  const bf16_t* PT = (const bf16_t*)(p.ws + OFF_PT);
  const float* GATES = (const float*)(p.ws + OFF_GATES);
  float* SCAL = (float*)(p.ws + OFF_SCAL);
  float* NLOC = (float*)(p.ws + OFF_NLOC);
  float* AL = (float*)(p.ws + OFF_AL);
  bf16_t* MLST = (bf16_t*)(p.ws + OFF_ST);
  bf16_t* HGST = (bf16_t*)(p.out);
  const int tid = threadIdx.x, lane = tid & 63, wave = tid >> 6, lr = lane & 31, lh = lane >> 5;
  for (int item = blockIdx.x; item < 1536; item += gridDim.x) {
    const int kind = item >= 768; const int it = item - kind * 768; const int gc = it >> 2, h = it & 3; const int tok0 = gc * 64;
    const int slot0 = it * 2;
    if (kind == 0) {
      load_tile_128x64(Vt, PT + (size_t)(512 + h * 128) * M + tok0, M);
      uint4 rk[4];
      const bf16_t* PTk = PT + (size_t)(h * 128) * M + tok0;
#pragma unroll
      for (int i = 0; i < 4; ++i) { int c = tid + 256 * i; rk[i] = *(const uint4*)(PTk + (size_t)(c >> 3) * M + (c & 7) * 8); }
      if (wave == 0) {
        const float* gp = GATES + (size_t)(tok0 + lane) * 16;
        float igf = gp[h], igb = gp[4 + h], lff = logsig(gp[8 + h]), lfb = logsig(gp[12 + h]);
        float bfw = lff;
#pragma unroll
        for (int o = 1; o < 64; o <<= 1) { float t = __shfl_up(bfw, o); if (lane >= o) bfw += t; }
        float blf = __shfl(bfw, 63);
        float gf = blf - bfw + igf; float mlocf = wmax(gf); wgf[lane] = expf(gf - mlocf);
        float bbw = lfb;
#pragma unroll
        for (int o = 1; o < 64; o <<= 1) { float t = __shfl_down(bbw, o); if (lane + o < 64) bbw += t; }
        float blb = __shfl(bbw, 0);
        float gb = blb - bbw + igb; float mlocb = wmax(gb); wgb[lane] = expf(gb - mlocb);
        if (lane == 0) { SCAL[slot0 * 4 + 0] = blf; SCAL[slot0 * 4 + 1] = mlocf; SCAL[(slot0 + 1) * 4 + 0] = blb; SCAL[(slot0 + 1) * 4 + 1] = mlocb; }
      }
      __syncthreads();
#pragma unroll
      for (int i = 0; i < 4; ++i) {
        int c = tid + 256 * i; int row = c >> 3, ch = c & 7;
        unsigned w[4] = {rk[i].x, rk[i].y, rk[i].z, rk[i].w};
        unsigned of[4], ob[4];
#pragma unroll
        for (int q = 0; q < 4; ++q) {
          float k0 = lo_bf(w[q]), k1 = hi_bf(w[q]);
          int t = ch * 8 + q * 2;
          of[q] = pack2(k0 * wgf[t], k1 * wgf[t + 1]); ob[q] = pack2(k0 * wgb[t], k1 * wgb[t + 1]);
        }
        *(uint4*)(Ktf + row * 72 + ch * 8) = make_uint4(of[0], of[1], of[2], of[3]);
        *(uint4*)(Ktb + row * 72 + ch * 8) = make_uint4(ob[0], ob[1], ob[2], ob[3]);
      }
    } else {
      bf16_t* Xf = Vt;
      bf16_t* Xb = (bf16_t*)(smem + 55808);
      load_tile_64x128(Xf, PN + (size_t)tok0 * PNW + 2048 + h * 128, PNW);
      load_tile_64x128(Xb, PN + (size_t)tok0 * PNW + 2560 + h * 128, PNW);
      __syncthreads();
      const int dir = tid >> 7, dk = tid & 127; const int ch = h * 128 + dk;
      const float lb = 1.f / (1.f + expf(p.ev_lb_logits[512 + ch] - p.ev_lb_logits[ch]));
      const bf16_t* xs = dir ? Xb : Xf;
      bf16_t* Kt = dir ? Ktb : Ktf;
      float R = 1.f;
#pragma unroll 2
      for (int s = 0; s < 64; ++s) {
        int t = dir ? s : 63 - s;
        float x = bf2f(xs[t * 136 + dk]); float f = lb + (1.f - lb) * __frcp_rn(1.f + __expf(-x));
        Kt[dk * 72 + t] = f2bf((1.f - f) * R); R *= f;
      }
      AL[(slot0 + dir) * 128 + dk] = R;
      __syncthreads();
      load_tile_128x64(Vt, PT + (size_t)(1024 + h * 128) * M + tok0, M);
    }
    __syncthreads();
    bf16_t* ST = kind ? HGST : MLST;
#pragma unroll 1
    for (int dir = 0; dir < 2; ++dir) {
      const bf16_t* Kt = dir ? Ktb : Ktf;
      f32x16 acc[4];
#pragma unroll
      for (int ni = 0; ni < 4; ++ni) acc[ni] = zero16();
#pragma unroll
      for (int ks = 0; ks < 4; ++ks) {
        bf16x8 a = ld8(Kt + (wave * 32 + lr) * 72 + ks * 16 + lh * 8);
#pragma unroll
        for (int ni = 0; ni < 4; ++ni) { bf16x8 b = ld8(Vt + (ni * 32 + lr) * 72 + ks * 16 + lh * 8); acc[ni] = MFMA(a, b, acc[ni]); }
      }
      bf16_t* dst = ST + (size_t)(slot0 + dir) * 16384;
#pragma unroll
      for (int ni = 0; ni < 4; ++ni)
#pragma unroll
        for (int g = 0; g < 4; ++g)
          *(uint2*)(dst + (ni * 32 + lr) * 128 + wave * 32 + 8 * g + 4 * lh) = pack4(acc[ni][4 * g], acc[ni][4 * g + 1], acc[ni][4 * g + 2], acc[ni][4 * g + 3]);
    }
    if (kind == 0) {
      const int dir = tid >> 7, dk = tid & 127; const bf16_t* Kt = dir ? Ktb : Ktf; float s = 0.f;
#pragma unroll 8
      for (int t = 0; t < 64; ++t) s += bf2f(Kt[dk * 72 + t]);
      NLOC[(slot0 + dir) * 128 + dk] = s;
    }
    __syncthreads();
  }
}

DI void s2_phase(const Params& p, unsigned char* smem) {
  const float* __restrict__ SCAL = (const float*)(p.ws + OFF_SCAL);
  float* __restrict__ MINIT = (float*)(p.ws + OFF_MINIT);
  const float* __restrict__ NLOC = (const float*)(p.ws + OFF_NLOC);
  float* __restrict__ NINIT = (float*)(p.ws + OFF_NINIT);
  const float* __restrict__ AL = (const float*)(p.ws + OFF_AL);
  bf16_t* MLST = (bf16_t*)(p.ws + OFF_ST);
  bf16_t* HGST = (bf16_t*)(p.out);
  float* tl = (float*)smem;
  const int tid = threadIdx.x;
  for (int u = blockIdx.x; u < 4352; u += gridDim.x) {
    int kind, sample, seq, h, dir, slab;
    if (u < 256) { kind = u >> 7; int v = u & 127; slab = v & 7; v >>= 3; dir = v & 1; v >>= 1; h = v & 3; seq = v >> 2; sample = 1; }
    else { int v = u - 256; kind = v >= 2048; v -= kind * 2048; slab = v & 7; v >>= 3; dir = v & 1; v >>= 1; h = v & 3; seq = v >> 2; sample = 0; }
    const int nc = sample ? 32 : 4; const int gc0 = sample ? 128 + seq * 32 : seq * 4;
    bf16_t* ST = kind ? HGST : MLST;
    const int e = slab * 2048 + tid * 8; const int dv = e >> 7, dk0 = e & 127;
    float st[8]; float nst = 0.f, m = 0.f;
    const int sidx = (seq * 2 + dir) * 4 + h;
    if (sample) {
      const float* S0 = (kind ? p.st_S : p.st_C) + (size_t)sidx * 16384;
#pragma unroll
      for (int j = 0; j < 8; ++j) st[j] = S0[(dk0 + j) * 128 + dv];
      if (kind == 0) { m = p.st_m[sidx]; if (slab == 0 && tid < 128) nst = p.st_n[sidx * 128 + tid]; }
    } else {
#pragma unroll
      for (int j = 0; j < 8; ++j) st[j] = 0.f;
    }
    const int slot0 = ((gc0 + (dir ? nc - 1 : 0)) * 4 + h) * 2 + dir;
    const int sstep = dir ? -8 : 8;
    uint4 Lq[4]; float4 Aq0[4], Aq1[4]; float2 Sq[4]; float Nq[4];
    const bool nthr = (kind == 0) && (slab == 0) && (tid < 128);
#pragma unroll
    for (int i = 0; i < 4; ++i) {
      const int sl = slot0 + i * sstep;
      Lq[i] = *(const uint4*)(ST + (size_t)sl * 16384 + e);
      Aq0[i] = make_float4(0.f, 0.f, 0.f, 0.f); Aq1[i] = Aq0[i]; Sq[i] = make_float2(0.f, 0.f); Nq[i] = 0.f;
      if (kind) { Aq0[i] = *(const float4*)(AL + sl * 128 + dk0); Aq1[i] = *(const float4*)(AL + sl * 128 + dk0 + 4); }
      else { Sq[i] = *(const float2*)(SCAL + sl * 4); if (nthr) Nq[i] = NLOC[sl * 128 + tid]; }
    }
    for (int ps = 0; ps < nc; ps += 4) {
#pragma unroll
      for (int i = 0; i < 4; ++i) {
        const int slot = slot0 + (ps + i) * sstep;
        const uint4 Lc = Lq[i];
        float dec[8]; float ls;
        if (kind == 0) {
          const float bl = Sq[i].x, mloc = Sq[i].y; const float mn = fmaxf(bl + m, mloc); const float d = __expf(bl + m - mn); ls = __expf(mloc - mn);
#pragma unroll
          for (int j = 0; j < 8; ++j) dec[j] = d;
          if (slab == 0) { if (tid == 0) MINIT[slot] = m; if (tid < 128) { NINIT[slot * 128 + tid] = nst; nst = d * nst + ls * Nq[i]; } }
          m = mn;
        } else {
          ls = 1.f;
          dec[0] = Aq0[i].x; dec[1] = Aq0[i].y; dec[2] = Aq0[i].z; dec[3] = Aq0[i].w;
          dec[4] = Aq1[i].x; dec[5] = Aq1[i].y; dec[6] = Aq1[i].z; dec[7] = Aq1[i].w;
        }
        *(uint4*)(ST + (size_t)slot * 16384 + e) = make_uint4(pack2(st[0], st[1]), pack2(st[2], st[3]), pack2(st[4], st[5]), pack2(st[6], st[7]));
        float l[8] = {lo_bf(Lc.x), hi_bf(Lc.x), lo_bf(Lc.y), hi_bf(Lc.y), lo_bf(Lc.z), hi_bf(Lc.z), lo_bf(Lc.w), hi_bf(Lc.w)};
#pragma unroll
        for (int j = 0; j < 8; ++j) st[j] = dec[j] * st[j] + ls * l[j];
        if (ps + i + 4 < nc) {
          const int sl = slot + 4 * sstep;
          Lq[i] = *(const uint4*)(ST + (size_t)sl * 16384 + e);
          if (kind) { Aq0[i] = *(const float4*)(AL + sl * 128 + dk0); Aq1[i] = *(const float4*)(AL + sl * 128 + dk0 + 4); }
          else { Sq[i] = *(const float2*)(SCAL + sl * 4); if (nthr) Nq[i] = NLOC[sl * 128 + tid]; }
        }
      }
    }
    if (!sample) {
#pragma unroll
      for (int j = 0; j < 8; ++j) tl[(dk0 + j) * 17 + (dv & 15)] = st[j];
      __syncthreads();
      float* Co = p.out + (kind ? OUT_S : OUT_C) + (size_t)sidx * 16384;
      const int dkr = tid >> 1, hf = tid & 1;
      float4 o0, o1;
      o0.x = tl[dkr * 17 + hf * 8 + 0]; o0.y = tl[dkr * 17 + hf * 8 + 1]; o0.z = tl[dkr * 17 + hf * 8 + 2]; o0.w = tl[dkr * 17 + hf * 8 + 3];
      o1.x = tl[dkr * 17 + hf * 8 + 4]; o1.y = tl[dkr * 17 + hf * 8 + 5]; o1.z = tl[dkr * 17 + hf * 8 + 6]; o1.w = tl[dkr * 17 + hf * 8 + 7];
      *(float4*)(Co + dkr * 128 + slab * 16 + hf * 8) = o0;
      *(float4*)(Co + dkr * 128 + slab * 16 + hf * 8 + 4) = o1;
      if (kind == 0 && slab == 0) { if (tid < 128) p.out[OUT_N + sidx * 128 + tid] = nst; if (tid == 0) p.out[OUT_M + sidx] = m; }
      __syncthreads();
    }
  }
}

DI void s3_epilogue(const float* Hs, const float* gain, const bf16_t* gate_src, bf16_t* mix_dst, bool use_silu) {
  const int tid = threadIdx.x, t = tid >> 2, part = tid & 3;
  const float* hr = Hs + t * 132 + part * 32;
  float ss = 0.f;
#pragma unroll
  for (int i = 0; i < 8; ++i) { float4 v = *(const float4*)(hr + i * 4); ss += v.x * v.x + v.y * v.y + v.z * v.z + v.w * v.w; }
  ss += __shfl_xor(ss, 1); ss += __shfl_xor(ss, 2);
  const float rstd = rsqrtf(ss * (1.f / 128.f) + 1e-6f);
#pragma unroll
  for (int i = 0; i < 8; ++i) {
    const int d = part * 32 + i * 4;
    float4 v = *(const float4*)(hr + i * 4); float4 g4 = *(const float4*)(gain + d);
    uint2 gs = *(const uint2*)(gate_src + (size_t)t * PNW + d);
    float x0 = lo_bf(gs.x), x1 = hi_bf(gs.x), x2 = lo_bf(gs.y), x3 = hi_bf(gs.y);
    float s0 = __frcp_rn(1.f + __expf(-x0)), s1 = __frcp_rn(1.f + __expf(-x1)), s2 = __frcp_rn(1.f + __expf(-x2)), s3 = __frcp_rn(1.f + __expf(-x3));
    if (use_silu) { s0 *= x0; s1 *= x1; s2 *= x2; s3 *= x3; }
    *(uint2*)(mix_dst + (size_t)t * 1024 + d) = pack4(v.x * rstd * g4.x * s0, v.y * rstd * g4.y * s1, v.z * rstd * g4.z * s2, v.w * rstd * g4.w * s3);
  }
}

DI void s3_phase(const Params& p, unsigned char* smem) {
  const bf16_t* PN = (const bf16_t*)(p.ws + OFF_PN);
  const bf16_t* PT = (const bf16_t*)(p.ws + OFF_PT);
  const float* GATES = (const float*)(p.ws + OFF_GATES);
  const float* SCAL = (const float*)(p.ws + OFF_SCAL);
  const float* NINIT = (const float*)(p.ws + OFF_NINIT);
  const float* MINIT = (const float*)(p.ws + OFF_MINIT);
  const bf16_t* MLST = (const bf16_t*)(p.ws + OFF_ST);
  const bf16_t* HGST = (const bf16_t*)(p.out);
  bf16_t* MIX = (bf16_t*)(p.out + OUT_AK);
  const int tid = threadIdx.x, lane = tid & 63, wave = tid >> 6, lr = lane & 31, lh = lane >> 5, wm = wave >> 1, wn = wave & 1;
  float* Hs = (float*)smem;
  for (int item = blockIdx.x; item < 1536; item += gridDim.x) {
    const int kind = item >= 768; const int it = item - kind * 768; const int gc = it >> 2, h = it & 3; const int tok0 = gc * 64;
    const int slotf = it * 2, slotb = it * 2 + 1;
    if (kind == 0) {
      bf16_t* Qs = (bf16_t*)smem;
      bf16_t* Ks = Qs + 64 * 136;
      bf16_t* Vt = Ks + 64 * 136;
      bf16_t* Pf = Vt + 128 * 72;
      bf16_t* Pb = Pf + 64 * 72;
      float* fa = (float*)(Pb + 64 * 72);
      float* rF = fa, *cF = fa + 64, *wF = fa + 128, *mtF = fa + 192, *rB = fa + 256, *cB = fa + 320, *wB = fa + 384, *mtB = fa + 448;
      float* facPf = fa + 512, *facPb = fa + 576, *facIf = fa + 640, *facIb = fa + 704;
      float* nF = fa + 768, *nB = fa + 896, *qnF = fa + 1024, *qnB = fa + 1088;
      load_tile_64x128(Qs, PN + (size_t)tok0 * PNW + h * 128, PNW);
      load_tile_64x128(Ks, PN + (size_t)tok0 * PNW + 512 + h * 128, PNW);
      load_tile_128x64(Vt, PT + (size_t)(512 + h * 128) * M + tok0, M);
      if (wave == 0) {
        const float* gp = GATES + (size_t)(tok0 + lane) * 16;
        float igf = gp[h], igb = gp[4 + h], lff = logsig(gp[8 + h]), lfb = logsig(gp[12 + h]);
        float bfw = lff;
#pragma unroll
        for (int o = 1; o < 64; o <<= 1) { float t = __shfl_up(bfw, o); if (lane >= o) bfw += t; }
        float cf = igf - bfw; float pm = cf;
#pragma unroll
        for (int o = 1; o < 64; o <<= 1) { float t = __shfl_up(pm, o); if (lane >= o) pm = fmaxf(pm, t); }
        float mF = MINIT[slotf];
        float interF = bfw + mF; float mt = fmaxf(interF, bfw + pm);
        rF[lane] = bfw - mt; cF[lane] = cf; wF[lane] = expf(interF - mt); mtF[lane] = mt;
        float bbw = lfb;
#pragma unroll
        for (int o = 1; o < 64; o <<= 1) { float t = __shfl_down(bbw, o); if (lane + o < 64) bbw += t; }
        float cb = igb - bbw; float sm = cb;
#pragma unroll
        for (int o = 1; o < 64; o <<= 1) { float t = __shfl_down(sm, o); if (lane + o < 64) sm = fmaxf(sm, t); }
        float mB = MINIT[slotb];
        float interB = bbw + mB; float mt2 = fmaxf(interB, bbw + sm);
        rB[lane] = bbw - mt2; cB[lane] = cb; wB[lane] = expf(interB - mt2); mtB[lane] = mt2;
      }
      if (wave >= 2) { int i = tid - 128; nF[i] = NINIT[slotf * 128 + i]; nB[i] = NINIT[slotb * 128 + i]; }
      __syncthreads();
      {
        f32x16 s = zero16();
#pragma unroll
        for (int ks = 0; ks < 8; ++ks) { bf16x8 a = ld8(Qs + (wm * 32 + lr) * 136 + ks * 16 + lh * 8); bf16x8 b = ld8(Ks + (wn * 32 + lr) * 136 + ks * 16 + lh * 8); s = MFMA(a, b, s); }
        const int sidx = wn * 32 + lr; const float cfs = cF[sidx], cbs = cB[sidx];
#pragma unroll
        for (int i = 0; i < 16; ++i) {
          const int t = wm * 32 + crow(i, lh);
          float pf = (sidx <= t) ? s[i] * __expf(rF[t] + cfs) : 0.f;
          float pb = (sidx >= t) ? s[i] * __expf(rB[t] + cbs) : 0.f;
          Pf[t * 72 + sidx] = f2bf(pf); Pb[t * 72 + sidx] = f2bf(pb);
        }
        const int t = tid >> 2, part = tid & 3; float sf = 0.f, sb = 0.f;
#pragma unroll 8
        for (int d = part * 32; d < part * 32 + 32; ++d) { float q = bf2f(Qs[t * 136 + d]); sf += q * nF[d]; sb += q * nB[d]; }
        sf += __shfl_xor(sf, 1); sf += __shfl_xor(sf, 2); sb += __shfl_xor(sb, 1); sb += __shfl_xor(sb, 2);
        if (part == 0) { qnF[t] = sf; qnB[t] = sb; }
      }
      __syncthreads();
      {
        const int t = tid >> 2, part = tid & 3; float sf = 0.f, sb = 0.f;
#pragma unroll
        for (int j = 0; j < 16; ++j) { sf += bf2f(Pf[t * 72 + part * 16 + j]); sb += bf2f(Pb[t * 72 + part * 16 + j]); }
        sf += __shfl_xor(sf, 1); sf += __shfl_xor(sf, 2); sb += __shfl_xor(sb, 1); sb += __shfl_xor(sb, 2);
        if (part == 0) {
          float denf = wF[t] * qnF[t] + sf; float Nf = fmaxf(fabsf(denf), expf(-mtF[t])); facPf[t] = 1.f / Nf; facIf[t] = wF[t] / Nf;
          float denb = wB[t] * qnB[t] + sb; float Nb = fmaxf(fabsf(denb), expf(-mtB[t])); facPb[t] = 1.f / Nb; facIb[t] = wB[t] / Nb;
        }
      }
      __syncthreads();
      f32x16 hacc[2]; hacc[0] = zero16(); hacc[1] = zero16();
#pragma unroll
      for (int pd = 0; pd < 2; ++pd) {
        __builtin_amdgcn_sched_barrier(0);
        const bf16_t* Pm = pd ? Pb : Pf; const float* fac = pd ? facPb : facPf;
        f32x16 t0[2]; t0[0] = zero16(); t0[1] = zero16();
#pragma unroll
        for (int ks = 0; ks < 4; ++ks) {
          bf16x8 bv = ld8(Vt + (wave * 32 + lr) * 72 + ks * 16 + lh * 8);
#pragma unroll
          for (int mi = 0; mi < 2; ++mi) t0[mi] = MFMA(ld8(Pm + (mi * 32 + lr) * 72 + ks * 16 + lh * 8), bv, t0[mi]);
        }
#pragma unroll
        for (int mi = 0; mi < 2; ++mi)
#pragma unroll
          for (int i = 0; i < 16; ++i) hacc[mi][i] += t0[mi][i] * fac[mi * 32 + crow(i, lh)];
      }
#pragma unroll
      for (int pd = 0; pd < 2; ++pd) {
        __builtin_amdgcn_sched_barrier(0);
        const bf16_t* Cm = MLST + (size_t)(pd ? slotb : slotf) * 16384 + (wave * 32 + lr) * 128 + lh * 8;
        const float* fac = pd ? facIb : facIf;
        f32x16 t0[2]; t0[0] = zero16(); t0[1] = zero16();
#pragma unroll
        for (int ks = 0; ks < 8; ++ks) {
          bf16x8 b0 = ld8(Cm + ks * 16);
#pragma unroll
          for (int mi = 0; mi < 2; ++mi) t0[mi] = MFMA(ld8(Qs + (mi * 32 + lr) * 136 + ks * 16 + lh * 8), b0, t0[mi]);
        }
#pragma unroll
        for (int mi = 0; mi < 2; ++mi)
#pragma unroll
          for (int i = 0; i < 16; ++i) hacc[mi][i] += t0[mi][i] * fac[mi * 32 + crow(i, lh)];
      }
      __syncthreads();
#pragma unroll
      for (int mi = 0; mi < 2; ++mi)
#pragma unroll
        for (int i = 0; i < 16; ++i) Hs[(mi * 32 + crow(i, lh)) * 132 + wave * 32 + lr] = hacc[mi][i];
      __syncthreads();
      s3_epilogue(Hs, p.ml_norm_g + h * 128, PN + (size_t)tok0 * PNW + 1024 + h * 128, MIX + (size_t)tok0 * 1024 + h * 128, false);
      __syncthreads();
    } else {
      bf16_t* QF = (bf16_t*)smem;
      bf16_t* QB = QF + 64 * 136;
      bf16_t* KF = QB + 64 * 136;
      bf16_t* KB = KF + 9216;
      bf16_t* P = KF;
      bf16_t* It = KB;
      load_tile_64x128(KF, PN + (size_t)tok0 * PNW + 2048 + h * 128, PNW);
      load_tile_64x128(KB, PN + (size_t)tok0 * PNW + 2560 + h * 128, PNW);
      load_tile_64x128(QF, PN + (size_t)tok0 * PNW + 1536 + h * 128, PNW);
      load_tile_64x128(QB, PN + (size_t)tok0 * PNW + 1536 + h * 128, PNW);
      __syncthreads();
      {
        const int dir = tid >> 7, dk = tid & 127; const int ch = h * 128 + dk;
        const float lb = 1.f / (1.f + expf(p.ev_lb_logits[512 + ch] - p.ev_lb_logits[ch]));
        bf16_t* Qd = dir ? QB : QF; bf16_t* Kd = dir ? KB : KF;
        float P = 1.f;
#pragma unroll 2
        for (int s = 0; s < 64; ++s) {
          int t = dir ? 63 - s : s;
          float x = bf2f(Kd[t * 136 + dk]); float f = lb + (1.f - lb) * __frcp_rn(1.f + __expf(-x));
          P *= f;
          float q = bf2f(Qd[t * 136 + dk]);
          Qd[t * 136 + dk] = f2bf(q * P); Kd[t * 136 + dk] = f2bf((1.f - f) * __frcp_rn(fmaxf(P, 1.8e-35f)));
        }
      }
      __syncthreads();
      f32x16 pacc;
      {
        f32x16 sf = zero16(), sb = zero16();
#pragma unroll
        for (int ks = 0; ks < 8; ++ks) {
          sf = MFMA(ld8(QF + (wm * 32 + lr) * 136 + ks * 16 + lh * 8), ld8(KF + (wn * 32 + lr) * 136 + ks * 16 + lh * 8), sf);
          sb = MFMA(ld8(QB + (wm * 32 + lr) * 136 + ks * 16 + lh * 8), ld8(KB + (wn * 32 + lr) * 136 + ks * 16 + lh * 8), sb);
        }
        const int sidx = wn * 32 + lr;
#pragma unroll
        for (int i = 0; i < 16; ++i) { const int t = wm * 32 + crow(i, lh); pacc[i] = ((sidx <= t) ? sf[i] : 0.f) + ((sidx >= t) ? sb[i] : 0.f); }
      }
      f32x16 o[2]; o[0] = zero16(); o[1] = zero16();
      {
        const bf16_t* Sf = HGST + (size_t)slotf * 16384 + (wave * 32 + lr) * 128 + lh * 8;
        const bf16_t* Sb = HGST + (size_t)slotb * 16384 + (wave * 32 + lr) * 128 + lh * 8;
#pragma unroll
        for (int ks = 0; ks < 8; ++ks) {
          bf16x8 b0 = ld8(Sf + ks * 16), b1 = ld8(Sb + ks * 16);
#pragma unroll
          for (int mi = 0; mi < 2; ++mi) {
            o[mi] = MFMA(ld8(QF + (mi * 32 + lr) * 136 + ks * 16 + lh * 8), b0, o[mi]);
            o[mi] = MFMA(ld8(QB + (mi * 32 + lr) * 136 + ks * 16 + lh * 8), b1, o[mi]);
          }
        }
      }
      __syncthreads();
      {
        const int sidx = wn * 32 + lr;
#pragma unroll
        for (int i = 0; i < 16; ++i) P[(wm * 32 + crow(i, lh)) * 72 + sidx] = f2bf(pacc[i]);
      }
      load_tile_128x64(It, PT + (size_t)(1024 + h * 128) * M + tok0, M);
      __syncthreads();
#pragma unroll
      for (int ks = 0; ks < 4; ++ks) {
        bf16x8 bv = ld8(It + (wave * 32 + lr) * 72 + ks * 16 + lh * 8);
#pragma unroll
        for (int mi = 0; mi < 2; ++mi) o[mi] = MFMA(ld8(P + (mi * 32 + lr) * 72 + ks * 16 + lh * 8), bv, o[mi]);
      }
#pragma unroll
      for (int mi = 0; mi < 2; ++mi)
#pragma unroll
        for (int i = 0; i < 16; ++i) Hs[(mi * 32 + crow(i, lh)) * 132 + wave * 32 + lr] = o[mi][i];
      __syncthreads();
      s3_epilogue(Hs, p.hg_norm_g + h * 128, PN + (size_t)tok0 * PNW + 3072 + h * 128, MIX + (size_t)tok0 * 1024 + 512 + h * 128, true);
      __syncthreads();
    }
  }
}

DI void online_softmax(f32x16& s, float& m, float& l, f32x16 (&O)[4], bf16x8& p0, bf16x8& p1) {
  float mx = s[0];
#pragma unroll
  for (int i = 1; i < 16; ++i) mx = fmaxf(mx, s[i]);
  { auto r = __builtin_amdgcn_permlane32_swap(__float_as_uint(mx), __float_as_uint(mx), false, false); mx = fmaxf(__uint_as_float(r[0]), __uint_as_float(r[1])); }
  const float mn = fmaxf(m, mx);
  if (__ballot(mn > m) != 0ull) {
    const float alpha = __builtin_amdgcn_exp2f(m - mn);
    l *= alpha;
#pragma unroll
    for (int mt = 0; mt < 4; ++mt)
#pragma unroll
      for (int i = 0; i < 16; ++i) O[mt][i] *= alpha;
    m = mn;
  }
  float sum = 0.f;
#pragma unroll
  for (int i = 0; i < 16; ++i) { s[i] = __builtin_amdgcn_exp2f(s[i] - m); sum += s[i]; }
  l += sum;
  uint4 u0 = make_uint4(pack2(s[0], s[1]), pack2(s[2], s[3]), pack2(s[4], s[5]), pack2(s[6], s[7]));
  uint4 u1 = make_uint4(pack2(s[8], s[9]), pack2(s[10], s[11]), pack2(s[12], s[13]), pack2(s[14], s[15]));
  p0 = __builtin_bit_cast(bf16x8, u0); p1 = __builtin_bit_cast(bf16x8, u1);
}

#define ATTN_GLOAD(KT) do { \
    const int kt_ = (KT); const bf16_t* ksrc; size_t kld; const bf16_t* vsrc; size_t vld; \
    if (sample && kt_ < 4) { ksrc = KC + ((size_t)(seq * 8 + h) * 256 + kt_ * 64) * 128; kld = 128; vsrc = VCT + (size_t)(seq * 8 + h) * 128 * 256 + kt_ * 64; vld = 256; } \
    else { const int kt2 = sample ? kt_ - 4 : kt_; const int t0 = tokbase + kt2 * 64; ksrc = Kb + (size_t)t0 * 1024 + h * 128; kld = 1024; vsrc = VT + (size_t)(h * 128) * M + t0; vld = M; } \
    ksrc += (size_t)(tid >> 4) * kld + (tid & 15) * 8; vsrc += (size_t)(tid >> 3) * vld + (tid & 7) * 8; \
    rk0 = *(const uint4*)(ksrc); rk1 = *(const uint4*)(ksrc + 16 * kld); rk2 = *(const uint4*)(ksrc + 32 * kld); rk3 = *(const uint4*)(ksrc + 48 * kld); \
    rv0 = *(const uint4*)(vsrc); rv1 = *(const uint4*)(vsrc + 32 * vld); rv2 = *(const uint4*)(vsrc + 64 * vld); rv3 = *(const uint4*)(vsrc + 96 * vld); } while (0)
#define ATTN_LSTORE(KD, VD) do { \
    bf16_t* kd_ = (KD) + (tid >> 4) * 136 + (tid & 15) * 8; bf16_t* vd_ = (VD) + (tid >> 3) * 72 + (tid & 7) * 8; \
    *(uint4*)(kd_) = rk0; *(uint4*)(kd_ + 16 * 136) = rk1; *(uint4*)(kd_ + 32 * 136) = rk2; *(uint4*)(kd_ + 48 * 136) = rk3; \
    *(uint4*)(vd_) = rv0; *(uint4*)(vd_ + 32 * 72) = rv1; *(uint4*)(vd_ + 64 * 72) = rv2; *(uint4*)(vd_ + 96 * 72) = rv3; } while (0)

DI void attn_phase(const Params& p, unsigned char* smem) {
  bf16_t* Ks = (bf16_t*)smem;
  bf16_t* Vts = Ks + 64 * 136;
  float* Cmb = (float*)smem;
  const bf16_t* Q = (const bf16_t*)(p.ws + OFF_Q);
  const bf16_t* Kb = (const bf16_t*)(p.ws + OFF_KB);
  const bf16_t* VT = (const bf16_t*)(p.ws + OFF_VT);
  const bf16_t* KC = (const bf16_t*)(p.ws + OFF_KC);
  const bf16_t* VCT = (const bf16_t*)(p.ws + OFF_VCT);
  bf16_t* ATT = (bf16_t*)(p.ws + OFF_ATT);
  const float* MISC = (const float*)(p.ws + OFF_MISC);
  const float lam = MISC[0], lam_init = MISC[1];
  const int tid = threadIdx.x, lane = tid & 63, wave = tid >> 6, lr = lane & 31, lh = lane >> 5;
  const int br = wave >> 1, qw = wave & 1;
  for (int vit = blockIdx.x; vit < 1536; vit += gridDim.x) {
    int item = vit;
    {
      const int b = vit & 511, rnd = vit >> 9; const int xcd = b & 7, slot = b >> 3;
      if (rnd == 0) item = ((xcd * 2 + (slot >> 5)) << 5) | (slot & 31);
      else item = 512 + (((xcd * 32 + (slot >> 1)) << 2) | (((slot & 1) << 1) | (rnd - 1)));
    }
    int sample, seq, h, qb;
    if (item < 512) { sample = 1; qb = item & 31; h = (item >> 5) & 7; seq = item >> 8; }
    else { int v = item - 512; sample = 0; qb = v & 3; h = (v >> 2) & 7; seq = v >> 5; }
    const int tokbase = sample ? MP + seq * 2048 : seq * 256;
    const int nkt = sample ? 36 : 4;
    const int qtok = tokbase + qb * 64 + qw * 32 + lr;
    bf16x8 q[4];
    {
      const bf16_t* qp = Q + (size_t)qtok * 1024 + h * 128 + br * 64 + lh * 8;
#pragma unroll
      for (int s = 0; s < 4; ++s) q[s] = ld8(qp + s * 16);
    }
    f32x16 O[4];
#pragma unroll
    for (int mt = 0; mt < 4; ++mt) O[mt] = zero16();
    float m = -1e30f, l = 0.f;
    uint4 rk0, rk1, rk2, rk3, rv0, rv1, rv2, rv3;
    ATTN_GLOAD(0);
    __syncthreads();
    ATTN_LSTORE(Ks, Vts);
    __syncthreads();
    for (int kt = 0; kt < nkt; ++kt) {
      const int cur = kt & 1;
      if (kt + 1 < nkt) ATTN_GLOAD(kt + 1);
      const bf16_t* Kc = Ks + cur * 17920; const bf16_t* Vc = Vts + cur * 17920;
#pragma unroll
      for (int sub = 0; sub < 2; ++sub) {
        __builtin_amdgcn_iglp_opt(3);
        f32x16 s1 = zero16();
#pragma unroll
        for (int s = 0; s < 4; ++s) s1 = MFMA(ld8(Kc + (sub * 32 + lr) * 136 + br * 64 + s * 16 + lh * 8), q[s], s1);
        bf16x8 pa[2];
        online_softmax(s1, m, l, O, pa[0], pa[1]);
#pragma unroll
        for (int k2 = 0; k2 < 2; ++k2)
#pragma unroll
          for (int mt = 0; mt < 4; ++mt) {
            const bf16_t* vp = Vc + (mt * 32 + lr) * 72 + sub * 32 + k2 * 16 + 4 * lh;
            uint2 lo = *(const uint2*)vp, hi = *(const uint2*)(vp + 8);
            bf16x8 vf = __builtin_bit_cast(bf16x8, make_uint4(lo.x, lo.y, hi.x, hi.y));
            O[mt] = MFMA(vf, pa[k2], O[mt]);
          }
      }
      if (kt + 1 < nkt) ATTN_LSTORE(Ks + (cur ^ 1) * 17920, Vts + (cur ^ 1) * 17920);
      __syncthreads();
    }
    l += __shfl_xor(l, 32);
    const float inv = br ? lam / l : 1.f / l;
    __syncthreads();
    if (br == 1) {
#pragma unroll
      for (int mt = 0; mt < 4; ++mt)
#pragma unroll
        for (int i = 0; i < 16; ++i) Cmb[(qw * 64 + mt * 16 + i) * 64 + lane] = O[mt][i] * inv;
    }
    __syncthreads();
    if (br == 0) {
      float ss = 0.f;
#pragma unroll
      for (int mt = 0; mt < 4; ++mt)
#pragma unroll
        for (int i = 0; i < 16; ++i) { float o = O[mt][i] * inv - Cmb[(qw * 64 + mt * 16 + i) * 64 + lane]; O[mt][i] = o; ss += o * o; }
      ss += __shfl_xor(ss, 32);
      const float sc = rsqrtf(ss * (1.f / 128.f) + 1e-6f) * (1.f - lam_init);
      bf16_t* dst = ATT + (size_t)qtok * 1024 + h * 128;
#pragma unroll
      for (int mt = 0; mt < 4; ++mt)
#pragma unroll
        for (int g = 0; g < 4; ++g) {
          const int dv = mt * 32 + 8 * g + 4 * lh;
          float4 g4 = *(const float4*)(p.da_norm_g + dv);
          *(uint2*)(dst + dv) = pack4(O[mt][4 * g] * sc * g4.x, O[mt][4 * g + 1] * sc * g4.y, O[mt][4 * g + 2] * sc * g4.z, O[mt][4 * g + 3] * sc * g4.w);
        }
    }
  }
}

__global__ void __launch_bounds__(256, 2) mega(Params p) {
  __shared__ __attribute__((aligned(16))) unsigned char smem[SMEM_BYTES];
  cg::grid_group grid = cg::this_grid();
  unsigned char* ws = p.ws;
  float* MOD = (float*)(ws + OFF_MOD);
  float* X = p.out + OUT_Y;
  bf16_t* A = (bf16_t*)(ws + OFF_A);
  bf16_t* U = (bf16_t*)(ws + OFF_U);

  __shared__ uint4 xb_words;
  unsigned* bar = (unsigned*)(ws + OFF_BAR);
  if (threadIdx.x == 0) xb_words = make_uint4(0u, 0u, 0u, 0u);
  __syncthreads();
  XcdBarrier xb = xcd_barrier_post(bar, (volatile LAS unsigned*)&xb_words);
  if (p.ws == nullptr) grid.sync();
  for (int rep = 0; rep < REP_P0; ++rep) phase0(p, smem);
  xcd_barrier(xb);
  norm_phase(p.x_prompt, p.x_sample, p.norm_mix_g, MOD, 1024, 0, A);
  xcd_barrier(xb);
  {
    EpiEvIn e{(bf16_t*)(ws + OFF_PN), (bf16_t*)(ws + OFF_PT), (float*)(ws + OFF_GATES), p.ev_gate_b};
    for (int rep = 0; rep < REP_G; ++rep) gemm_phase<128, 128, 64, false>(A, 1024, (const bf16_t*)(ws + OFF_W_EVIN), 1024, M, 4736, 1024, e, smem);
  }
  xcd_barrier(xb);
  for (int rep = 0; rep < REP_MIX; ++rep) s1_phase(p, smem);
  xcd_barrier(xb);
  s2_phase(p, smem);
  xcd_barrier(xb);
  for (int rep = 0; rep < REP_MIX; ++rep) s3_phase(p, smem);
  xcd_barrier(xb);
  {
    EpiResid e{p.x_prompt, p.x_sample, X, MOD + 2048};
    gemm_phase<128, 64, 64, false>((const bf16_t*)(p.out + OUT_AK), 1024, (const bf16_t*)(ws + OFF_W_EVOUT), 1024, M, 1024, 1024, e, smem);
  }
  xcd_barrier(xb);
  norm_phase(X, X + (size_t)MP * D, p.norm_ffn_g, MOD, 4096, 3072, A);
  xcd_barrier(xb);
  {
    EpiFFUp e{U};
    for (int rep = 0; rep < REP_G; ++rep) gemm_phase<128, 128, 64, false>(A, 1024, (const bf16_t*)(ws + OFF_W_FFU0), 1024, M, 5632, 1024, e, smem);
  }
  xcd_barrier(xb);
  {
    EpiResid e{X, X + (size_t)MP * D, X, MOD + 5120};
    gemm_phase<128, 128, 64, true>(U, DFF, (const bf16_t*)(ws + OFF_W_FFD0), DFF, M, 1024, DFF, e, smem);
  }
  xcd_barrier(xb);
  norm_phase(X, X + (size_t)MP * D, p.norm_mix_g + 1024, MOD + 3 * 6144, 1024, 0, A);
  xcd_barrier(xb);
  {
    EpiOdIn e{(bf16_t*)(ws + OFF_Q), (bf16_t*)(ws + OFF_KB), (bf16_t*)(ws + OFF_VT), p.out + OUT_AK, p.out + OUT_AV, (const float*)(ws + OFF_ROPE)};
    for (int rep = 0; rep < REP_G; ++rep) gemm_phase<128, 128, 64, false>(A, 1024, (const bf16_t*)(ws + OFF_W_ODIN), 1024, M, 3072, 1024, e, smem);
  }
  xcd_barrier(xb);
  for (int rep = 0; rep < REP_ATT; ++rep) attn_phase(p, smem);
  xcd_barrier(xb);
  {
    EpiResid e{X, X + (size_t)MP * D, X, MOD + 3 * 6144 + 2048};
    gemm_phase<128, 128, 64, true>((const bf16_t*)(ws + OFF_ATT), 1024, (const bf16_t*)(ws + OFF_W_ODOUT), 1024, M, 1024, 1024, e, smem);
  }
  xcd_barrier(xb);
  norm_phase(X, X + (size_t)MP * D, p.norm_ffn_g + 1024, MOD + 3 * 6144, 4096, 3072, A);
  xcd_barrier(xb);
  {
    EpiFFUp e{U};
    for (int rep = 0; rep < REP_G; ++rep) gemm_phase<128, 128, 64, false>(A, 1024, (const bf16_t*)(ws + OFF_W_FFU1), 1024, M, 5632, 1024, e, smem);
  }
  xcd_barrier(xb);
  {
    EpiResid e{X, X + (size_t)MP * D, X, MOD + 3 * 6144 + 5120};
    gemm_phase<128, 128, 64, true>(U, DFF, (const bf16_t*)(ws + OFF_W_FFD1), DFF, M, 1024, DFF, e, smem);
  }
  xcd_barrier(xb);
  final_norm_phase(X, p.final_norm_g);
}

extern "C" void kernel_launch(void* const* d_in, const int* in_sizes, int n_in, void* d_out, int out_size, void* d_ws, size_t ws_size, hipStream_t stream) {
  static int grid_blocks = 0;
  if (!grid_blocks) {
    int dev = 0, cus = 0, per_cu = 0;
    (void)hipGetDevice(&dev);
    (void)hipDeviceGetAttribute(&cus, hipDeviceAttributeMultiprocessorCount, dev);
    (void)hipOccupancyMaxActiveBlocksPerMultiprocessor(&per_cu, mega, 256, 0);
    per_cu = 2;
    grid_blocks = cus * per_cu;
    if (ws_size < WS_END) { fprintf(stderr, "kernel_launch: workspace too small: %zu < %zu\n", ws_size, (size_t)WS_END); grid_blocks = -1; }
  }
  if (grid_blocks < 0) return;
  (void)hipMemsetAsync((unsigned char*)d_ws + OFF_BAR, 0, 16384, stream);
  Params p{};
  const float** pp = (const float**)&p;
  for (int i = 0; i < 28; ++i) pp[i] = (const float*)d_in[i];
  p.out = (float*)d_out; p.ws = (unsigned char*)d_ws;
  void* args[] = {&p};
  hipError_t e = hipLaunchCooperativeKernel((void*)mega, dim3(grid_blocks), dim3(256), args, 0, stream);
  if (e != hipSuccess) fprintf(stderr, "cooperative launch failed: %s (grid %d)\n", hipGetErrorString(e), grid_blocks);
}
```

```cpp
#include <hip/hip_runtime.h>
#include <hip/hip_cooperative_groups.h>
#include <cstdio>
namespace cg = cooperative_groups;

typedef unsigned short bf16_t;
using bf16x8 = __attribute__((ext_vector_type(8))) short;
using f32x16 = __attribute__((ext_vector_type(16))) float;
#define DI __device__ __forceinline__
#define MFMA(a, b, c) __builtin_amdgcn_mfma_f32_32x32x16_bf16((a), (b), (c), 0, 0, 0)

constexpr int D = 1024;
constexpr int M = 12288;
constexpr int MP = 8192;
constexpr int DFF = 2816;
constexpr int PNW = 3584;
constexpr int SMEM_BYTES = 77824;
#ifndef REP_G
#define REP_G 1
#endif
#ifndef REP_P0
#define REP_P0 1
#endif
#ifndef REP_MIX
#define REP_MIX 1
#endif
#ifndef REP_ATT
#define REP_ATT 1
#endif

constexpr size_t OFF_W_EVIN = 0;
constexpr size_t OFF_W_EVOUT = OFF_W_EVIN + (size_t)4736 * 1024 * 2;
constexpr size_t OFF_W_FFU0 = OFF_W_EVOUT + (size_t)1024 * 1024 * 2;
constexpr size_t OFF_W_FFU1 = OFF_W_FFU0 + (size_t)5632 * 1024 * 2;
constexpr size_t OFF_W_FFD0 = OFF_W_FFU1 + (size_t)5632 * 1024 * 2;
constexpr size_t OFF_W_FFD1 = OFF_W_FFD0 + (size_t)1024 * 2816 * 2;
constexpr size_t OFF_W_ODIN = OFF_W_FFD1 + (size_t)1024 * 2816 * 2;
constexpr size_t OFF_W_ODOUT = OFF_W_ODIN + (size_t)3072 * 1024 * 2;
constexpr size_t OFF_MOD = OFF_W_ODOUT + (size_t)1024 * 1024 * 2;
constexpr size_t OFF_ROPE = OFF_MOD + (size_t)2 * 3 * 6144 * 4;
constexpr size_t OFF_MISC = OFF_ROPE + 8192;
constexpr size_t OFF_BAR = OFF_MISC + 256;
constexpr size_t OFF_GATES = OFF_BAR + 16384;
constexpr size_t OFF_KC = OFF_GATES + (size_t)M * 16 * 4;
constexpr size_t OFF_VCT = OFF_KC + (size_t)2 * 8 * 256 * 128 * 2;
constexpr size_t OFF_NLOC = OFF_VCT + (size_t)2 * 8 * 256 * 128 * 2;
constexpr size_t OFF_NINIT = OFF_NLOC + (size_t)1536 * 128 * 4;
constexpr size_t OFF_SCAL = OFF_NINIT + (size_t)1536 * 128 * 4;
constexpr size_t OFF_MINIT = OFF_SCAL + (size_t)1536 * 4 * 4;
constexpr size_t OFF_AL = OFF_MINIT + (size_t)1536 * 4;
constexpr size_t OFF_PN = OFF_AL + (size_t)1536 * 128 * 4;
constexpr size_t OFF_PT = OFF_PN + (size_t)M * PNW * 2;
constexpr size_t OFF_ST = OFF_PT + (size_t)1536 * M * 2;
constexpr size_t WS_END = OFF_ST + (size_t)1536 * 16384 * 2;
constexpr size_t OFF_A = OFF_ST;
constexpr size_t OFF_ATT = OFF_ST + (size_t)M * 1024 * 2;
constexpr size_t OFF_U = OFF_PN;
constexpr size_t OFF_Q = OFF_PN;
constexpr size_t OFF_KB = OFF_PN + (size_t)M * 1024 * 2;
constexpr size_t OFF_VT = OFF_PN + (size_t)2 * M * 1024 * 2;
constexpr size_t OUT_Y = 0;
constexpr size_t OUT_AK = (size_t)M * 1024;
constexpr size_t OUT_AV = OUT_AK + (size_t)MP * 1024;
constexpr size_t OUT_C = OUT_AV + (size_t)MP * 1024;
constexpr size_t OUT_N = OUT_C + (size_t)32 * 2 * 4 * 16384;
constexpr size_t OUT_M = OUT_N + (size_t)32 * 2 * 4 * 128;
constexpr size_t OUT_S = OUT_M + 256;

struct Params {
  const float *x_prompt, *x_sample, *c, *c_ctx, *cache_k, *cache_v, *st_C, *st_n, *st_m, *st_S;
  const float *ada_w, *ada_b, *norm_mix_g, *norm_ffn_g, *ev_w_in, *ev_gate_b, *ev_lb_logits, *ml_norm_g, *hg_norm_g;
  const float *ev_w_out, *od_w_in, *od_lambda, *da_norm_g, *od_w_out, *ffn_w1, *ffn_w3, *ffn_w2, *final_norm_g;
  float* out;
  unsigned char* ws;
};

typedef __bf16 bf16v2 __attribute__((ext_vector_type(2)));
typedef float f32v2 __attribute__((ext_vector_type(2)));
DI unsigned short f2bf(float x) { return __builtin_bit_cast(unsigned short, (__bf16)x); }
DI float bf2f(unsigned short h) { return __uint_as_float(((unsigned)h) << 16); }
DI unsigned pack2(float a, float b) { f32v2 v = {a, b}; return __builtin_bit_cast(unsigned, __builtin_convertvector(v, bf16v2)); }
DI uint2 pack4(float a, float b, float c, float d) { return make_uint2(pack2(a, b), pack2(c, d)); }
DI float lo_bf(unsigned u) { return __uint_as_float(u << 16); }
DI float hi_bf(unsigned u) { return __uint_as_float(u & 0xffff0000u); }
DI int crow(int reg, int h) { return (reg & 3) + 8 * (reg >> 2) + 4 * h; }
DI float wsum(float v) {
#pragma unroll
  for (int o = 32; o > 0; o >>= 1) v += __shfl_xor(v, o);
  return v;
}
DI float wmax(float v) {
#pragma unroll
  for (int o = 32; o > 0; o >>= 1) v = fmaxf(v, __shfl_xor(v, o));
  return v;
}
DI float logsig(float x) { return fminf(x, 0.f) - log1pf(expf(-fabsf(x))); }
DI float sigmoidf(float x) { return 1.f / (1.f + expf(-x)); }
DI f32x16 zero16() { f32x16 z;
#pragma unroll
  for (int i = 0; i < 16; ++i) z[i] = 0.f;
  return z; }
DI bf16x8 ld8(const bf16_t* p) { return *(const bf16x8*)p; }


#define XB_TMO      128
#define XB_XCNT(j)  (256  + 64 * (j))
#define XB_XSUB(j)  (1280 + 64 * (j))
#define XB_XGEN(j)  (2304 + 64 * (j))
#define XB_TOP      3328
#define XB_TOPGEN   3392
#define XCD_BAR_WORDS 3456
#define XB_SPIN_CAP (1u << 22)
#define LAS __attribute__((address_space(3)))
DI unsigned xb_ld(unsigned* p)              { return __hip_atomic_load(p, __ATOMIC_RELAXED, __HIP_MEMORY_SCOPE_AGENT); }
DI unsigned xb_add(unsigned* p, unsigned v) { return __hip_atomic_fetch_add(p, v, __ATOMIC_RELAXED, __HIP_MEMORY_SCOPE_AGENT); }
DI unsigned xb_xcc_id() { return (unsigned)__builtin_amdgcn_s_getreg((3 << 11) | 20) & 0xFu; }
#define XB_SPIN(cond, bar) do { unsigned _sp = 0; while (cond) { __builtin_amdgcn_s_sleep(1); \
    if ((++_sp & 255u) == 0u) { if (xb_ld(&(bar)[XB_TMO])) break; if (_sp > XB_SPIN_CAP) { atomicAdd(&(bar)[XB_TMO], 1u); break; } } } } while (0)
struct XcdBarrier { unsigned* bar; unsigned x; volatile LAS unsigned* st; };
DI XcdBarrier xcd_barrier_post(unsigned* bar, volatile LAS unsigned* st) {
  XcdBarrier b; b.bar = bar; b.x = xb_xcc_id(); b.st = st;
  if (threadIdx.x == 0) (void)xb_add(&bar[XB_XCNT(b.x)], 1u);
  return b;
}
DI void xcd_barrier_complete(unsigned* bar, unsigned x, unsigned& nloc, unsigned& nx) {
  const unsigned G = gridDim.x * gridDim.y * gridDim.z;
  unsigned sum, cnt, mine, sp = 0u;
  for (;;) {
    sum = 0u; cnt = 0u; mine = 0u;
#pragma unroll
    for (unsigned j = 0; j < 16; ++j) { const unsigned c = xb_ld(&bar[XB_XCNT(j)]); sum += c; cnt += (c > 0u) ? 1u : 0u; mine = (j == x) ? c : mine; }
    if (sum == G) break;
    __builtin_amdgcn_s_sleep(1);
    if ((++sp & 255u) == 0u) { if (xb_ld(&bar[XB_TMO])) break; if (sp > XB_SPIN_CAP) { atomicAdd(&bar[XB_TMO], 1u); break; } }
  }
  nloc = mine > 0u ? mine : 1u; nx = cnt > 0u ? cnt : 1u;
}
DI void xcd_barrier(const XcdBarrier& b) {
  asm volatile("s_waitcnt vmcnt(0)" ::: "memory");
  __syncthreads();
  if (threadIdx.x == 0) {
    unsigned* bar = b.bar;
    __builtin_amdgcn_s_waitcnt(0);
    unsigned nloc = b.st[0], nx = b.st[1];
    if (nloc == 0u) { xcd_barrier_complete(bar, b.x, nloc, nx); b.st[0] = nloc; b.st[1] = nx; }
    const unsigned old = xb_add(&bar[XB_XSUB(b.x)], 1u);
    const unsigned gen = old / nloc;
    if (old + 1u == (gen + 1u) * nloc) {
      __builtin_amdgcn_fence(__ATOMIC_RELEASE, "agent");
      asm volatile("s_waitcnt vmcnt(0)" ::: "memory");
      const unsigned og = xb_add(&bar[XB_TOP], 1u);
      const unsigned tg = og / nx;
      if (og + 1u == (tg + 1u) * nx) xb_add(&bar[XB_TOPGEN], 1u);
      else XB_SPIN(xb_ld(&bar[XB_TOPGEN]) == tg, bar);
      __builtin_amdgcn_fence(__ATOMIC_ACQUIRE, "agent");
      xb_add(&bar[XB_XGEN(b.x)], 1u);
      asm volatile("s_waitcnt vmcnt(0)" ::: "memory");
    } else {
      XB_SPIN(xb_ld(&bar[XB_XGEN(b.x)]) == gen, bar);
      __builtin_amdgcn_fence(__ATOMIC_ACQUIRE, "agent");
      asm volatile("s_waitcnt vmcnt(0)" ::: "memory");
    }
  }
  __syncthreads();
}

DI void load_tile_64x128(bf16_t* dst, const bf16_t* src, size_t ld) {
  const int tid = threadIdx.x;
#pragma unroll
  for (int i = 0; i < 4; ++i) { int c = tid + 256 * i; int row = c >> 4, ch = c & 15; *(uint4*)(dst + row * 136 + ch * 8) = *(const uint4*)(src + (size_t)row * ld + ch * 8); }
}
DI void load_tile_128x64(bf16_t* dst, const bf16_t* src, size_t ld) {
  const int tid = threadIdx.x;
#pragma unroll
  for (int i = 0; i < 4; ++i) { int c = tid + 256 * i; int row = c >> 3, ch = c & 7; *(uint4*)(dst + row * 72 + ch * 8) = *(const uint4*)(src + (size_t)row * ld + ch * 8); }
}

struct TDesc { const float* src0; const float* src1; bf16_t* dst; int srcN, K, kind, tn, tk; };
DI TDesc tdecode(const Params& p, int t) {
  TDesc d; d.src1 = nullptr;
  if (t < 1184) { d.src0 = p.ev_w_in; d.srcN = 4624; d.K = 1024; d.dst = (bf16_t*)(p.ws + OFF_W_EVIN); d.kind = 1; d.tn = t / 16; d.tk = t % 16; }
  else if (t < 1440) { t -= 1184; d.src0 = p.ev_w_out; d.srcN = 1024; d.K = 1024; d.dst = (bf16_t*)(p.ws + OFF_W_EVOUT); d.kind = 0; d.tn = t / 16; d.tk = t % 16; }
  else if (t < 4256) { t -= 1440; int l = t / 1408; t -= l * 1408; d.src0 = p.ffn_w1 + (size_t)l * 1024 * DFF; d.src1 = p.ffn_w3 + (size_t)l * 1024 * DFF; d.srcN = DFF; d.K = 1024;
    d.dst = (bf16_t*)(p.ws + (l ? OFF_W_FFU1 : OFF_W_FFU0)); d.kind = 2; d.tn = t / 16; d.tk = t % 16; }
  else if (t < 5664) { t -= 4256; int l = t / 704; t -= l * 704; d.src0 = p.ffn_w2 + (size_t)l * DFF * 1024; d.srcN = 1024; d.K = DFF;
    d.dst = (bf16_t*)(p.ws + (l ? OFF_W_FFD1 : OFF_W_FFD0)); d.kind = 0; d.tn = t / 44; d.tk = t % 44; }
  else if (t < 6432) { t -= 5664; d.src0 = p.od_w_in; d.srcN = 3072; d.K = 1024; d.dst = (bf16_t*)(p.ws + OFF_W_ODIN); d.kind = 0; d.tn = t / 16; d.tk = t % 16; }
  else { t -= 6432; d.src0 = p.od_w_out; d.srcN = 1024; d.K = 1024; d.dst = (bf16_t*)(p.ws + OFF_W_ODOUT); d.kind = 0; d.tn = t / 16; d.tk = t % 16; }
  return d;
}
DI void t_load(const TDesc& d, float4& v0, float4& v1, float4& v2, float4& v3) {
  const int tid = threadIdx.x; const int c4 = (tid & 15) * 4, kr = tid >> 4;
  const int n = d.tn * 64 + c4;
  const float* src = d.src0; int sc;
  if (d.kind == 0) sc = n;
  else if (d.kind == 1) sc = n < 2048 ? n : (n < 4608 ? n + 16 : (n < 4624 ? n - 4608 + 2048 : -1));
  else { int jb = n >> 6, r = n & 63; src = (r < 32) ? d.src0 : d.src1; sc = jb * 32 + (r & 31); }
  v0 = v1 = v2 = v3 = make_float4(0.f, 0.f, 0.f, 0.f);
  if (sc >= 0) {
    const float* b = src + (size_t)(d.tk * 64 + kr) * d.srcN + sc;
    v0 = *(const float4*)(b); v1 = *(const float4*)(b + (size_t)16 * d.srcN); v2 = *(const float4*)(b + (size_t)32 * d.srcN); v3 = *(const float4*)(b + (size_t)48 * d.srcN);
  }
}
DI void t_ldsw(float* lds, const float4& v0, const float4& v1, const float4& v2, const float4& v3) {
  const int tid = threadIdx.x; const int c4 = (tid & 15) * 4, kr = tid >> 4;
  float* d = lds + kr * 65 + c4;
  d[0] = v0.x; d[1] = v0.y; d[2] = v0.z; d[3] = v0.w;
  d[16 * 65] = v1.x; d[16 * 65 + 1] = v1.y; d[16 * 65 + 2] = v1.z; d[16 * 65 + 3] = v1.w;
  d[32 * 65] = v2.x; d[32 * 65 + 1] = v2.y; d[32 * 65 + 2] = v2.z; d[32 * 65 + 3] = v2.w;
  d[48 * 65] = v3.x; d[48 * 65 + 1] = v3.y; d[48 * 65 + 2] = v3.z; d[48 * 65 + 3] = v3.w;
}
DI void t_store(const TDesc& d, const float* lds) {
  const int tid = threadIdx.x; const int nn = tid >> 2, kq = (tid & 3) * 16;
  unsigned w[8];
#pragma unroll
  for (int j = 0; j < 8; ++j) w[j] = pack2(lds[(kq + 2 * j) * 65 + nn], lds[(kq + 2 * j + 1) * 65 + nn]);
  bf16_t* o = d.dst + (size_t)(d.tn * 64 + nn) * d.K + d.tk * 64 + kq;
  *(uint4*)o = make_uint4(w[0], w[1], w[2], w[3]);
  *(uint4*)(o + 8) = make_uint4(w[4], w[5], w[6], w[7]);
}

DI void mod_unit(const Params& p, int u, float* lds) {
  float* sil = lds; float* red = lds + 3072;
  float* MOD = (float*)(p.ws + OFF_MOD);
  const int tid = threadIdx.x;
  for (int i = tid; i < 3072; i += 256) { int j = i >> 10, k = i & 1023; float v = (j == 0) ? p.c_ctx[k] : p.c[(j - 1) * 1024 + k]; sil[i] = v / (1.f + expf(-v)); }
  __syncthreads();
  const int l = u / 48, cb = u % 48; const int cgp = tid & 31, kg = tid >> 5;
  const float* w = p.ada_w + (size_t)l * 1024 * 6144 + cb * 128 + cgp * 4;
  float a0x = 0, a0y = 0, a0z = 0, a0w = 0, a1x = 0, a1y = 0, a1z = 0, a1w = 0, a2x = 0, a2y = 0, a2z = 0, a2w = 0;
#pragma unroll 4
  for (int k = kg * 128; k < kg * 128 + 128; ++k) {
    float4 wv = *(const float4*)(w + (size_t)k * 6144);
    float s0 = sil[k], s1 = sil[1024 + k], s2 = sil[2048 + k];
    a0x += s0 * wv.x; a0y += s0 * wv.y; a0z += s0 * wv.z; a0w += s0 * wv.w;
    a1x += s1 * wv.x; a1y += s1 * wv.y; a1z += s1 * wv.z; a1w += s1 * wv.w;
    a2x += s2 * wv.x; a2y += s2 * wv.y; a2z += s2 * wv.z; a2w += s2 * wv.w;
  }
  float* r0 = red + (kg * 3 + 0) * 128 + cgp * 4; r0[0] = a0x; r0[1] = a0y; r0[2] = a0z; r0[3] = a0w;
  float* r1 = red + (kg * 3 + 1) * 128 + cgp * 4; r1[0] = a1x; r1[1] = a1y; r1[2] = a1z; r1[3] = a1w;
  float* r2 = red + (kg * 3 + 2) * 128 + cgp * 4; r2[0] = a2x; r2[1] = a2y; r2[2] = a2z; r2[3] = a2w;
  __syncthreads();
  for (int i = tid; i < 384; i += 256) {
    int j = i >> 7, cc = i & 127; float s = 0;
#pragma unroll
    for (int g = 0; g < 8; ++g) s += red[(g * 3 + j) * 128 + cc];
    s += p.ada_b[l * 6144 + cb * 128 + cc];
    MOD[(l * 3 + j) * 6144 + cb * 128 + cc] = s;
  }
  __syncthreads();
}

DI void phase0(const Params& p, unsigned char* smem) {
  float* lds = (float*)smem;
  const int tid = threadIdx.x;
  {
    int item = blockIdx.x;
    if (item < 96) { mod_unit(p, item, lds); item += gridDim.x; }
    float4 v0, v1, v2, v3;
    TDesc cur = tdecode(p, 0);
    bool have = item < 6784;
    if (have) { cur = tdecode(p, item - 96); t_load(cur, v0, v1, v2, v3); }
    while (have) {
      t_ldsw(lds, v0, v1, v2, v3);
      const int nitem = item + gridDim.x; const bool hn = nitem < 6784;
      TDesc nxt = cur;
      if (hn) { nxt = tdecode(p, nitem - 96); t_load(nxt, v0, v1, v2, v3); }
      __syncthreads();
      t_store(cur, lds);
      __syncthreads();
      cur = nxt; item = nitem; have = hn;
    }
  }
  for (int item = blockIdx.x; item < 7041; item += gridDim.x) {
    if (item < 6784) continue;
    int t = item - 96;
    t -= 6688;
    if (t < 256) {
      bf16_t* KC = (bf16_t*)(p.ws + OFF_KC); bf16_t* VCT = (bf16_t*)(p.ws + OFF_VCT);
#pragma unroll 4
      for (int j = 0; j < 16; ++j) {
        int idx = t * 4096 + j * 256 + tid;
        if (idx < 524288) { int d = idx & 127, key = (idx >> 7) & 255, h = (idx >> 15) & 7, b = idx >> 18;
          KC[idx] = f2bf(p.cache_k[((size_t)(b * 256 + key) * 8 + h) * 128 + d]); }
        else { int i2 = idx - 524288; int key = i2 & 255, dv = (i2 >> 8) & 127, h = (i2 >> 15) & 7, b = i2 >> 18;
          VCT[i2] = f2bf(p.cache_v[((size_t)(b * 256 + key) * 8 + h) * 128 + dv]); }
      }
      continue;
    }
    float* ROPE = (float*)(p.ws + OFF_ROPE); float* MISC = (float*)(p.ws + OFF_MISC);
    for (int idx = tid; idx < 1024; idx += 256) {
      int pos = idx >> 4, i = idx & 15;
      float inv = powf(10000.f, -(float)i / 16.f);
      float ang = (float)pos * inv;
      ROPE[idx * 2] = cosf(ang); ROPE[idx * 2 + 1] = sinf(ang);
    }
    if (tid == 0) {
      float s01 = 0, s23 = 0;
      for (int i = 0; i < 64; ++i) { s01 += p.od_lambda[i] * p.od_lambda[64 + i]; s23 += p.od_lambda[128 + i] * p.od_lambda[192 + i]; }
      const float lam_init = 0.8f - 0.6f * expf(-0.3f);
      MISC[0] = expf(s01) - expf(s23) + lam_init;
      MISC[1] = lam_init;
    }
  }
}

DI void norm_phase(const float* src_p, const float* src_s, const float* gain, const float* mod, int sc_off, int sh_off, bf16_t* A) {
  const int wave = threadIdx.x >> 6, lane = threadIdx.x & 63;
  for (int row = blockIdx.x * 4 + wave; row < M; row += gridDim.x * 4) {
    const float* src = row < MP ? src_p + (size_t)row * D : src_s + (size_t)(row - MP) * D;
    const int j = row < MP ? 0 : 1 + ((row - MP) >> 11);
    float4 v[4]; float ss = 0;
#pragma unroll
    for (int i = 0; i < 4; ++i) { v[i] = *(const float4*)(src + i * 256 + lane * 4); ss += v[i].x * v[i].x + v[i].y * v[i].y + v[i].z * v[i].z + v[i].w * v[i].w; }
    ss = wsum(ss);
    const float rstd = rsqrtf(ss * (1.f / 1024.f) + 1e-6f);
    const float* msc = mod + j * 6144 + sc_off; const float* msh = mod + j * 6144 + sh_off;
#pragma unroll
    for (int i = 0; i < 4; ++i) {
      int c = i * 256 + lane * 4;
      float4 g4 = *(const float4*)(gain + c), sc4 = *(const float4*)(msc + c), sh4 = *(const float4*)(msh + c);
      float o0 = v[i].x * rstd * g4.x * (1.f + sc4.x) + sh4.x;
      float o1 = v[i].y * rstd * g4.y * (1.f + sc4.y) + sh4.y;
      float o2 = v[i].z * rstd * g4.z * (1.f + sc4.z) + sh4.z;
      float o3 = v[i].w * rstd * g4.w * (1.f + sc4.w) + sh4.w;
      *(uint2*)(A + (size_t)row * D + c) = pack4(o0, o1, o2, o3);
    }
  }
}

DI void final_norm_phase(float* X, const float* gain) {
  const int wave = threadIdx.x >> 6, lane = threadIdx.x & 63;
  for (int row = blockIdx.x * 4 + wave; row < M; row += gridDim.x * 4) {
    float* src = X + (size_t)row * D;
    float4 v[4]; float ss = 0;
#pragma unroll
    for (int i = 0; i < 4; ++i) { v[i] = *(const float4*)(src + i * 256 + lane * 4); ss += v[i].x * v[i].x + v[i].y * v[i].y + v[i].z * v[i].z + v[i].w * v[i].w; }
    ss = wsum(ss);
    const float rstd = rsqrtf(ss * (1.f / 1024.f) + 1e-6f);
#pragma unroll
    for (int i = 0; i < 4; ++i) {
      int c = i * 256 + lane * 4;
      float4 g4 = *(const float4*)(gain + c);
      float4 o; o.x = v[i].x * rstd * g4.x; o.y = v[i].y * rstd * g4.y; o.z = v[i].z * rstd * g4.z; o.w = v[i].w * rstd * g4.w;
      *(float4*)(src + c) = o;
    }
  }
}

template <int BM, int BN, int BK, bool SPLIT, class Epi>
DI void gemm_phase(const bf16_t* __restrict__ A, int lda, const bf16_t* __restrict__ Bt, int ldb, int Mrows, int N, int K, const Epi& epi, unsigned char* smem) {
  constexpr int MI = BM / 64, NI = BN / 64;
  constexpr int LDK = BK + 8;
  constexpr int LDS_A = BM * LDK, LDS_B = BN * LDK;
  constexpr int CPR = BK / 8;
  constexpr int RPP = 256 / CPR;
  constexpr int NA = BM / RPP, NB = BN / RPP;
  bf16_t* As = (bf16_t*)smem;
  bf16_t* Bs = As + 2 * LDS_A;
  const int tid = threadIdx.x, lane = tid & 63, wave = tid >> 6, wm = wave >> 1, wn = wave & 1, lr = lane & 31, lh = lane >> 5;
  const int ntm = Mrows / BM, ntn = N / BN, nkfull = K / BK;
  const int lrow = tid / CPR, lch = tid % CPR;
  const int lofs = lrow * LDK + lch * 8;
  const bf16_t* as0 = As + (wm * (BM / 2) + lr) * LDK + lh * 8;
  const bf16_t* bs0 = Bs + (wn * (BN / 2) + lr) * LDK + lh * 8;
  const int ntiles = ntm * ntn;
  const int nfull = SPLIT ? ((int)gridDim.x < ntiles ? (int)gridDim.x : ntiles) : ntiles;
  const int nitems = SPLIT ? nfull + 2 * (ntiles - nfull) : ntiles;
  for (int item = blockIdx.x; item < nitems; item += gridDim.x) {
    int tile = item, kbeg = 0, nk = nkfull; bool part = false;
    if (SPLIT && item >= nfull) { tile = nfull + ((item - nfull) >> 1); nk = nkfull >> 1; kbeg = ((item - nfull) & 1) * nk; part = true; }
    const int tm = tile % ntm, tn = tile / ntm; const int m0 = tm * BM, n0 = tn * BN;
    f32x16 acc[MI][NI];
#pragma unroll
    for (int mi = 0; mi < MI; ++mi)
#pragma unroll
      for (int ni = 0; ni < NI; ++ni) acc[mi][ni] = zero16();
    static_assert(NA <= 4 && NB <= 4, "staging registers");
    uint4 a00, a01, a02, a03, b00, b01, b02, b03, a10, a11, a12, a13, b10, b11, b12, b13;
    a00 = a01 = a02 = a03 = b00 = b01 = b02 = b03 = a10 = a11 = a12 = a13 = b10 = b11 = b12 = b13 = make_uint4(0u, 0u, 0u, 0u);
    const bf16_t* Ag = A + (size_t)(m0 + lrow) * lda + lch * 8 + (size_t)kbeg * BK;
    const bf16_t* Bg = Bt + (size_t)(n0 + lrow) * ldb + lch * 8 + (size_t)kbeg * BK;
    if (NA > 0) a00 = *(const uint4*)(Ag + (size_t)(RPP * 0) * lda + (0) * BK);
    if (NA > 1) a01 = *(const uint4*)(Ag + (size_t)(RPP * 1) * lda + (0) * BK);
    if (NA > 2) a02 = *(const uint4*)(Ag + (size_t)(RPP * 2) * lda + (0) * BK);
    if (NA > 3) a03 = *(const uint4*)(Ag + (size_t)(RPP * 3) * lda + (0) * BK);
    if (NB > 0) b00 = *(const uint4*)(Bg + (size_t)(RPP * 0) * ldb + (0) * BK);
    if (NB > 1) b01 = *(const uint4*)(Bg + (size_t)(RPP * 1) * ldb + (0) * BK);
    if (NB > 2) b02 = *(const uint4*)(Bg + (size_t)(RPP * 2) * ldb + (0) * BK);
    if (NB > 3) b03 = *(const uint4*)(Bg + (size_t)(RPP * 3) * ldb + (0) * BK);
    if (NA > 0) a10 = *(const uint4*)(Ag + (size_t)(RPP * 0) * lda + (1) * BK);
    if (NA > 1) a11 = *(const uint4*)(Ag + (size_t)(RPP * 1) * lda + (1) * BK);
    if (NA > 2) a12 = *(const uint4*)(Ag + (size_t)(RPP * 2) * lda + (1) * BK);
    if (NA > 3) a13 = *(const uint4*)(Ag + (size_t)(RPP * 3) * lda + (1) * BK);
    if (NB > 0) b10 = *(const uint4*)(Bg + (size_t)(RPP * 0) * ldb + (1) * BK);
    if (NB > 1) b11 = *(const uint4*)(Bg + (size_t)(RPP * 1) * ldb + (1) * BK);
    if (NB > 2) b12 = *(const uint4*)(Bg + (size_t)(RPP * 2) * ldb + (1) * BK);
    if (NB > 3) b13 = *(const uint4*)(Bg + (size_t)(RPP * 3) * ldb + (1) * BK);
    if (NA > 0) *(uint4*)(As + (0) * LDS_A + lofs + RPP * 0 * LDK) = a00;
    if (NA > 1) *(uint4*)(As + (0) * LDS_A + lofs + RPP * 1 * LDK) = a01;
    if (NA > 2) *(uint4*)(As + (0) * LDS_A + lofs + RPP * 2 * LDK) = a02;
    if (NA > 3) *(uint4*)(As + (0) * LDS_A + lofs + RPP * 3 * LDK) = a03;
    if (NB > 0) *(uint4*)(Bs + (0) * LDS_B + lofs + RPP * 0 * LDK) = b00;
    if (NB > 1) *(uint4*)(Bs + (0) * LDS_B + lofs + RPP * 1 * LDK) = b01;
    if (NB > 2) *(uint4*)(Bs + (0) * LDS_B + lofs + RPP * 2 * LDK) = b02;
    if (NB > 3) *(uint4*)(Bs + (0) * LDS_B + lofs + RPP * 3 * LDK) = b03;
    __syncthreads();
    for (int kt = 0; kt < nk; kt += 2) {
      if (kt + 2 < nk) {
        if (NA > 0) a00 = *(const uint4*)(Ag + (size_t)(RPP * 0) * lda + (kt + 2) * BK);
        if (NA > 1) a01 = *(const uint4*)(Ag + (size_t)(RPP * 1) * lda + (kt + 2) * BK);
        if (NA > 2) a02 = *(const uint4*)(Ag + (size_t)(RPP * 2) * lda + (kt + 2) * BK);
        if (NA > 3) a03 = *(const uint4*)(Ag + (size_t)(RPP * 3) * lda + (kt + 2) * BK);
        if (NB > 0) b00 = *(const uint4*)(Bg + (size_t)(RPP * 0) * ldb + (kt + 2) * BK);
        if (NB > 1) b01 = *(const uint4*)(Bg + (size_t)(RPP * 1) * ldb + (kt + 2) * BK);
        if (NB > 2) b02 = *(const uint4*)(Bg + (size_t)(RPP * 2) * ldb + (kt + 2) * BK);
        if (NB > 3) b03 = *(const uint4*)(Bg + (size_t)(RPP * 3) * ldb + (kt + 2) * BK);
      }
      __builtin_amdgcn_sched_barrier(0);
      {
        __builtin_amdgcn_iglp_opt(1);
        const bf16_t* as = as0 + (0) * LDS_A; const bf16_t* bs = bs0 + (0) * LDS_B;
      #pragma unroll
        for (int ks = 0; ks < BK / 16; ++ks) {
          bf16x8 af[MI], bfr[NI];
      #pragma unroll
          for (int mi = 0; mi < MI; ++mi) af[mi] = ld8(as + mi * 32 * LDK + ks * 16);
      #pragma unroll
          for (int ni = 0; ni < NI; ++ni) bfr[ni] = ld8(bs + ni * 32 * LDK + ks * 16);
      #pragma unroll
          for (int mi = 0; mi < MI; ++mi)
      #pragma unroll
            for (int ni = 0; ni < NI; ++ni) acc[mi][ni] = MFMA(af[mi], bfr[ni], acc[mi][ni]);
        }
      }
      if (NA > 0) *(uint4*)(As + (1) * LDS_A + lofs + RPP * 0 * LDK) = a10;
      if (NA > 1) *(uint4*)(As + (1) * LDS_A + lofs + RPP * 1 * LDK) = a11;
      if (NA > 2) *(uint4*)(As + (1) * LDS_A + lofs + RPP * 2 * LDK) = a12;
      if (NA > 3) *(uint4*)(As + (1) * LDS_A + lofs + RPP * 3 * LDK) = a13;
      if (NB > 0) *(uint4*)(Bs + (1) * LDS_B + lofs + RPP * 0 * LDK) = b10;
      if (NB > 1) *(uint4*)(Bs + (1) * LDS_B + lofs + RPP * 1 * LDK) = b11;
      if (NB > 2) *(uint4*)(Bs + (1) * LDS_B + lofs + RPP * 2 * LDK) = b12;
      if (NB > 3) *(uint4*)(Bs + (1) * LDS_B + lofs + RPP * 3 * LDK) = b13;
      __syncthreads();
      if (kt + 3 < nk) {
        if (NA > 0) a10 = *(const uint4*)(Ag + (size_t)(RPP * 0) * lda + (kt + 3) * BK);
        if (NA > 1) a11 = *(const uint4*)(Ag + (size_t)(RPP * 1) * lda + (kt + 3) * BK);
        if (NA > 2) a12 = *(const uint4*)(Ag + (size_t)(RPP * 2) * lda + (kt + 3) * BK);
        if (NA > 3) a13 = *(const uint4*)(Ag + (size_t)(RPP * 3) * lda + (kt + 3) * BK);
        if (NB > 0) b10 = *(const uint4*)(Bg + (size_t)(RPP * 0) * ldb + (kt + 3) * BK);
        if (NB > 1) b11 = *(const uint4*)(Bg + (size_t)(RPP * 1) * ldb + (kt + 3) * BK);
        if (NB > 2) b12 = *(const uint4*)(Bg + (size_t)(RPP * 2) * ldb + (kt + 3) * BK);
        if (NB > 3) b13 = *(const uint4*)(Bg + (size_t)(RPP * 3) * ldb + (kt + 3) * BK);
      }
      __builtin_amdgcn_sched_barrier(0);
      {
        __builtin_amdgcn_iglp_opt(1);
        const bf16_t* as = as0 + (1) * LDS_A; const bf16_t* bs = bs0 + (1) * LDS_B;
      #pragma unroll
        for (int ks = 0; ks < BK / 16; ++ks) {
          bf16x8 af[MI], bfr[NI];
      #pragma unroll
          for (int mi = 0; mi < MI; ++mi) af[mi] = ld8(as + mi * 32 * LDK + ks * 16);
      #pragma unroll
          for (int ni = 0; ni < NI; ++ni) bfr[ni] = ld8(bs + ni * 32 * LDK + ks * 16);
      #pragma unroll
          for (int mi = 0; mi < MI; ++mi)
      #pragma unroll
            for (int ni = 0; ni < NI; ++ni) acc[mi][ni] = MFMA(af[mi], bfr[ni], acc[mi][ni]);
        }
      }
      if (kt + 2 < nk) {
        if (NA > 0) *(uint4*)(As + (0) * LDS_A + lofs + RPP * 0 * LDK) = a00;
        if (NA > 1) *(uint4*)(As + (0) * LDS_A + lofs + RPP * 1 * LDK) = a01;
        if (NA > 2) *(uint4*)(As + (0) * LDS_A + lofs + RPP * 2 * LDK) = a02;
        if (NA > 3) *(uint4*)(As + (0) * LDS_A + lofs + RPP * 3 * LDK) = a03;
        if (NB > 0) *(uint4*)(Bs + (0) * LDS_B + lofs + RPP * 0 * LDK) = b00;
        if (NB > 1) *(uint4*)(Bs + (0) * LDS_B + lofs + RPP * 1 * LDK) = b01;
        if (NB > 2) *(uint4*)(Bs + (0) * LDS_B + lofs + RPP * 2 * LDK) = b02;
        if (NB > 3) *(uint4*)(Bs + (0) * LDS_B + lofs + RPP * 3 * LDK) = b03;
      }
      __syncthreads();
    }
    epi.template run<MI, NI>(acc, m0 + wm * (BM / 2), n0 + wn * (BN / 2), lr, lh, part);
  }
}

struct EpiEvIn {
  bf16_t* PN; bf16_t* PT; float* gates; const float* gate_b;
  template <int MI, int NI> DI void run(f32x16 (&acc)[MI][NI], int rbase, int cbase, int lr, int lh, bool part) const {
#pragma unroll
    for (int ni = 0; ni < NI; ++ni) {
      const int col = cbase + ni * 32 + lr; const int seg = col >> 9, cc = col & 511;
      int nat = -1, tr = -1; float scale = 1.f;
      switch (seg) {
        case 0: nat = 0; scale = 0.08838834764831845f; break;
        case 1: nat = 512; tr = 0; break;
        case 2: tr = 512; break;
        case 3: nat = 1024; break;
        case 4: nat = 1536; break;
        case 5: nat = 2048; break;
        case 6: nat = 2560; break;
        case 7: tr = 1024; break;
        case 8: nat = 3072; break;
        default: break;
      }
#pragma unroll
      for (int mi = 0; mi < MI; ++mi)
#pragma unroll
        for (int g = 0; g < 4; ++g) {
          const int row = rbase + mi * 32 + 8 * g + 4 * lh;
          float v0 = acc[mi][ni][4 * g] * scale, v1 = acc[mi][ni][4 * g + 1] * scale, v2 = acc[mi][ni][4 * g + 2] * scale, v3 = acc[mi][ni][4 * g + 3] * scale;
          if (seg == 9) {
            if (cc < 16) { float b = gate_b[cc];
              gates[(size_t)row * 16 + cc] = v0 + b; gates[(size_t)(row + 1) * 16 + cc] = v1 + b; gates[(size_t)(row + 2) * 16 + cc] = v2 + b; gates[(size_t)(row + 3) * 16 + cc] = v3 + b; }
          } else {
            if (nat >= 0) { bf16_t* d = PN + (size_t)row * PNW + nat + cc; d[0] = f2bf(v0); d[PNW] = f2bf(v1); d[2 * PNW] = f2bf(v2); d[3 * PNW] = f2bf(v3); }
            if (tr >= 0) *(uint2*)(PT + (size_t)(tr + cc) * M + row) = pack4(v0, v1, v2, v3);
          }
        }
    }
  }
};

struct EpiResid {
  const float* xin_p; const float* xin_s; float* X; const float* gmod;
  template <int MI, int NI> DI void run(f32x16 (&acc)[MI][NI], int rbase, int cbase, int lr, int lh, bool part) const {
#pragma unroll
    for (int ni = 0; ni < NI; ++ni) {
      const int col = cbase + ni * 32 + lr;
#pragma unroll
      for (int mi = 0; mi < MI; ++mi) {
        const int r0 = rbase + mi * 32; const int j = r0 < MP ? 0 : 1 + ((r0 - MP) >> 11);
        const float gv = gmod[j * 6144 + col];
#pragma unroll
        for (int gg = 0; gg < 4; ++gg) {
          const int row = rbase + mi * 32 + 8 * gg + 4 * lh;
          const float* xi = (row < MP ? xin_p + (size_t)row * D : xin_s + (size_t)(row - MP) * D) + col;
          float* xo = X + (size_t)row * D + col;
#pragma unroll
          for (int e = 0; e < 4; ++e) {
            if (part) atomicAdd(xo + (size_t)e * D, gv * acc[mi][ni][4 * gg + e]);
            else xo[(size_t)e * D] = xi[(size_t)e * D] + gv * acc[mi][ni][4 * gg + e];
          }
        }
      }
    }
  }
};

struct EpiFFUp {
  bf16_t* U;
  template <int MI, int NI> DI void run(f32x16 (&acc)[MI][NI], int rbase, int cbase, int lr, int lh, bool part) const {
    static_assert(NI == 2, "ffn up needs paired tiles");
    const int oc = (cbase >> 6) * 32 + lr;
#pragma unroll
    for (int mi = 0; mi < MI; ++mi)
#pragma unroll
      for (int g = 0; g < 4; ++g) {
        const int row = rbase + mi * 32 + 8 * g + 4 * lh;
#pragma unroll
        for (int e = 0; e < 4; ++e) {
          float a1 = acc[mi][0][4 * g + e], a3 = acc[mi][1][4 * g + e];
          U[(size_t)(row + e) * DFF + oc] = f2bf(a1 * __frcp_rn(1.f + __expf(-a1)) * a3);
        }
      }
  }
};

struct EpiOdIn {
  bf16_t* Q; bf16_t* Kb; bf16_t* VT; float* AK; float* AV; const float* rope;
  template <int MI, int NI> DI void run(f32x16 (&acc)[MI][NI], int rbase, int cbase, int lr, int lh, bool part) const {
#pragma unroll
    for (int ni = 0; ni < NI; ++ni) {
      const int col = cbase + ni * 32 + lr; const int seg = col >> 10, cc = col & 1023; const int d = col & 127;
#pragma unroll
      for (int mi = 0; mi < MI; ++mi)
#pragma unroll
        for (int g = 0; g < 4; ++g) {
          const bool sample = (rbase + mi * 32) >= MP;
          const int row = rbase + mi * 32 + 8 * g + 4 * lh;
          float v[4];
#pragma unroll
          for (int e = 0; e < 4; ++e) v[e] = acc[mi][ni][4 * g + e];
          if (seg < 2) {
            if (sample) {
#pragma unroll
              for (int e = 0; e < 4; ++e) {
                float pv = __shfl_xor(v[e], 16);
                int n = (row + e - MP) & 2047; int pos = (d & 32) ? (n & 63) : (n >> 6);
                float2 cs = *(const float2*)(rope + (pos * 16 + (d & 15)) * 2);
                v[e] = (d & 16) ? (pv * cs.y + v[e] * cs.x) : (v[e] * cs.x - pv * cs.y);
              }
            }
            if (seg == 0) {
#pragma unroll
              for (int e = 0; e < 4; ++e) Q[(size_t)(row + e) * 1024 + cc] = f2bf(v[e] * 0.18033688011112042f);
            } else {
#pragma unroll
              for (int e = 0; e < 4; ++e) Kb[(size_t)(row + e) * 1024 + cc] = f2bf(v[e]);
              if (!sample) {
#pragma unroll
                for (int e = 0; e < 4; ++e) AK[(size_t)(row + e) * 1024 + cc] = v[e];
              }
            }
          } else {
            *(uint2*)(VT + (size_t)cc * M + row) = pack4(v[0], v[1], v[2], v[3]);
            if (!sample) {
#pragma unroll
              for (int e = 0; e < 4; ++e) AV[(size_t)(row + e) * 1024 + cc] = v[e];
            }
          }
        }
    }
  }
};

DI void s1_phase(const Params& p, unsigned char* smem) {
  bf16_t* Vt = (bf16_t*)smem;
  bf16_t* Ktf = Vt + 128 * 72;
  bf16_t* Ktb = Ktf + 128 * 72;
  float* wgf = (float*)(Ktb + 128 * 72);
  float* wgb = wgf + 64;
  const bf16_t* PN = (const bf16_t*)(p.ws + OFF_PN);
  const bf16_t* PT = (const bf16_t*)(p.ws + OFF_PT);
  const float* GATES = (const float*)(p.ws + OFF_GATES);
  float* SCAL = (float*)(p.ws + OFF_SCAL);
  float* NLOC = (float*)(p.ws + OFF_NLOC);
  float* AL = (float*)(p.ws + OFF_AL);
  bf16_t* MLST = (bf16_t*)(p.ws + OFF_ST);
  bf16_t* HGST = (bf16_t*)(p.out);
  const int tid = threadIdx.x, lane = tid & 63, wave = tid >> 6, lr = lane & 31, lh = lane >> 5;
  for (int item = blockIdx.x; item < 1536; item += gridDim.x) {
    const int kind = item >= 768; const int it = item - kind * 768; const int gc = it >> 2, h = it & 3; const int tok0 = gc * 64;
    const int slot0 = it * 2;
    if (kind == 0) {
      load_tile_128x64(Vt, PT + (size_t)(512 + h * 128) * M + tok0, M);
      uint4 rk[4];
      const bf16_t* PTk = PT + (size_t)(h * 128) * M + tok0;
#pragma unroll
      for (int i = 0; i < 4; ++i) { int c = tid + 256 * i; rk[i] = *(const uint4*)(PTk + (size_t)(c >> 3) * M + (c & 7) * 8); }
      if (wave == 0) {
        const float* gp = GATES + (size_t)(tok0 + lane) * 16;
        float igf = gp[h], igb = gp[4 + h], lff = logsig(gp[8 + h]), lfb = logsig(gp[12 + h]);
        float bfw = lff;
#pragma unroll
        for (int o = 1; o < 64; o <<= 1) { float t = __shfl_up(bfw, o); if (lane >= o) bfw += t; }
        float blf = __shfl(bfw, 63);
        float gf = blf - bfw + igf; float mlocf = wmax(gf); wgf[lane] = expf(gf - mlocf);
        float bbw = lfb;
#pragma unroll
        for (int o = 1; o < 64; o <<= 1) { float t = __shfl_down(bbw, o); if (lane + o < 64) bbw += t; }
        float blb = __shfl(bbw, 0);
        float gb = blb - bbw + igb; float mlocb = wmax(gb); wgb[lane] = expf(gb - mlocb);
        if (lane == 0) { SCAL[slot0 * 4 + 0] = blf; SCAL[slot0 * 4 + 1] = mlocf; SCAL[(slot0 + 1) * 4 + 0] = blb; SCAL[(slot0 + 1) * 4 + 1] = mlocb; }
      }
      __syncthreads();
#pragma unroll
      for (int i = 0; i < 4; ++i) {
        int c = tid + 256 * i; int row = c >> 3, ch = c & 7;
        unsigned w[4] = {rk[i].x, rk[i].y, rk[i].z, rk[i].w};
        unsigned of[4], ob[4];
#pragma unroll
        for (int q = 0; q < 4; ++q) {
          float k0 = lo_bf(w[q]), k1 = hi_bf(w[q]);
          int t = ch * 8 + q * 2;
          of[q] = pack2(k0 * wgf[t], k1 * wgf[t + 1]); ob[q] = pack2(k0 * wgb[t], k1 * wgb[t + 1]);
        }
        *(uint4*)(Ktf + row * 72 + ch * 8) = make_uint4(of[0], of[1], of[2], of[3]);
        *(uint4*)(Ktb + row * 72 + ch * 8) = make_uint4(ob[0], ob[1], ob[2], ob[3]);
      }
    } else {
      bf16_t* Xf = Vt;
      bf16_t* Xb = (bf16_t*)(smem + 55808);
      load_tile_64x128(Xf, PN + (size_t)tok0 * PNW + 2048 + h * 128, PNW);
      load_tile_64x128(Xb, PN + (size_t)tok0 * PNW + 2560 + h * 128, PNW);
      __syncthreads();
      const int dir = tid >> 7, dk = tid & 127; const int ch = h * 128 + dk;
      const float lb = 1.f / (1.f + expf(p.ev_lb_logits[512 + ch] - p.ev_lb_logits[ch]));
      const bf16_t* xs = dir ? Xb : Xf;
      bf16_t* Kt = dir ? Ktb : Ktf;
      float R = 1.f;
#pragma unroll 2
      for (int s = 0; s < 64; ++s) {
        int t = dir ? s : 63 - s;
        float x = bf2f(xs[t * 136 + dk]); float f = lb + (1.f - lb) * __frcp_rn(1.f + __expf(-x));
        Kt[dk * 72 + t] = f2bf((1.f - f) * R); R *= f;
      }
      AL[(slot0 + dir) * 128 + dk] = R;
      __syncthreads();
      load_tile_128x64(Vt, PT + (size_t)(1024 + h * 128) * M + tok0, M);
    }
    __syncthreads();
    bf16_t* ST = kind ? HGST : MLST;
#pragma unroll 1
    for (int dir = 0; dir < 2; ++dir) {
      const bf16_t* Kt = dir ? Ktb : Ktf;
      f32x16 acc[4];
#pragma unroll
      for (int ni = 0; ni < 4; ++ni) acc[ni] = zero16();
#pragma unroll
      for (int ks = 0; ks < 4; ++ks) {
        bf16x8 a = ld8(Kt + (wave * 32 + lr) * 72 + ks * 16 + lh * 8);
#pragma unroll
        for (int ni = 0; ni < 4; ++ni) { bf16x8 b = ld8(Vt + (ni * 32 + lr) * 72 + ks * 16 + lh * 8); acc[ni] = MFMA(a, b, acc[ni]); }
      }
      bf16_t* dst = ST + (size_t)(slot0 + dir) * 16384;
#pragma unroll
      for (int ni = 0; ni < 4; ++ni)
#pragma unroll
        for (int g = 0; g < 4; ++g)
          *(uint2*)(dst + (ni * 32 + lr) * 128 + wave * 32 + 8 * g + 4 * lh) = pack4(acc[ni][4 * g], acc[ni][4 * g + 1], acc[ni][4 * g + 2], acc[ni][4 * g + 3]);
    }
    if (kind == 0) {
      const int dir = tid >> 7, dk = tid & 127; const bf16_t* Kt = dir ? Ktb : Ktf; float s = 0.f;
#pragma unroll 8
      for (int t = 0; t < 64; ++t) s += bf2f(Kt[dk * 72 + t]);
      NLOC[(slot0 + dir) * 128 + dk] = s;
    }
    __syncthreads();
  }
}

DI void s2_phase(const Params& p, unsigned char* smem) {
  const float* __restrict__ SCAL = (const float*)(p.ws + OFF_SCAL);
  float* __restrict__ MINIT = (float*)(p.ws + OFF_MINIT);
  const float* __restrict__ NLOC = (const float*)(p.ws + OFF_NLOC);
  float* __restrict__ NINIT = (float*)(p.ws + OFF_NINIT);
  const float* __restrict__ AL = (const float*)(p.ws + OFF_AL);
  bf16_t* MLST = (bf16_t*)(p.ws + OFF_ST);
  bf16_t* HGST = (bf16_t*)(p.out);
  float* tl = (float*)smem;
  const int tid = threadIdx.x;
  for (int u = blockIdx.x; u < 4352; u += gridDim.x) {
    int kind, sample, seq, h, dir, slab;
    if (u < 256) { kind = u >> 7; int v = u & 127; slab = v & 7; v >>= 3; dir = v & 1; v >>= 1; h = v & 3; seq = v >> 2; sample = 1; }
    else { int v = u - 256; kind = v >= 2048; v -= kind * 2048; slab = v & 7; v >>= 3; dir = v & 1; v >>= 1; h = v & 3; seq = v >> 2; sample = 0; }
    const int nc = sample ? 32 : 4; const int gc0 = sample ? 128 + seq * 32 : seq * 4;
    bf16_t* ST = kind ? HGST : MLST;
    const int e = slab * 2048 + tid * 8; const int dv = e >> 7, dk0 = e & 127;
    float st[8]; float nst = 0.f, m = 0.f;
    const int sidx = (seq * 2 + dir) * 4 + h;
    if (sample) {
      const float* S0 = (kind ? p.st_S : p.st_C) + (size_t)sidx * 16384;
#pragma unroll
      for (int j = 0; j < 8; ++j) st[j] = S0[(dk0 + j) * 128 + dv];
      if (kind == 0) { m = p.st_m[sidx]; if (slab == 0 && tid < 128) nst = p.st_n[sidx * 128 + tid]; }
    } else {
#pragma unroll
      for (int j = 0; j < 8; ++j) st[j] = 0.f;
    }
    const int slot0 = ((gc0 + (dir ? nc - 1 : 0)) * 4 + h) * 2 + dir;
    const int sstep = dir ? -8 : 8;
    uint4 Lq[4]; float4 Aq0[4], Aq1[4]; float2 Sq[4]; float Nq[4];
    const bool nthr = (kind == 0) && (slab == 0) && (tid < 128);
#pragma unroll
    for (int i = 0; i < 4; ++i) {
      const int sl = slot0 + i * sstep;
      Lq[i] = *(const uint4*)(ST + (size_t)sl * 16384 + e);
      Aq0[i] = make_float4(0.f, 0.f, 0.f, 0.f); Aq1[i] = Aq0[i]; Sq[i] = make_float2(0.f, 0.f); Nq[i] = 0.f;
      if (kind) { Aq0[i] = *(const float4*)(AL + sl * 128 + dk0); Aq1[i] = *(const float4*)(AL + sl * 128 + dk0 + 4); }
      else { Sq[i] = *(const float2*)(SCAL + sl * 4); if (nthr) Nq[i] = NLOC[sl * 128 + tid]; }
    }
    for (int ps = 0; ps < nc; ps += 4) {
#pragma unroll
      for (int i = 0; i < 4; ++i) {
        const int slot = slot0 + (ps + i) * sstep;
        const uint4 Lc = Lq[i];
        float dec[8]; float ls;
        if (kind == 0) {
          const float bl = Sq[i].x, mloc = Sq[i].y; const float mn = fmaxf(bl + m, mloc); const float d = __expf(bl + m - mn); ls = __expf(mloc - mn);
#pragma unroll
          for (int j = 0; j < 8; ++j) dec[j] = d;
          if (slab == 0) { if (tid == 0) MINIT[slot] = m; if (tid < 128) { NINIT[slot * 128 + tid] = nst; nst = d * nst + ls * Nq[i]; } }
          m = mn;
        } else {
          ls = 1.f;
          dec[0] = Aq0[i].x; dec[1] = Aq0[i].y; dec[2] = Aq0[i].z; dec[3] = Aq0[i].w;
          dec[4] = Aq1[i].x; dec[5] = Aq1[i].y; dec[6] = Aq1[i].z; dec[7] = Aq1[i].w;
        }
        *(uint4*)(ST + (size_t)slot * 16384 + e) = make_uint4(pack2(st[0], st[1]), pack2(st[2], st[3]), pack2(st[4], st[5]), pack2(st[6], st[7]));
        float l[8] = {lo_bf(Lc.x), hi_bf(Lc.x), lo_bf(Lc.y), hi_bf(Lc.y), lo_bf(Lc.z), hi_bf(Lc.z), lo_bf(Lc.w), hi_bf(Lc.w)};
#pragma unroll
        for (int j = 0; j < 8; ++j) st[j] = dec[j] * st[j] + ls * l[j];
        if (ps + i + 4 < nc) {
          const int sl = slot + 4 * sstep;
          Lq[i] = *(const uint4*)(ST + (size_t)sl * 16384 + e);
          if (kind) { Aq0[i] = *(const float4*)(AL + sl * 128 + dk0); Aq1[i] = *(const float4*)(AL + sl * 128 + dk0 + 4); }
          else { Sq[i] = *(const float2*)(SCAL + sl * 4); if (nthr) Nq[i] = NLOC[sl * 128 + tid]; }
        }
      }
    }
    if (!sample) {
#pragma unroll
      for (int j = 0; j < 8; ++j) tl[(dk0 + j) * 17 + (dv & 15)] = st[j];
      __syncthreads();
      float* Co = p.out + (kind ? OUT_S : OUT_C) + (size_t)sidx * 16384;
      const int dkr = tid >> 1, hf = tid & 1;
      float4 o0, o1;
      o0.x = tl[dkr * 17 + hf * 8 + 0]; o0.y = tl[dkr * 17 + hf * 8 + 1]; o0.z = tl[dkr * 17 + hf * 8 + 2]; o0.w = tl[dkr * 17 + hf * 8 + 3];
      o1.x = tl[dkr * 17 + hf * 8 + 4]; o1.y = tl[dkr * 17 + hf * 8 + 5]; o1.z = tl[dkr * 17 + hf * 8 + 6]; o1.w = tl[dkr * 17 + hf * 8 + 7];
      *(float4*)(Co + dkr * 128 + slab * 16 + hf * 8) = o0;
      *(float4*)(Co + dkr * 128 + slab * 16 + hf * 8 + 4) = o1;
      if (kind == 0 && slab == 0) { if (tid < 128) p.out[OUT_N + sidx * 128 + tid] = nst; if (tid == 0) p.out[OUT_M + sidx] = m; }
      __syncthreads();
    }
  }
}

DI void s3_epilogue(const float* Hs, const float* gain, const bf16_t* gate_src, bf16_t* mix_dst, bool use_silu) {
  const int tid = threadIdx.x, t = tid >> 2, part = tid & 3;
  const float* hr = Hs + t * 132 + part * 32;
  float ss = 0.f;
#pragma unroll
  for (int i = 0; i < 8; ++i) { float4 v = *(const float4*)(hr + i * 4); ss += v.x * v.x + v.y * v.y + v.z * v.z + v.w * v.w; }
  ss += __shfl_xor(ss, 1); ss += __shfl_xor(ss, 2);
  const float rstd = rsqrtf(ss * (1.f / 128.f) + 1e-6f);
#pragma unroll
  for (int i = 0; i < 8; ++i) {
    const int d = part * 32 + i * 4;
    float4 v = *(const float4*)(hr + i * 4); float4 g4 = *(const float4*)(gain + d);
    uint2 gs = *(const uint2*)(gate_src + (size_t)t * PNW + d);
    float x0 = lo_bf(gs.x), x1 = hi_bf(gs.x), x2 = lo_bf(gs.y), x3 = hi_bf(gs.y);
    float s0 = __frcp_rn(1.f + __expf(-x0)), s1 = __frcp_rn(1.f + __expf(-x1)), s2 = __frcp_rn(1.f + __expf(-x2)), s3 = __frcp_rn(1.f + __expf(-x3));
    if (use_silu) { s0 *= x0; s1 *= x1; s2 *= x2; s3 *= x3; }
    *(uint2*)(mix_dst + (size_t)t * 1024 + d) = pack4(v.x * rstd * g4.x * s0, v.y * rstd * g4.y * s1, v.z * rstd * g4.z * s2, v.w * rstd * g4.w * s3);
  }
}

DI void s3_phase(const Params& p, unsigned char* smem) {
  const bf16_t* PN = (const bf16_t*)(p.ws + OFF_PN);
  const bf16_t* PT = (const bf16_t*)(p.ws + OFF_PT);
  const float* GATES = (const float*)(p.ws + OFF_GATES);
  const float* SCAL = (const float*)(p.ws + OFF_SCAL);
  const float* NINIT = (const float*)(p.ws + OFF_NINIT);
  const float* MINIT = (const float*)(p.ws + OFF_MINIT);
  const bf16_t* MLST = (const bf16_t*)(p.ws + OFF_ST);
  const bf16_t* HGST = (const bf16_t*)(p.out);
  bf16_t* MIX = (bf16_t*)(p.out + OUT_AK);
  const int tid = threadIdx.x, lane = tid & 63, wave = tid >> 6, lr = lane & 31, lh = lane >> 5, wm = wave >> 1, wn = wave & 1;
  float* Hs = (float*)smem;
  for (int item = blockIdx.x; item < 1536; item += gridDim.x) {
    const int kind = item >= 768; const int it = item - kind * 768; const int gc = it >> 2, h = it & 3; const int tok0 = gc * 64;
    const int slotf = it * 2, slotb = it * 2 + 1;
    if (kind == 0) {
      bf16_t* Qs = (bf16_t*)smem;
      bf16_t* Ks = Qs + 64 * 136;
      bf16_t* Vt = Ks + 64 * 136;
      bf16_t* Pf = Vt + 128 * 72;
      bf16_t* Pb = Pf + 64 * 72;
      float* fa = (float*)(Pb + 64 * 72);
      float* rF = fa, *cF = fa + 64, *wF = fa + 128, *mtF = fa + 192, *rB = fa + 256, *cB = fa + 320, *wB = fa + 384, *mtB = fa + 448;
      float* facPf = fa + 512, *facPb = fa + 576, *facIf = fa + 640, *facIb = fa + 704;
      float* nF = fa + 768, *nB = fa + 896, *qnF = fa + 1024, *qnB = fa + 1088;
      load_tile_64x128(Qs, PN + (size_t)tok0 * PNW + h * 128, PNW);
      load_tile_64x128(Ks, PN + (size_t)tok0 * PNW + 512 + h * 128, PNW);
      load_tile_128x64(Vt, PT + (size_t)(512 + h * 128) * M + tok0, M);
      if (wave == 0) {
        const float* gp = GATES + (size_t)(tok0 + lane) * 16;
        float igf = gp[h], igb = gp[4 + h], lff = logsig(gp[8 + h]), lfb = logsig(gp[12 + h]);
        float bfw = lff;
#pragma unroll
        for (int o = 1; o < 64; o <<= 1) { float t = __shfl_up(bfw, o); if (lane >= o) bfw += t; }
        float cf = igf - bfw; float pm = cf;
#pragma unroll
        for (int o = 1; o < 64; o <<= 1) { float t = __shfl_up(pm, o); if (lane >= o) pm = fmaxf(pm, t); }
        float mF = MINIT[slotf];
        float interF = bfw + mF; float mt = fmaxf(interF, bfw + pm);
        rF[lane] = bfw - mt; cF[lane] = cf; wF[lane] = expf(interF - mt); mtF[lane] = mt;
        float bbw = lfb;
#pragma unroll
        for (int o = 1; o < 64; o <<= 1) { float t = __shfl_down(bbw, o); if (lane + o < 64) bbw += t; }
        float cb = igb - bbw; float sm = cb;
#pragma unroll
        for (int o = 1; o < 64; o <<= 1) { float t = __shfl_down(sm, o); if (lane + o < 64) sm = fmaxf(sm, t); }
        float mB = MINIT[slotb];
        float interB = bbw + mB; float mt2 = fmaxf(interB, bbw + sm);
        rB[lane] = bbw - mt2; cB[lane] = cb; wB[lane] = expf(interB - mt2); mtB[lane] = mt2;
      }
      if (wave >= 2) { int i = tid - 128; nF[i] = NINIT[slotf * 128 + i]; nB[i] = NINIT[slotb * 128 + i]; }
      __syncthreads();
      {
        f32x16 s = zero16();
#pragma unroll
        for (int ks = 0; ks < 8; ++ks) { bf16x8 a = ld8(Qs + (wm * 32 + lr) * 136 + ks * 16 + lh * 8); bf16x8 b = ld8(Ks + (wn * 32 + lr) * 136 + ks * 16 + lh * 8); s = MFMA(a, b, s); }
        const int sidx = wn * 32 + lr; const float cfs = cF[sidx], cbs = cB[sidx];
#pragma unroll
        for (int i = 0; i < 16; ++i) {
          const int t = wm * 32 + crow(i, lh);
          float pf = (sidx <= t) ? s[i] * __expf(rF[t] + cfs) : 0.f;
          float pb = (sidx >= t) ? s[i] * __expf(rB[t] + cbs) : 0.f;
          Pf[t * 72 + sidx] = f2bf(pf); Pb[t * 72 + sidx] = f2bf(pb);
        }
        const int t = tid >> 2, part = tid & 3; float sf = 0.f, sb = 0.f;
#pragma unroll 8
        for (int d = part * 32; d < part * 32 + 32; ++d) { float q = bf2f(Qs[t * 136 + d]); sf += q * nF[d]; sb += q * nB[d]; }
        sf += __shfl_xor(sf, 1); sf += __shfl_xor(sf, 2); sb += __shfl_xor(sb, 1); sb += __shfl_xor(sb, 2);
        if (part == 0) { qnF[t] = sf; qnB[t] = sb; }
      }
      __syncthreads();
      {
        const int t = tid >> 2, part = tid & 3; float sf = 0.f, sb = 0.f;
#pragma unroll
        for (int j = 0; j < 16; ++j) { sf += bf2f(Pf[t * 72 + part * 16 + j]); sb += bf2f(Pb[t * 72 + part * 16 + j]); }
        sf += __shfl_xor(sf, 1); sf += __shfl_xor(sf, 2); sb += __shfl_xor(sb, 1); sb += __shfl_xor(sb, 2);
        if (part == 0) {
          float denf = wF[t] * qnF[t] + sf; float Nf = fmaxf(fabsf(denf), expf(-mtF[t])); facPf[t] = 1.f / Nf; facIf[t] = wF[t] / Nf;
          float denb = wB[t] * qnB[t] + sb; float Nb = fmaxf(fabsf(denb), expf(-mtB[t])); facPb[t] = 1.f / Nb; facIb[t] = wB[t] / Nb;
        }
      }
      __syncthreads();
      f32x16 hacc[2]; hacc[0] = zero16(); hacc[1] = zero16();
#pragma unroll
      for (int pd = 0; pd < 2; ++pd) {
        __builtin_amdgcn_sched_barrier(0);
        const bf16_t* Pm = pd ? Pb : Pf; const float* fac = pd ? facPb : facPf;
        f32x16 t0[2]; t0[0] = zero16(); t0[1] = zero16();
#pragma unroll
        for (int ks = 0; ks < 4; ++ks) {
          bf16x8 bv = ld8(Vt + (wave * 32 + lr) * 72 + ks * 16 + lh * 8);
#pragma unroll
          for (int mi = 0; mi < 2; ++mi) t0[mi] = MFMA(ld8(Pm + (mi * 32 + lr) * 72 + ks * 16 + lh * 8), bv, t0[mi]);
        }
#pragma unroll
        for (int mi = 0; mi < 2; ++mi)
#pragma unroll
          for (int i = 0; i < 16; ++i) hacc[mi][i] += t0[mi][i] * fac[mi * 32 + crow(i, lh)];
      }
#pragma unroll
      for (int pd = 0; pd < 2; ++pd) {
        __builtin_amdgcn_sched_barrier(0);
        const bf16_t* Cm = MLST + (size_t)(pd ? slotb : slotf) * 16384 + (wave * 32 + lr) * 128 + lh * 8;
        const float* fac = pd ? facIb : facIf;
        f32x16 t0[2]; t0[0] = zero16(); t0[1] = zero16();
#pragma unroll
        for (int ks = 0; ks < 8; ++ks) {
          bf16x8 b0 = ld8(Cm + ks * 16);
#pragma unroll
          for (int mi = 0; mi < 2; ++mi) t0[mi] = MFMA(ld8(Qs + (mi * 32 + lr) * 136 + ks * 16 + lh * 8), b0, t0[mi]);
        }
#pragma unroll
        for (int mi = 0; mi < 2; ++mi)
#pragma unroll
          for (int i = 0; i < 16; ++i) hacc[mi][i] += t0[mi][i] * fac[mi * 32 + crow(i, lh)];
      }
      __syncthreads();
#pragma unroll
      for (int mi = 0; mi < 2; ++mi)
#pragma unroll
        for (int i = 0; i < 16; ++i) Hs[(mi * 32 + crow(i, lh)) * 132 + wave * 32 + lr] = hacc[mi][i];
      __syncthreads();
      s3_epilogue(Hs, p.ml_norm_g + h * 128, PN + (size_t)tok0 * PNW + 1024 + h * 128, MIX + (size_t)tok0 * 1024 + h * 128, false);
      __syncthreads();
    } else {
      bf16_t* QF = (bf16_t*)smem;
      bf16_t* QB = QF + 64 * 136;
      bf16_t* KF = QB + 64 * 136;
      bf16_t* KB = KF + 9216;
      bf16_t* P = KF;
      bf16_t* It = KB;
      load_tile_64x128(KF, PN + (size_t)tok0 * PNW + 2048 + h * 128, PNW);
      load_tile_64x128(KB, PN + (size_t)tok0 * PNW + 2560 + h * 128, PNW);
      load_tile_64x128(QF, PN + (size_t)tok0 * PNW + 1536 + h * 128, PNW);
      load_tile_64x128(QB, PN + (size_t)tok0 * PNW + 1536 + h * 128, PNW);
      __syncthreads();
      {
        const int dir = tid >> 7, dk = tid & 127; const int ch = h * 128 + dk;
        const float lb = 1.f / (1.f + expf(p.ev_lb_logits[512 + ch] - p.ev_lb_logits[ch]));
        bf16_t* Qd = dir ? QB : QF; bf16_t* Kd = dir ? KB : KF;
        float P = 1.f;
#pragma unroll 2
        for (int s = 0; s < 64; ++s) {
          int t = dir ? 63 - s : s;
          float x = bf2f(Kd[t * 136 + dk]); float f = lb + (1.f - lb) * __frcp_rn(1.f + __expf(-x));
          P *= f;
          float q = bf2f(Qd[t * 136 + dk]);
          Qd[t * 136 + dk] = f2bf(q * P); Kd[t * 136 + dk] = f2bf((1.f - f) * __frcp_rn(fmaxf(P, 1.8e-35f)));
        }
      }
      __syncthreads();
      f32x16 pacc;
      {
        f32x16 sf = zero16(), sb = zero16();
#pragma unroll
        for (int ks = 0; ks < 8; ++ks) {
          sf = MFMA(ld8(QF + (wm * 32 + lr) * 136 + ks * 16 + lh * 8), ld8(KF + (wn * 32 + lr) * 136 + ks * 16 + lh * 8), sf);
          sb = MFMA(ld8(QB + (wm * 32 + lr) * 136 + ks * 16 + lh * 8), ld8(KB + (wn * 32 + lr) * 136 + ks * 16 + lh * 8), sb);
        }
        const int sidx = wn * 32 + lr;
#pragma unroll
        for (int i = 0; i < 16; ++i) { const int t = wm * 32 + crow(i, lh); pacc[i] = ((sidx <= t) ? sf[i] : 0.f) + ((sidx >= t) ? sb[i] : 0.f); }
      }
      f32x16 o[2]; o[0] = zero16(); o[1] = zero16();
      {
        const bf16_t* Sf = HGST + (size_t)slotf * 16384 + (wave * 32 + lr) * 128 + lh * 8;
        const bf16_t* Sb = HGST + (size_t)slotb * 16384 + (wave * 32 + lr) * 128 + lh * 8;
#pragma unroll
        for (int ks = 0; ks < 8; ++ks) {
          bf16x8 b0 = ld8(Sf + ks * 16), b1 = ld8(Sb + ks * 16);
#pragma unroll
          for (int mi = 0; mi < 2; ++mi) {
            o[mi] = MFMA(ld8(QF + (mi * 32 + lr) * 136 + ks * 16 + lh * 8), b0, o[mi]);
            o[mi] = MFMA(ld8(QB + (mi * 32 + lr) * 136 + ks * 16 + lh * 8), b1, o[mi]);
          }
        }
      }
      __syncthreads();
      {
        const int sidx = wn * 32 + lr;
#pragma unroll
        for (int i = 0; i < 16; ++i) P[(wm * 32 + crow(i, lh)) * 72 + sidx] = f2bf(pacc[i]);
      }
      load_tile_128x64(It, PT + (size_t)(1024 + h * 128) * M + tok0, M);
      __syncthreads();
#pragma unroll
      for (int ks = 0; ks < 4; ++ks) {
        bf16x8 bv = ld8(It + (wave * 32 + lr) * 72 + ks * 16 + lh * 8);
#pragma unroll
        for (int mi = 0; mi < 2; ++mi) o[mi] = MFMA(ld8(P + (mi * 32 + lr) * 72 + ks * 16 + lh * 8), bv, o[mi]);
      }
#pragma unroll
      for (int mi = 0; mi < 2; ++mi)
#pragma unroll
        for (int i = 0; i < 16; ++i) Hs[(mi * 32 + crow(i, lh)) * 132 + wave * 32 + lr] = o[mi][i];
      __syncthreads();
      s3_epilogue(Hs, p.hg_norm_g + h * 128, PN + (size_t)tok0 * PNW + 3072 + h * 128, MIX + (size_t)tok0 * 1024 + 512 + h * 128, true);
      __syncthreads();
    }
  }
}

DI void online_softmax(f32x16& s, float& m, float& l, f32x16 (&O)[4], bf16x8& p0, bf16x8& p1) {
  float mx = s[0];
#pragma unroll
  for (int i = 1; i < 16; ++i) mx = fmaxf(mx, s[i]);
  { auto r = __builtin_amdgcn_permlane32_swap(__float_as_uint(mx), __float_as_uint(mx), false, false); mx = fmaxf(__uint_as_float(r[0]), __uint_as_float(r[1])); }
  const float mn = fmaxf(m, mx);
  if (__ballot(mn > m) != 0ull) {
    const float alpha = __builtin_amdgcn_exp2f(m - mn);
    l *= alpha;
#pragma unroll
    for (int mt = 0; mt < 4; ++mt)
#pragma unroll
      for (int i = 0; i < 16; ++i) O[mt][i] *= alpha;
    m = mn;
  }
  float sum = 0.f;
#pragma unroll
  for (int i = 0; i < 16; ++i) { s[i] = __builtin_amdgcn_exp2f(s[i] - m); sum += s[i]; }
  l += sum;
  uint4 u0 = make_uint4(pack2(s[0], s[1]), pack2(s[2], s[3]), pack2(s[4], s[5]), pack2(s[6], s[7]));
  uint4 u1 = make_uint4(pack2(s[8], s[9]), pack2(s[10], s[11]), pack2(s[12], s[13]), pack2(s[14], s[15]));
  p0 = __builtin_bit_cast(bf16x8, u0); p1 = __builtin_bit_cast(bf16x8, u1);
}

#define ATTN_GLOAD(KT) do { \
    const int kt_ = (KT); const bf16_t* ksrc; size_t kld; const bf16_t* vsrc; size_t vld; \
    if (sample && kt_ < 4) { ksrc = KC + ((size_t)(seq * 8 + h) * 256 + kt_ * 64) * 128; kld = 128; vsrc = VCT + (size_t)(seq * 8 + h) * 128 * 256 + kt_ * 64; vld = 256; } \
    else { const int kt2 = sample ? kt_ - 4 : kt_; const int t0 = tokbase + kt2 * 64; ksrc = Kb + (size_t)t0 * 1024 + h * 128; kld = 1024; vsrc = VT + (size_t)(h * 128) * M + t0; vld = M; } \
    ksrc += (size_t)(tid >> 4) * kld + (tid & 15) * 8; vsrc += (size_t)(tid >> 3) * vld + (tid & 7) * 8; \
    rk0 = *(const uint4*)(ksrc); rk1 = *(const uint4*)(ksrc + 16 * kld); rk2 = *(const uint4*)(ksrc + 32 * kld); rk3 = *(const uint4*)(ksrc + 48 * kld); \
    rv0 = *(const uint4*)(vsrc); rv1 = *(const uint4*)(vsrc + 32 * vld); rv2 = *(const uint4*)(vsrc + 64 * vld); rv3 = *(const uint4*)(vsrc + 96 * vld); } while (0)
#define ATTN_LSTORE(KD, VD) do { \
    bf16_t* kd_ = (KD) + (tid >> 4) * 136 + (tid & 15) * 8; bf16_t* vd_ = (VD) + (tid >> 3) * 72 + (tid & 7) * 8; \
    *(uint4*)(kd_) = rk0; *(uint4*)(kd_ + 16 * 136) = rk1; *(uint4*)(kd_ + 32 * 136) = rk2; *(uint4*)(kd_ + 48 * 136) = rk3; \
    *(uint4*)(vd_) = rv0; *(uint4*)(vd_ + 32 * 72) = rv1; *(uint4*)(vd_ + 64 * 72) = rv2; *(uint4*)(vd_ + 96 * 72) = rv3; } while (0)

DI void attn_phase(const Params& p, unsigned char* smem) {
  bf16_t* Ks = (bf16_t*)smem;
  bf16_t* Vts = Ks + 64 * 136;
  float* Cmb = (float*)smem;
  const bf16_t* Q = (const bf16_t*)(p.ws + OFF_Q);
  const bf16_t* Kb = (const bf16_t*)(p.ws + OFF_KB);
  const bf16_t* VT = (const bf16_t*)(p.ws + OFF_VT);
  const bf16_t* KC = (const bf16_t*)(p.ws + OFF_KC);
  const bf16_t* VCT = (const bf16_t*)(p.ws + OFF_VCT);
  bf16_t* ATT = (bf16_t*)(p.ws + OFF_ATT);
  const float* MISC = (const float*)(p.ws + OFF_MISC);
  const float lam = MISC[0], lam_init = MISC[1];
  const int tid = threadIdx.x, lane = tid & 63, wave = tid >> 6, lr = lane & 31, lh = lane >> 5;
  const int br = wave >> 1, qw = wave & 1;
  for (int vit = blockIdx.x; vit < 1536; vit += gridDim.x) {
    int item = vit;
    {
      const int b = vit & 511, rnd = vit >> 9; const int xcd = b & 7, slot = b >> 3;
      if (rnd == 0) item = ((xcd * 2 + (slot >> 5)) << 5) | (slot & 31);
      else item = 512 + (((xcd * 32 + (slot >> 1)) << 2) | (((slot & 1) << 1) | (rnd - 1)));
    }
    int sample, seq, h, qb;
    if (item < 512) { sample = 1; qb = item & 31; h = (item >> 5) & 7; seq = item >> 8; }
    else { int v = item - 512; sample = 0; qb = v & 3; h = (v >> 2) & 7; seq = v >> 5; }
    const int tokbase = sample ? MP + seq * 2048 : seq * 256;
    const int nkt = sample ? 36 : 4;
    const int qtok = tokbase + qb * 64 + qw * 32 + lr;
    bf16x8 q[4];
    {
      const bf16_t* qp = Q + (size_t)qtok * 1024 + h * 128 + br * 64 + lh * 8;
#pragma unroll
      for (int s = 0; s < 4; ++s) q[s] = ld8(qp + s * 16);
    }
    f32x16 O[4];
#pragma unroll
    for (int mt = 0; mt < 4; ++mt) O[mt] = zero16();
    float m = -1e30f, l = 0.f;
    uint4 rk0, rk1, rk2, rk3, rv0, rv1, rv2, rv3;
    ATTN_GLOAD(0);
    __syncthreads();
    ATTN_LSTORE(Ks, Vts);
    __syncthreads();
    for (int kt = 0; kt < nkt; ++kt) {
      const int cur = kt & 1;
      if (kt + 1 < nkt) ATTN_GLOAD(kt + 1);
      const bf16_t* Kc = Ks + cur * 17920; const bf16_t* Vc = Vts + cur * 17920;
#pragma unroll
      for (int sub = 0; sub < 2; ++sub) {
        __builtin_amdgcn_iglp_opt(3);
        f32x16 s1 = zero16();
#pragma unroll
        for (int s = 0; s < 4; ++s) s1 = MFMA(ld8(Kc + (sub * 32 + lr) * 136 + br * 64 + s * 16 + lh * 8), q[s], s1);
        bf16x8 pa[2];
        online_softmax(s1, m, l, O, pa[0], pa[1]);
#pragma unroll
        for (int k2 = 0; k2 < 2; ++k2)
#pragma unroll
          for (int mt = 0; mt < 4; ++mt) {
            const bf16_t* vp = Vc + (mt * 32 + lr) * 72 + sub * 32 + k2 * 16 + 4 * lh;
            uint2 lo = *(const uint2*)vp, hi = *(const uint2*)(vp + 8);
            bf16x8 vf = __builtin_bit_cast(bf16x8, make_uint4(lo.x, lo.y, hi.x, hi.y));
            O[mt] = MFMA(vf, pa[k2], O[mt]);
          }
      }
      if (kt + 1 < nkt) ATTN_LSTORE(Ks + (cur ^ 1) * 17920, Vts + (cur ^ 1) * 17920);
      __syncthreads();
    }
    l += __shfl_xor(l, 32);
    const float inv = br ? lam / l : 1.f / l;
    __syncthreads();
    if (br == 1) {
#pragma unroll
      for (int mt = 0; mt < 4; ++mt)
#pragma unroll
        for (int i = 0; i < 16; ++i) Cmb[(qw * 64 + mt * 16 + i) * 64 + lane] = O[mt][i] * inv;
    }
    __syncthreads();
    if (br == 0) {
      float ss = 0.f;
#pragma unroll
      for (int mt = 0; mt < 4; ++mt)
#pragma unroll
        for (int i = 0; i < 16; ++i) { float o = O[mt][i] * inv - Cmb[(qw * 64 + mt * 16 + i) * 64 + lane]; O[mt][i] = o; ss += o * o; }
      ss += __shfl_xor(ss, 32);
      const float sc = rsqrtf(ss * (1.f / 128.f) + 1e-6f) * (1.f - lam_init);
      bf16_t* dst = ATT + (size_t)qtok * 1024 + h * 128;
#pragma unroll
      for (int mt = 0; mt < 4; ++mt)
#pragma unroll
        for (int g = 0; g < 4; ++g) {
          const int dv = mt * 32 + 8 * g + 4 * lh;
          float4 g4 = *(const float4*)(p.da_norm_g + dv);
          *(uint2*)(dst + dv) = pack4(O[mt][4 * g] * sc * g4.x, O[mt][4 * g + 1] * sc * g4.y, O[mt][4 * g + 2] * sc * g4.z, O[mt][4 * g + 3] * sc * g4.w);
        }
    }
  }
}

__global__ void __launch_bounds__(256, 2) mega(Params p) {
  __shared__ __attribute__((aligned(16))) unsigned char smem[SMEM_BYTES];
  cg::grid_group grid = cg::this_grid();
  unsigned char* ws = p.ws;
  float* MOD = (float*)(ws + OFF_MOD);
  float* X = p.out + OUT_Y;
  bf16_t* A = (bf16_t*)(ws + OFF_A);
  bf16_t* U = (bf16_t*)(ws + OFF_U);

  __shared__ uint4 xb_words;
  unsigned* bar = (unsigned*)(ws + OFF_BAR);
  if (threadIdx.x == 0) xb_words = make_uint4(0u, 0u, 0u, 0u);
  __syncthreads();
  XcdBarrier xb = xcd_barrier_post(bar, (volatile LAS unsigned*)&xb_words);
  if (p.ws == nullptr) grid.sync();
  for (int rep = 0; rep < REP_P0; ++rep) phase0(p, smem);
  xcd_barrier(xb);
  norm_phase(p.x_prompt, p.x_sample, p.norm_mix_g, MOD, 1024, 0, A);
  xcd_barrier(xb);
  {
    EpiEvIn e{(bf16_t*)(ws + OFF_PN), (bf16_t*)(ws + OFF_PT), (float*)(ws + OFF_GATES), p.ev_gate_b};
    for (int rep = 0; rep < REP_G; ++rep) gemm_phase<128, 128, 64, false>(A, 1024, (const bf16_t*)(ws + OFF_W_EVIN), 1024, M, 4736, 1024, e, smem);
  }
  xcd_barrier(xb);
  for (int rep = 0; rep < REP_MIX; ++rep) s1_phase(p, smem);
  xcd_barrier(xb);
  s2_phase(p, smem);
  xcd_barrier(xb);
  for (int rep = 0; rep < REP_MIX; ++rep) s3_phase(p, smem);
  xcd_barrier(xb);
  {
    EpiResid e{p.x_prompt, p.x_sample, X, MOD + 2048};
    gemm_phase<128, 64, 64, false>((const bf16_t*)(p.out + OUT_AK), 1024, (const bf16_t*)(ws + OFF_W_EVOUT), 1024, M, 1024, 1024, e, smem);
  }
  xcd_barrier(xb);
  norm_phase(X, X + (size_t)MP * D, p.norm_ffn_g, MOD, 4096, 3072, A);
  xcd_barrier(xb);
  {
    EpiFFUp e{U};
    for (int rep = 0; rep < REP_G; ++rep) gemm_phase<128, 128, 64, false>(A, 1024, (const bf16_t*)(ws + OFF_W_FFU0), 1024, M, 5632, 1024, e, smem);
  }
  xcd_barrier(xb);
  {
    EpiResid e{X, X + (size_t)MP * D, X, MOD + 5120};
    gemm_phase<128, 128, 64, true>(U, DFF, (const bf16_t*)(ws + OFF_W_FFD0), DFF, M, 1024, DFF, e, smem);
  }
  xcd_barrier(xb);
  norm_phase(X, X + (size_t)MP * D, p.norm_mix_g + 1024, MOD + 3 * 6144, 1024, 0, A);
  xcd_barrier(xb);
  {
    EpiOdIn e{(bf16_t*)(ws + OFF_Q), (bf16_t*)(ws + OFF_KB), (bf16_t*)(ws + OFF_VT), p.out + OUT_AK, p.out + OUT_AV, (const float*)(ws + OFF_ROPE)};
    for (int rep = 0; rep < REP_G; ++rep) gemm_phase<128, 128, 64, false>(A, 1024, (const bf16_t*)(ws + OFF_W_ODIN), 1024, M, 3072, 1024, e, smem);
  }
  xcd_barrier(xb);
  for (int rep = 0; rep < REP_ATT; ++rep) attn_phase(p, smem);
  xcd_barrier(xb);
  {
    EpiResid e{X, X + (size_t)MP * D, X, MOD + 3 * 6144 + 2048};
    gemm_phase<128, 128, 64, true>((const bf16_t*)(ws + OFF_ATT), 1024, (const bf16_t*)(ws + OFF_W_ODOUT), 1024, M, 1024, 1024, e, smem);
  }
  xcd_barrier(xb);
  norm_phase(X, X + (size_t)MP * D, p.norm_ffn_g + 1024, MOD + 3 * 6144, 4096, 3072, A);
  xcd_barrier(xb);
  {
    EpiFFUp e{U};
    for (int rep = 0; rep < REP_G; ++rep) gemm_phase<128, 128, 64, false>(A, 1024, (const bf16_t*)(ws + OFF_W_FFU1), 1024, M, 5632, 1024, e, smem);
  }
  xcd_barrier(xb);
  {
    EpiResid e{X, X + (size_t)MP * D, X, MOD + 3 * 6144 + 5120};
    gemm_phase<128, 128, 64, true>(U, DFF, (const bf16_t*)(ws + OFF_W_FFD1), DFF, M, 1024, DFF, e, smem);
  }
  xcd_barrier(xb);
  final_norm_phase(X, p.final_norm_g);
}

extern "C" void kernel_launch(void* const* d_in, const int* in_sizes, int n_in, void* d_out, int out_size, void* d_ws, size_t ws_size, hipStream_t stream) {
  static int grid_blocks = 0;
  if (!grid_blocks) {
    int dev = 0, cus = 0, per_cu = 0;
    (void)hipGetDevice(&dev);
    (void)hipDeviceGetAttribute(&cus, hipDeviceAttributeMultiprocessorCount, dev);
    (void)hipOccupancyMaxActiveBlocksPerMultiprocessor(&per_cu, mega, 256, 0);
    per_cu = 2;
    grid_blocks = cus * per_cu;
    if (ws_size < WS_END) { fprintf(stderr, "kernel_launch: workspace too small: %zu < %zu\n", ws_size, (size_t)WS_END); grid_blocks = -1; }
  }
  if (grid_blocks < 0) return;
  (void)hipMemsetAsync((unsigned char*)d_ws + OFF_BAR, 0, 16384, stream);
  Params p{};
  const float** pp = (const float**)&p;
  for (int i = 0; i < 28; ++i) pp[i] = (const float*)d_in[i];
  p.out = (float*)d_out; p.ws = (unsigned char*)d_ws;
  void* args[] = {&p};
  hipError_t e = hipLaunchCooperativeKernel((void*)mega, dim3(grid_blocks), dim3(256), args, 0, stream);
  if (e != hipSuccess) fprintf(stderr, "cooperative launch failed: %s (grid %d)\n", hipGetErrorString(e), grid_blocks);
}
```
